# Optimizing an MI355X kernel written in HIP

```python
import jax, jax.numpy as jnp
from jax import lax
import numpy as np

D_MODEL = 2048
BATCH = 4
SEQ = 8192
DEPTH = 1
DEC_BATCH = 32
DEC_SEQ = 16
PAST_LEN = 2048

CHUNK = 64
Q_BLOCK = 128
HEAD_DIM = 128
MIX_WIDTH = D_MODEL
SB_WIDTH = MIX_WIDTH // 2
ML_WIDTH = MIX_WIDTH - SB_WIDTH
SB_HEADS = SB_WIDTH // HEAD_DIM
ML_HEADS = ML_WIDTH // HEAD_DIM
CONV_W = 4
D_FF = ((8 * D_MODEL // 3 + 127) // 128) * 128
IN_PROJ = 3 * SB_WIDTH + 4 * ML_WIDTH + 2 * ML_HEADS
EPS = 1e-6

kernel_name = 'stick_breaking_mlstm_hymba_step'


def rmsnorm(x, g):
    xf = x.astype(jnp.float32)
    xf = xf * lax.rsqrt(jnp.mean(xf * xf, axis=-1, keepdims=True) + EPS)
    return (xf * g.astype(jnp.float32)).astype(x.dtype)


def head_rmsnorm(y, g, n_heads, dtype):
    B, T, W = y.shape
    yf = y.astype(jnp.float32).reshape(B, T, n_heads, W // n_heads)
    yf = yf * lax.rsqrt(jnp.mean(yf * yf, axis=-1, keepdims=True) + EPS)
    return (yf.reshape(B, T, W) * g.astype(jnp.float32)).astype(dtype)


def swiglu(x, w1, w3, w2):
    return (jax.nn.silu(x @ w1) * (x @ w3)) @ w2


def causal_conv(u, buf, w, b):
    T = u.shape[1]
    full = jnp.concatenate([buf.astype(u.dtype), u], axis=1)
    out = b
    for j in range(CONV_W):
        out = out + w[j] * full[:, j:j + T]
    return out, full[:, T:]


def stick_breaking(q, k, v, q_pos, k_pos):
    z = jnp.einsum('bqhd,bkhd->bhqk', q.astype(jnp.float32), k.astype(jnp.float32)) * HEAD_DIM ** -0.5
    mask = k_pos[None, :] < q_pos[:, None]
    log_1m = jnp.where(mask, jax.nn.log_sigmoid(-z), 0.0)
    suffix = lax.cumsum(log_1m, axis=3, reverse=True) - log_1m
    a = jnp.where(mask, jnp.exp(jax.nn.log_sigmoid(z) + suffix), 0.0)
    return jnp.einsum('bhqk,bkhd->bqhd', a, v.astype(jnp.float32))


def stick_breaking_prompt(q, k, v):
    B, T, H, d = q.shape
    nb = T // Q_BLOCK
    qb = jnp.moveaxis(q.reshape(B, nb, Q_BLOCK, H, d), 1, 0)
    qpos = jnp.arange(T, dtype=jnp.int32).reshape(nb, Q_BLOCK)
    kpos = jnp.arange(T, dtype=jnp.int32)
    out = lax.map(lambda a: stick_breaking(a[0], k, v, a[1], kpos), (qb, qpos))
    return jnp.moveaxis(out, 0, 1).reshape(B, T, H, d)


def _mlstm_chunk(carry, xs):
    C0, n0, m0 = carry
    q, k, v, ig, lf = xs
    L = q.shape[1]
    ig = jnp.swapaxes(ig, 1, 2)
    b = jnp.cumsum(jnp.swapaxes(lf, 1, 2), axis=-1)
    causal = jnp.tril(jnp.ones((L, L), dtype=bool))
    dmat = jnp.where(causal, b[..., :, None] - b[..., None, :] + ig[..., None, :], -jnp.inf)
    m_inter = b + m0[..., None]
    m = jnp.maximum(m_inter, jnp.max(dmat, axis=-1))
    w = jnp.exp(dmat - m[..., None])
    inter = jnp.exp(m_inter - m)
    s = jnp.einsum('blhd,bshd->bhls', q, k) * w
    num = jnp.einsum('bhls,bshd->bhld', s, v) + inter[..., None] * jnp.einsum('blhd,bhde->bhle', q, C0)
    den = jnp.sum(s, axis=-1) + inter * jnp.einsum('blhd,bhd->bhl', q, n0)
    h = num / jnp.maximum(jnp.abs(den), jnp.exp(-m))[..., None]
    w_end = w[..., -1, :]
    decay_end = inter[..., -1]
    C_new = decay_end[..., None, None] * C0 + jnp.einsum('bhs,bshd,bshe->bhde', w_end, k, v)
    n_new = decay_end[..., None] * n0 + jnp.einsum('bhs,bshd->bhd', w_end, k)
    return (C_new, n_new, m[..., -1]), jnp.swapaxes(h, 1, 2)


def mlstm(q, k, v, ig, lf, C0, n0, m0):
    B, T, H, d = q.shape
    L = min(T, CHUNK)
    nc = T // L
    to_chunks = lambda t: jnp.moveaxis(t.astype(jnp.float32).reshape((B, nc, L) + t.shape[2:]), 1, 0)
    xs = (to_chunks(q), to_chunks(k), to_chunks(v), to_chunks(ig), to_chunks(lf))
    (C, n, m), h = lax.scan(_mlstm_chunk, (C0, n0, m0), xs)
    return jnp.moveaxis(h, 0, 1).reshape(B, T, H, d), C, n, m


def token_mix(h, w_in, b_ig, b_fg, conv_w, conv_b, sb_g, ml_g, w_out,
              conv_buf, C0, n0, m0, k_past, v_past):
    B, T, _ = h.shape
    u = h @ w_in
    q_a, k_a, v_a, qk_b, v_b, o_b, gates = jnp.split(
        u, [SB_WIDTH, 2 * SB_WIDTH, 3 * SB_WIDTH, 3 * SB_WIDTH + 2 * ML_WIDTH,
            3 * SB_WIDTH + 3 * ML_WIDTH, 3 * SB_WIDTH + 4 * ML_WIDTH], axis=-1)
    q_a = q_a.reshape(B, T, SB_HEADS, HEAD_DIM)
    k_a = k_a.reshape(B, T, SB_HEADS, HEAD_DIM)
    v_a = v_a.reshape(B, T, SB_HEADS, HEAD_DIM)
    if k_past is None:
        y_a = stick_breaking_prompt(q_a, k_a, v_a)
    else:
        P = k_past.shape[1]
        k_all = jnp.concatenate([k_past.astype(k_a.dtype), k_a], axis=1)
        v_all = jnp.concatenate([v_past.astype(v_a.dtype), v_a], axis=1)
        y_a = stick_breaking(q_a, k_all, v_all, P + jnp.arange(T, dtype=jnp.int32),
                             jnp.arange(P + T, dtype=jnp.int32))
    qk_c, conv_new = causal_conv(qk_b, conv_buf, conv_w, conv_b)
    qk_c = jax.nn.silu(qk_c)
    q_b = qk_c[..., :ML_WIDTH].reshape(B, T, ML_HEADS, HEAD_DIM)
    k_b = qk_c[..., ML_WIDTH:].reshape(B, T, ML_HEADS, HEAD_DIM) * HEAD_DIM ** -0.5
    v_b = v_b.reshape(B, T, ML_HEADS, HEAD_DIM)
    gf = gates.astype(jnp.float32)
    ig = gf[..., :ML_HEADS] + b_ig.astype(jnp.float32)
    lf = jax.nn.log_sigmoid(gf[..., ML_HEADS:] + b_fg.astype(jnp.float32))
    h_b, C, n, m = mlstm(q_b, k_b, v_b, ig, lf, C0, n0, m0)
    y_b = jax.nn.sigmoid(o_b.astype(jnp.float32)) * h_b.reshape(B, T, ML_WIDTH)
    merged = jnp.concatenate([head_rmsnorm(y_a.reshape(B, T, SB_WIDTH), sb_g, SB_HEADS, h.dtype),
                              head_rmsnorm(y_b, ml_g, ML_HEADS, h.dtype)], axis=-1)
    return merged @ w_out, k_a, v_a, C, n, m, conv_new


def layer(x, g1, f1w1, f1w3, f1w2, gm, w_in, b_ig, b_fg, conv_w, conv_b, sb_g, ml_g, w_out,
          g2, f2w1, f2w3, f2w2, conv_buf, C0, n0, m0, k_past, v_past):
    x = x + 0.5 * swiglu(rmsnorm(x, g1), f1w1, f1w3, f1w2)
    y, k_a, v_a, C, n, m, conv_new = token_mix(rmsnorm(x, gm), w_in, b_ig, b_fg, conv_w, conv_b,
                                               sb_g, ml_g, w_out, conv_buf, C0, n0, m0, k_past, v_past)
    x = x + y
    x = x + 0.5 * swiglu(rmsnorm(x, g2), f2w1, f2w3, f2w2)
    return x, (k_a, v_a, C, n, m, conv_new)


def setup_inputs(seed: int = 0) -> dict:
    key = jax.random.key(seed)
    ks = jax.random.split(key, 32)
    nrm = lambda k, shape, s: jax.random.normal(k, shape, jnp.float32) * s
    gain = lambda k, shape: 1.0 + 0.02 * jax.random.normal(k, shape, jnp.float32)
    return {
        'x_prompt': nrm(ks[0], (BATCH, SEQ, D_MODEL), 1.0),
        'x_sample': nrm(ks[1], (DEC_BATCH, DEC_SEQ, D_MODEL), 1.0),
        'cache_k': nrm(ks[2], (DEPTH, DEC_BATCH, PAST_LEN, SB_HEADS, HEAD_DIM), 1.0),
        'cache_v': nrm(ks[3], (DEPTH, DEC_BATCH, PAST_LEN, SB_HEADS, HEAD_DIM), 1.0),
        'state_C': nrm(ks[4], (DEPTH, DEC_BATCH, ML_HEADS, HEAD_DIM, HEAD_DIM), 0.05),
        'state_n': nrm(ks[5], (DEPTH, DEC_BATCH, ML_HEADS, HEAD_DIM), 0.05),
        'state_m': nrm(ks[6], (DEPTH, DEC_BATCH, ML_HEADS), 1.0),
        'state_conv': nrm(ks[7], (DEPTH, DEC_BATCH, CONV_W - 1, 2 * ML_WIDTH), 1.0),
        'norm_ffn1_g': gain(ks[8], (DEPTH, D_MODEL)),
        'ffn1_w1': nrm(ks[9], (DEPTH, D_MODEL, D_FF), D_MODEL ** -0.5),
        'ffn1_w3': nrm(ks[10], (DEPTH, D_MODEL, D_FF), D_MODEL ** -0.5),
        'ffn1_w2': nrm(ks[11], (DEPTH, D_FF, D_MODEL), D_FF ** -0.5),
        'norm_mix_g': gain(ks[12], (DEPTH, D_MODEL)),
        'w_in': nrm(ks[13], (DEPTH, D_MODEL, IN_PROJ), D_MODEL ** -0.5),
        'b_igate': nrm(ks[14], (DEPTH, ML_HEADS), 0.1),
        'b_fgate': jnp.linspace(3.0, 6.0, ML_HEADS, dtype=jnp.float32)[None, :] + nrm(ks[15], (DEPTH, ML_HEADS), 0.1),
        'conv_w': nrm(ks[16], (DEPTH, CONV_W, 2 * ML_WIDTH), CONV_W ** -0.5),
        'conv_b': nrm(ks[17], (DEPTH, 2 * ML_WIDTH), 0.02),
        'sb_norm_g': gain(ks[18], (DEPTH, SB_WIDTH)),
        'ml_norm_g': gain(ks[19], (DEPTH, ML_WIDTH)),
        'w_out': nrm(ks[20], (DEPTH, MIX_WIDTH, D_MODEL), MIX_WIDTH ** -0.5),
        'norm_ffn2_g': gain(ks[21], (DEPTH, D_MODEL)),
        'ffn2_w1': nrm(ks[22], (DEPTH, D_MODEL, D_FF), D_MODEL ** -0.5),
        'ffn2_w3': nrm(ks[23], (DEPTH, D_MODEL, D_FF), D_MODEL ** -0.5),
        'ffn2_w2': nrm(ks[24], (DEPTH, D_FF, D_MODEL), D_FF ** -0.5),
        'final_norm_g': gain(ks[25], (D_MODEL,)),
    }


def reference(x_prompt, x_sample, cache_k, cache_v, state_C, state_n, state_m, state_conv,
              norm_ffn1_g, ffn1_w1, ffn1_w3, ffn1_w2, norm_mix_g, w_in, b_igate, b_fgate,
              conv_w, conv_b, sb_norm_g, ml_norm_g, w_out, norm_ffn2_g, ffn2_w1, ffn2_w3, ffn2_w2,
              final_norm_g):
    xp, xs = x_prompt, x_sample
    Bp = xp.shape[0]
    st_p, st_s = [], []
    for l in range(DEPTH):
        lw = (norm_ffn1_g[l], ffn1_w1[l], ffn1_w3[l], ffn1_w2[l], norm_mix_g[l], w_in[l],
              b_igate[l], b_fgate[l], conv_w[l], conv_b[l], sb_norm_g[l], ml_norm_g[l], w_out[l],
              norm_ffn2_g[l], ffn2_w1[l], ffn2_w3[l], ffn2_w2[l])
        xp, sp = layer(xp, *lw,
                       jnp.zeros((Bp, CONV_W - 1, 2 * ML_WIDTH), xp.dtype),
                       jnp.zeros((Bp, ML_HEADS, HEAD_DIM, HEAD_DIM), jnp.float32),
                       jnp.zeros((Bp, ML_HEADS, HEAD_DIM), jnp.float32),
                       jnp.zeros((Bp, ML_HEADS), jnp.float32), None, None)
        xs, ss = layer(xs, *lw, state_conv[l], state_C[l].astype(jnp.float32),
                       state_n[l].astype(jnp.float32), state_m[l].astype(jnp.float32),
                       cache_k[l], cache_v[l])
        st_p.append(tuple(t.astype(x_prompt.dtype) for t in sp))
        st_s.append(tuple(t.astype(state_C.dtype) for t in ss))
    y_prompt = rmsnorm(xp, final_norm_g)
    y_sample = rmsnorm(xs, final_norm_g)
    new_k_prompt, new_v_prompt, new_C_prompt, new_n_prompt, new_m_prompt, new_conv_prompt = [
        jnp.stack(s) for s in zip(*st_p)]
    new_k_sample, new_v_sample, new_C_sample, new_n_sample, new_m_sample, new_conv_sample = [
        jnp.stack(s) for s in zip(*st_s)]
    return (y_prompt, y_sample, new_k_prompt, new_v_prompt, new_C_prompt, new_n_prompt, new_m_prompt,
            new_conv_prompt, new_k_sample, new_v_sample, new_C_sample, new_n_sample, new_m_sample,
            new_conv_sample)
```

```cpp
#include <hip/hip_runtime.h>
#include <cstdio>
#include <cstdint>

#ifndef MK_N_LAUNCHES
#define MK_N_LAUNCHES 1
#endif

constexpr int DM = 2048, MP = 32768, MS = 512, MROWS = MP + MS, TP = 8192, TS = 16, NBP = 4, NBS = 32, PAST = 2048;
constexpr int FF = 5504, FF2 = 2 * FF, NIN = 7184, NINP = 7424, HD = 128, NH = 8, GW = 1024;
constexpr int NCHP = NBP * NH * (TP / 64), NCHS = NBS * NH, NCH = NCHP + NCHS;
constexpr int LDX = DM, LDW = DM;
constexpr float EPS = 1e-6f;
constexpr float QSCALE = 0.08838834764831845f * 1.4426950408889634f;
constexpr float KSCALE = 0.08838834764831845f;

constexpr size_t O_Y = 0, O_KP = 68157440, O_VP = 101711872, O_CP = 135266304, O_NP = 135790592, O_MP = 135794688, O_CVP = 135794720,
                 O_KS = 135819296, O_VS = 136343584, O_CS = 136867872, O_NS = 141062176, O_MS = 141094944, O_CVS = 141095200, O_END = 141291808;

namespace pg8 {
#define PG8_LAS __attribute__((address_space(3)))
typedef unsigned short bf16_t;
typedef short bf16x8 __attribute__((ext_vector_type(8)));
typedef float f32x4 __attribute__((ext_vector_type(4)));
typedef unsigned u32x4 __attribute__((ext_vector_type(4)));
constexpr int BM = 256, BK = 64, HALF = 128, HTB = HALF * BK * 2  , STAGE_BYTES = 8 * HTB, NXCD = 8, WGM = 4;

__host__ __device__ __forceinline__ int lds_byte(int r, int c) { const int st = (r >> 4) * 2 + (c >> 5), rr = r & 15, cc = c & 31, ob = rr * 64 + cc * 2; return st * 1024 + (ob ^ (((ob >> 9) & 1) << 5)); }
__host__ __device__ __forceinline__ void stage_rc(int b, int& R, int& C) { const int st = b / 1024, sb = b % 1024, swz = sb ^ (((sb >> 9) & 1) << 5); R = (st >> 1) * 16 + swz / 64; C = (st & 1) * 32 + (swz % 64) / 2; }
__host__ __device__ __forceinline__ int perm32(int rho) { const int n = rho >> 4, i = rho & 15; return 8 * (i >> 2) + 4 * n + (i & 3); }

struct Unit { int pm, pn; };
struct Gemm { const bf16_t* A; const bf16_t* Bt; int M, N, K; int kt0 = 0, ktn = 0;   };
__host__ __device__ __forceinline__ size_t tiled_elem(int row, int col, int nKT) {
    const size_t blk = ((size_t)(row >> 8) * nKT + (col >> 6)) * 2 + ((row >> 7) & 1);
    return blk * 8192 + (size_t)(lds_byte(row & 127, col & 63) >> 1);
}
__host__ __device__ __forceinline__ int perm32inv(int c) { return 16 * ((c >> 2) & 1) + 4 * (c >> 3) + (c & 3); }
__host__ __device__ __forceinline__ size_t tiled_elem_b(int n, int k, int nKT) { return tiled_elem((n & ~31) + perm32inv(n & 31), k, nKT); }

struct StaticOrder {
    bool rev = false;
    bool shared_a = false;
    int nM, nN, nwg, G, c, wgm;
    __host__ __device__ void init(int M, int N, int G_, int c_, int wgm_ = WGM) { nM = M / BM; nN = N / BM; nwg = nM * nN; G = G_; c = c_; wgm = wgm_; }
    __host__ __device__ bool next(int i, Unit& u) const {
        const long L = (long)i * G + c; if (L >= nwg) return false;
        int wgid = (int)L; if (!shared_a) { const int q = nwg / NXCD, r = nwg % NXCD, xcd = wgid % NXCD, off = wgid / NXCD; wgid = (xcd < r ? xcd * (q + 1) : r * (q + 1) + (xcd - r) * q) + off; }
        const int nig = wgm * nN, gid = wgid / nig, fm = gid * wgm, gsz = (nM - fm) < wgm ? (nM - fm) : wgm;
        u.pm = fm + ((wgid % nig) % gsz); u.pn = (wgid % nig) / gsz; if (rev) u.pm = nM - 1 - u.pm; return true;
    }
    __device__ __forceinline__ void a_ready(const Unit&) const {}
    __device__ __forceinline__ void done(const Unit&) const {}
};
struct SingleOrder {
    int pm, pn;
    __host__ __device__ bool next(int i, Unit& u) const { if (i != 0) return false; u.pm = pm; u.pn = pn; return true; }
    __device__ __forceinline__ void a_ready(const Unit&) const {}
    __device__ __forceinline__ void done(const Unit&) const {}
};


typedef float f32x2 __attribute__((ext_vector_type(2)));
typedef __bf16 bf16x2_t __attribute__((ext_vector_type(2)));
__device__ __forceinline__ unsigned cvt_pk_bf16(float lo, float hi) { f32x2 v = {lo, hi}; bf16x2_t b = __builtin_convertvector(v, bf16x2_t); return __builtin_bit_cast(unsigned, b); }
__device__ __forceinline__ u32x4 pack8(f32x4 a, f32x4 b) { u32x4 w; w.x = cvt_pk_bf16(a[0], a[1]); w.y = cvt_pk_bf16(a[2], a[3]); w.z = cvt_pk_bf16(b[0], b[1]); w.w = cvt_pk_bf16(b[2], b[3]); return w; }

__device__ __forceinline__ void row_rstd(const float* SS, const Unit& u, int wr, int fr, int fq, float (&r)[2][4]) {
#pragma unroll
    for (int ai = 0; ai < 2; ++ai)
#pragma unroll
        for (int m = 0; m < 4; ++m) {
            const int row = u.pm * BM + ai * HALF + wr * 64 + m * 16 + fr;
            const f32x4* p = (const f32x4*)(SS + (size_t)row * 32 + fq * 8);
            const f32x4 a = p[0], b = p[1];
            float s = ((a[0] + a[1]) + (a[2] + a[3])) + ((b[0] + b[1]) + (b[2] + b[3]));
            s += __shfl_xor(s, 16); s += __shfl_xor(s, 32);
            r[ai][m] = 1.0f / sqrtf(s * (1.0f / 2048.0f) + 1e-6f);
        }
}
__device__ __forceinline__ float logsig_f(float x) { return fminf(x, 0.f) - 0.6931471805599453f * __builtin_amdgcn_logf(1.0f + __builtin_amdgcn_exp2f(-1.4426950408889634f * fabsf(x))); }
__device__ __forceinline__ void row_rstd_direct(const float* RS, const Unit& u, int wr, int fr, float (&r)[2][4]) {
#pragma unroll
    for (int ai = 0; ai < 2; ++ai)
#pragma unroll
        for (int m = 0; m < 4; ++m) r[ai][m] = RS[u.pm * BM + ai * HALF + wr * 64 + m * 16 + fr];
}
__device__ __forceinline__ float sigmoid_f(float a) { return __builtin_amdgcn_rcpf(1.0f + __builtin_amdgcn_exp2f(-1.4426950408889634f * a)); }

template <bool DIRECT  > struct EpiSwiGLU {
    static constexpr bool PERM = true, AFTER_DRAIN = false, TOUCH_NEXT = false;
    bf16_t* H; int ldh; const float* SS;
    __device__ __forceinline__ void operator()(const f32x4 (&acc)[2][2][4][2], const Unit& u, int wr, int wc, int fr, int fq) const {
        float r[2][4]; if (DIRECT) row_rstd_direct(SS, u, wr, fr, r); else row_rstd(SS, u, wr, fr, fq, r);
        const int col0 = u.pn * HALF + wc * 32 + 8 * fq;
#pragma unroll
        for (int ai = 0; ai < 2; ++ai)
#pragma unroll
            for (int m = 0; m < 4; ++m) {
                const float rs = r[ai][m], rsn = rs * -1.4426950408889634f;
                bf16_t* rowp = H + tiled_elem(u.pm * BM + ai * HALF + wr * 64 + m * 16 + fr, col0, ldh / BK);
                f32x4 o[2];
#pragma unroll
                for (int n = 0; n < 2; ++n)
#pragma unroll
                    for (int hv = 0; hv < 2; ++hv) {
                        const f32x2 av = (f32x2){acc[ai][0][m][n][2 * hv], acc[ai][0][m][n][2 * hv + 1]}, bv = (f32x2){acc[ai][1][m][n][2 * hv], acc[ai][1][m][n][2 * hv + 1]};
                        const f32x2 t = av * rsn; f32x2 e; e.x = __builtin_amdgcn_exp2f(t.x); e.y = __builtin_amdgcn_exp2f(t.y);
                        const f32x2 d = e + 1.0f; f32x2 q; q.x = __builtin_amdgcn_rcpf(d.x); q.y = __builtin_amdgcn_rcpf(d.y);
                        const f32x2 h = (av * (rs * rs)) * (bv * q);
                        o[n][2 * hv] = h.x; o[n][2 * hv + 1] = h.y; }
                *(u32x4*)rowp = pack8(o[0], o[1]);
            }
    }
};

__device__ __forceinline__ f32x4 bf_lo4(unsigned a, unsigned b) { return (f32x4){__uint_as_float(a << 16), __uint_as_float(a & 0xffff0000u), __uint_as_float(b << 16), __uint_as_float(b & 0xffff0000u)}; }
struct EpiResid {
    static constexpr bool PERM = true, AFTER_DRAIN = false, TOUCH_NEXT = true;
    const bf16_t* base; bf16_t* out; float* SSout; float scale; int ldx;
    __device__ __forceinline__ float touch(const Unit& n) const { float s = 0.f;
#pragma unroll
        for (int q = 0; q < 2; ++q) { const int line = (int)threadIdx.x + 512 * q, b = line >> 7;
            s += *(const float*)(base + tiled_elem(n.pm * BM + (b & 1) * HALF, n.pn * BM + (b >> 1) * BK, 2048 / BK) + (size_t)(line & 127) * 64); }
        return s; }
    __device__ __forceinline__ void operator()(const f32x4 (&acc)[2][2][4][2], const Unit& u, int wr, int wc, int fr, int fq) const {
        const int colb = u.pn * BM + wc * 32 + 8 * fq;
        const size_t row0 = (size_t)(u.pm * BM + wr * 64 + fr);
        u32x4 bv[2][4][2];
#pragma unroll
        for (int ai = 0; ai < 2; ++ai)
#pragma unroll
            for (int m = 0; m < 4; ++m)
#pragma unroll
                for (int bj = 0; bj < 2; ++bj) bv[ai][m][bj] = *(const u32x4*)(base + tiled_elem((int)row0 + ai * HALF + m * 16, colb + bj * HALF, 2048 / BK));
#pragma unroll
        for (int ai = 0; ai < 2; ++ai)
#pragma unroll
            for (int m = 0; m < 4; ++m) {
                const size_t row = row0 + ai * HALF + m * 16;
                float ss = 0.f;
#pragma unroll
                for (int bj = 0; bj < 2; ++bj) {
                    const u32x4 b = bv[ai][m][bj];
                    const f32x4 v0 = bf_lo4(b.x, b.y) + acc[ai][bj][m][0] * scale, v1 = bf_lo4(b.z, b.w) + acc[ai][bj][m][1] * scale;
                    *(u32x4*)(out + tiled_elem((int)row, colb + bj * HALF, 2048 / BK)) = pack8(v0, v1);
                    ss += ((v0[0] * v0[0] + v0[1] * v0[1]) + (v0[2] * v0[2] + v0[3] * v0[3])) + ((v1[0] * v1[0] + v1[1] * v1[1]) + (v1[2] * v1[2] + v1[3] * v1[3]));
                }
                { const auto r16 = __builtin_amdgcn_permlane16_swap(__float_as_uint(ss), __float_as_uint(ss), false, false); ss = __uint_as_float(r16[0]) + __uint_as_float(r16[1]);
                  const auto r32 = __builtin_amdgcn_permlane32_swap(__float_as_uint(ss), __float_as_uint(ss), false, false); ss = __uint_as_float(r32[0]) + __uint_as_float(r32[1]); }
                if (fq == 0) SSout[row * 32 + u.pn * 4 + wc] = ss;
            }
    }
};

struct EpiInProj {
    static constexpr bool PERM = true, AFTER_DRAIN = false, TOUCH_NEXT = false;
    const float* SS;        bf16_t *QA, *KA, *VA, *QKB, *VB, *OB; float *outKP, *outVP, *outKS, *outVS; float* G; const float *b_ig, *b_fg; int splitRow; float qscale;
    __device__ __forceinline__ void operator()(const f32x4 (&acc)[2][2][4][2], const Unit& u, int wr, int wc, int fr, int fq) const {
        float r[2][4]; row_rstd_direct(SS, u, wr, fr, r);
        const int pn = u.pn;
        if (pn == 28) {
            if (wc == 0 && fq < 2) {
                const float* bias = fq == 0 ? b_ig : b_fg;
                const f32x4 bv0 = *(const f32x4*)bias, bv1 = *(const f32x4*)(bias + 4);
#pragma unroll
                for (int ai = 0; ai < 2; ++ai)
#pragma unroll
                    for (int m = 0; m < 4; ++m) {
                        const int row = u.pm * BM + ai * HALF + wr * 64 + m * 16 + fr;
                        f32x4 v0 = acc[ai][0][m][0] * r[ai][m] + bv0, v1 = acc[ai][0][m][1] * r[ai][m] + bv1;
                        if (fq == 1) {
#pragma unroll
                            for (int j = 0; j < 4; ++j) { v0[j] = logsig_f(v0[j]); v1[j] = logsig_f(v1[j]); }
                        }
                        *(f32x4*)(G + (size_t)row * 16 + 8 * fq) = v0; *(f32x4*)(G + (size_t)row * 16 + 8 * fq + 4) = v1;
                    }
            }
            return;
        }
        bf16_t* dst; int ld = 1024, ct = pn & 3; float sc = 1.f; float *fP = nullptr, *fS = nullptr; bool sig = false;
        if (pn < 4) { dst = QA; sc = qscale; }
        else if (pn < 8) { dst = KA; fP = outKP; fS = outKS; }
        else if (pn < 12) { dst = VA; fP = outVP; fS = outVS; }
        else if (pn < 20) { dst = QKB; ld = 2048; ct = pn - 12; }
        else if (pn < 24) { dst = VB; }
        else { dst = OB; sig = true; }
        const int colb = ct * BM + wc * 32 + 8 * fq;
#pragma unroll
        for (int ai = 0; ai < 2; ++ai)
#pragma unroll
            for (int m = 0; m < 4; ++m) {
                const int row = u.pm * BM + ai * HALF + wr * 64 + m * 16 + fr;
                const float rs = r[ai][m] * sc;
                float* fp = nullptr;
                if (fP) fp = (row >= splitRow) ? fS + (size_t)(row - splitRow) * 1024 : fP + (size_t)row * 1024;
#pragma unroll
                for (int bj = 0; bj < 2; ++bj) {
                    const int col = colb + bj * HALF;
                    f32x4 v0 = acc[ai][bj][m][0] * rs, v1 = acc[ai][bj][m][1] * rs;
                    if (sig) {
#pragma unroll
                        for (int j = 0; j < 4; ++j) { v0[j] = sigmoid_f(v0[j]); v1[j] = sigmoid_f(v1[j]); }
                    }
                    if (fp) { *(f32x4*)(fp + col) = v0; *(f32x4*)(fp + col + 4) = v1; }
                    *(u32x4*)(dst + (size_t)row * ld + col) = pack8(v0, v1);
                }
            }
    }
};


struct EpiPartial {
    static constexpr bool PERM = true, AFTER_DRAIN = false, TOUCH_NEXT = false;
    float* P; int row_base;
    __device__ __forceinline__ void operator()(const f32x4 (&acc)[2][2][4][2], const Unit& u, int wr, int wc, int fr, int fq) const {
        const int colb = u.pn * BM + wc * 32 + 8 * fq;
        const int row0 = u.pm * BM - row_base + wr * 64 + fr;
#pragma unroll
        for (int ai = 0; ai < 2; ++ai)
#pragma unroll
            for (int m = 0; m < 4; ++m)
#pragma unroll
                for (int bj = 0; bj < 2; ++bj) {
                    float* p = P + (size_t)(row0 + ai * HALF + m * 16) * 2048 + colb + bj * HALF;
                    *(f32x4*)p = acc[ai][bj][m][0]; *(f32x4*)(p + 4) = acc[ai][bj][m][1];
                }
    }
};

struct EpiProbe {
    static constexpr bool PERM = true, AFTER_DRAIN = false, TOUCH_NEXT = false;
    float* sink; int flag;
    __device__ __forceinline__ void operator()(const f32x4 (&acc)[2][2][4][2], const Unit& u, int wr, int wc, int fr, int fq) const {
        if (flag) {
            f32x4 s = (f32x4){0.f, 0.f, 0.f, 0.f};
#pragma unroll
            for (int ai = 0; ai < 2; ++ai)
#pragma unroll
                for (int bj = 0; bj < 2; ++bj)
#pragma unroll
                    for (int m = 0; m < 4; ++m)
#pragma unroll
                        for (int n = 0; n < 2; ++n) s += acc[ai][bj][m][n];
            *(f32x4*)(sink + (size_t)(u.pm * 8 + u.pn) * 2048 + threadIdx.x * 4) = s;
        }
    }
};
template <class Epi, class Sched, bool ALIGN_EPI = false, bool SP2 = false>
__device__ __forceinline__ void gemm_phase(PG8_LAS unsigned char* lds, const Gemm g, const Sched& S, const Epi& E) {
    const int tid = threadIdx.x, wid = __builtin_amdgcn_readfirstlane(tid >> 6), lane = tid & 63, wr = wid >> 2, wc = wid & 3, fr = lane & 15, fq = lane >> 4;
    const int K = g.K, nt = g.ktn > 0 ? g.ktn : K / BK;
    unsigned voffA[2], voffB[2];
#pragma unroll
    for (int i = 0; i < 2; ++i) { voffA[i] = (unsigned)(wid * 2048 + lane * 16); voffB[i] = voffA[i]; }
    static_assert(Epi::PERM, "the tiled weight copies carry the PERM row order");
    const size_t kstep = 32768;
    const size_t hstepA = 16384, hstepB = 16384;
    const size_t tstepA = (size_t)(K / BK) * 32768, tstepB = tstepA;
    const unsigned ldsw = (unsigned)wid * 2048u;
    const int aoff = lds_byte(wr * 64 + fr, fq * 8), boff = lds_byte(wc * 32 + fr, fq * 8);
#ifndef PG8_DMA_AUX
#define PG8_DMA_AUX 16
#endif
#define PG8_SA(b, h) (((b) * 2 + (h)) * HTB)
#define PG8_SB(b, h) ((4 + (b) * 2 + (h)) * HTB)
#define PG8_STAGE(bufoff, gbase, voff) do { const unsigned* _g = (const unsigned*)((const char*)(gbase) + (voff)[0]); PG8_LAS unsigned* _l = (PG8_LAS unsigned*)(lds + (bufoff) + ldsw); \
        __builtin_amdgcn_global_load_lds(_g, _l, 16, 0, PG8_DMA_AUX); __builtin_amdgcn_global_load_lds(_g, _l, 16, 1024, PG8_DMA_AUX); } while (0)
#define PG8_LDA(dst, b, h) do { _Pragma("unroll") for (int m = 0; m < 4; ++m) _Pragma("unroll") for (int k = 0; k < 2; ++k) dst[m][k] = *(const PG8_LAS bf16x8*)(lds + PG8_SA(b, h) + aoff + m * 2048 + k * 1024); } while (0)
#define PG8_LDB(dst, b, h) do { _Pragma("unroll") for (int n = 0; n < 2; ++n) _Pragma("unroll") for (int k = 0; k < 2; ++k) dst[n][k] = *(const PG8_LAS bf16x8*)(lds + PG8_SB(b, h) + boff + n * 2048 + k * 1024); } while (0)
#define PG8_MMA(ai, bj, At, Bt) do { __builtin_amdgcn_s_setprio(1); _Pragma("unroll") for (int m = 0; m < 4; ++m) _Pragma("unroll") for (int n = 0; n < 2; ++n) _Pragma("unroll") for (int k = 0; k < 2; ++k) \
        acc[ai][bj][m][n] = __builtin_amdgcn_mfma_f32_16x16x32_bf16(Bt[n][k], At[m][k], acc[ai][bj][m][n], 0, 0, 0); __builtin_amdgcn_s_setprio(0); } while (0)
#define PG8_WAIT_V(n) asm volatile("s_waitcnt vmcnt(" #n ")" ::: "memory")
#define PG8_WAIT_L(n) asm volatile("s_waitcnt lgkmcnt(" #n ")" ::: "memory")
#define PG8_BAR __builtin_amdgcn_s_barrier()
#define PG8_SCHED __builtin_amdgcn_sched_barrier(0)
    Unit cur, nxt; int ui = 0;
    if (!S.next(0, cur)) return;
    f32x4 acc[2][2][4][2];
#pragma unroll
    for (int a = 0; a < 2; ++a)
#pragma unroll
        for (int b = 0; b < 2; ++b)
#pragma unroll
            for (int m = 0; m < 4; ++m)
#pragma unroll
                for (int n = 0; n < 2; ++n) acc[a][b][m][n] = (f32x4){0.f, 0.f, 0.f, 0.f};
    bf16x8 At[4][2], B0[2][2], B1[2][2];
    const size_t koff = (size_t)g.kt0 * kstep;
    const char* cA = (const char*)g.A + (size_t)cur.pm * tstepA + koff; const char* cB = (const char*)g.Bt + (size_t)cur.pn * tstepB + koff;
    S.a_ready(cur);
    if constexpr (SP2) {
        PG8_STAGE(PG8_SB(0, 0), cB, voffB); PG8_STAGE(PG8_SB(0, 1), cB + hstepB, voffB); PG8_STAGE(PG8_SA(0, 0), cA, voffA); PG8_STAGE(PG8_SA(0, 1), cA + hstepA, voffA);
        if (wr == 1) PG8_BAR;
        PG8_WAIT_V(2); PG8_BAR;
        PG8_STAGE(PG8_SB(1, 0), cB + kstep, voffB); PG8_STAGE(PG8_SA(1, 0), cA + kstep, voffA); PG8_STAGE(PG8_SB(1, 1), cB + hstepB + kstep, voffB);
        PG8_WAIT_V(6); PG8_BAR;
    } else {
        PG8_STAGE(PG8_SB(0, 0), cB, voffB); PG8_STAGE(PG8_SA(0, 0), cA, voffA); PG8_STAGE(PG8_SB(0, 1), cB + hstepB, voffB); PG8_STAGE(PG8_SA(0, 1), cA + hstepA, voffA);
        if (wr == 1) PG8_BAR;
        PG8_WAIT_V(4); PG8_BAR;
        PG8_STAGE(PG8_SB(1, 0), cB + kstep, voffB); PG8_STAGE(PG8_SA(1, 0), cA + kstep, voffA); PG8_STAGE(PG8_SB(1, 1), cB + hstepB + kstep, voffB);
        PG8_WAIT_V(6); PG8_BAR;
    }
    for (;;) {
        const bool has_next = S.next(ui + 1, nxt);
        const char* nA = has_next ? (const char*)g.A + (size_t)nxt.pm * tstepA + koff : cA; const char* nB = has_next ? (const char*)g.Bt + (size_t)nxt.pn * tstepB + koff : cB;
        for (int t = 0; t < nt; t += 2) {
            const bool last = (t == nt - 2);
            const char* a1 = cA + (size_t)(t + 1) * kstep;
            const char* a2 = last ? nA : cA + (size_t)(t + 2) * kstep; const char* b2 = last ? nB : cB + (size_t)(t + 2) * kstep;
            const char* a3 = a2 + kstep; const char* b3 = b2 + kstep;
            if (last && has_next) S.a_ready(nxt);
            if constexpr (SP2) {
            PG8_LDB(B0, 0, 0); PG8_LDB(B1, 0, 1); PG8_SCHED; PG8_LDA(At, 0, 0); PG8_STAGE(PG8_SA(1, 1), a1 + hstepA, voffA);
            PG8_WAIT_V(8); PG8_WAIT_L(0); PG8_BAR; PG8_MMA(0, 0, At, B0); PG8_MMA(0, 1, At, B1); PG8_BAR; PG8_SCHED;
            PG8_LDA(At, 0, 1); PG8_STAGE(PG8_SB(0, 0), b2, voffB); PG8_STAGE(PG8_SB(0, 1), b2 + hstepB, voffB); PG8_STAGE(PG8_SA(0, 0), a2, voffA);
            PG8_WAIT_V(8); PG8_WAIT_L(0); PG8_BAR; PG8_MMA(1, 0, At, B0); PG8_MMA(1, 1, At, B1); PG8_BAR; PG8_SCHED;
            PG8_LDB(B0, 1, 0); PG8_LDB(B1, 1, 1); PG8_SCHED; PG8_LDA(At, 1, 0); PG8_STAGE(PG8_SA(0, 1), a2 + hstepA, voffA);
            PG8_WAIT_V(8); PG8_WAIT_L(0); PG8_BAR; PG8_MMA(0, 0, At, B0); PG8_MMA(0, 1, At, B1); PG8_BAR; PG8_SCHED;
            PG8_LDA(At, 1, 1); PG8_STAGE(PG8_SB(1, 0), b3, voffB); PG8_STAGE(PG8_SB(1, 1), b3 + hstepB, voffB); PG8_STAGE(PG8_SA(1, 0), a3, voffA);
            PG8_WAIT_V(8); PG8_WAIT_L(0); PG8_BAR; PG8_MMA(1, 0, At, B0); PG8_MMA(1, 1, At, B1); PG8_BAR; PG8_SCHED;
            } else {
            PG8_LDB(B0, 0, 0); PG8_SCHED; PG8_LDA(At, 0, 0); PG8_STAGE(PG8_SA(1, 1), a1 + hstepA, voffA);
            PG8_WAIT_L(8); PG8_BAR; PG8_WAIT_L(0); PG8_MMA(0, 0, At, B0); PG8_BAR; PG8_SCHED;
            PG8_LDB(B1, 0, 1); PG8_STAGE(PG8_SB(0, 0), b2, voffB);
            PG8_BAR; PG8_WAIT_L(0); PG8_MMA(0, 1, At, B1); PG8_BAR;
            PG8_LDA(At, 0, 1); PG8_STAGE(PG8_SA(0, 0), a2, voffA);
            PG8_BAR; PG8_WAIT_L(0); PG8_MMA(1, 0, At, B0); PG8_BAR; PG8_SCHED;
            PG8_STAGE(PG8_SB(0, 1), b2 + hstepB, voffB);
            PG8_WAIT_V(6); PG8_BAR; PG8_MMA(1, 1, At, B1); PG8_BAR;
            PG8_LDB(B0, 1, 0); PG8_SCHED; PG8_LDA(At, 1, 0); PG8_STAGE(PG8_SA(0, 1), a2 + hstepA, voffA);
            PG8_WAIT_L(8); PG8_BAR; PG8_WAIT_L(0); PG8_MMA(0, 0, At, B0); PG8_BAR; PG8_SCHED;
            PG8_LDB(B1, 1, 1); PG8_STAGE(PG8_SB(1, 0), b3, voffB);
            PG8_BAR; PG8_WAIT_L(0); PG8_MMA(0, 1, At, B1); PG8_BAR;
            PG8_LDA(At, 1, 1); PG8_STAGE(PG8_SA(1, 0), a3, voffA);
            PG8_BAR; PG8_WAIT_L(0); PG8_MMA(1, 0, At, B0); PG8_BAR; PG8_SCHED;
            PG8_STAGE(PG8_SB(1, 1), b3 + hstepB, voffB);
            PG8_WAIT_V(6); PG8_BAR; PG8_MMA(1, 1, At, B1); PG8_BAR;
            }
        }
        if constexpr (ALIGN_EPI) { if (wr == 0) PG8_BAR; }
        float tch = 0.f; if constexpr (Epi::TOUCH_NEXT) { if (has_next) tch = E.touch(nxt); }
        if constexpr (!Epi::AFTER_DRAIN) { E(acc, cur, wr, wc, fr, fq); S.done(cur); }
        if constexpr (Epi::TOUCH_NEXT) asm volatile("" :: "v"(tch));
        if (!has_next) break;
#pragma unroll
        for (int a = 0; a < 2; ++a)
#pragma unroll
            for (int b = 0; b < 2; ++b)
#pragma unroll
                for (int m = 0; m < 4; ++m)
#pragma unroll
                    for (int n = 0; n < 2; ++n) acc[a][b][m][n] = (f32x4){0.f, 0.f, 0.f, 0.f};
        cur = nxt; cA = nA; cB = nB; ++ui;
        if constexpr (ALIGN_EPI) { if (wr == 1) PG8_BAR; }
    }
    PG8_WAIT_V(0);
    if constexpr (!ALIGN_EPI) { if (wr == 0) PG8_BAR; }
    PG8_BAR;
    if constexpr (Epi::AFTER_DRAIN) { E.fused(acc, cur, wr, wc, fr, fq, lds, wid, lane); S.done(cur); }
#undef PG8_SA
#undef PG8_SB
#undef PG8_STAGE
#undef PG8_LDA
#undef PG8_LDB
#undef PG8_MMA
#undef PG8_WAIT_V
#undef PG8_WAIT_L
#undef PG8_BAR
#undef PG8_SCHED
}
}

constexpr size_t MiB = 1u << 20;
constexpr size_t WS_CTL = 0, CTL_ZERO_BYTES = 1 * MiB;
constexpr size_t WS_W13A = 1 * MiB;
constexpr size_t WS_W2A = WS_W13A + 46 * MiB;
constexpr size_t WS_WIN = WS_W2A + 22 * MiB;
constexpr size_t WS_WOUT = WS_WIN + 31 * MiB;
constexpr size_t WS_W13B = WS_WOUT + 9 * MiB;
constexpr size_t WS_W2B = WS_W13B + 46 * MiB;
constexpr size_t WS_XB = WS_W2B + 22 * MiB;
constexpr size_t WS_SS = WS_XB + 139 * MiB;
constexpr size_t WS_G = WS_SS + 20 * MiB;
constexpr size_t WS_SSEG = WS_G + 3 * MiB;
constexpr size_t WS_NSEG = WS_SSEG + 1 * MiB;
constexpr size_t WS_RSEG = WS_NSEG + 1 * MiB;
constexpr size_t WS_HU = WS_RSEG + 16 * MiB;
constexpr size_t WS_QA = WS_HU, WS_KA = WS_QA + 65 * MiB, WS_VA = WS_KA + 65 * MiB, WS_QKB = WS_VA + 65 * MiB, WS_VB = WS_QKB + 130 * MiB, WS_OB = WS_VB + 65 * MiB;
constexpr size_t WS_END = WS_OB + 65 * MiB;
static_assert((size_t)MROWS * FF * 2 <= 350 * MiB && (size_t)MROWS * LDX * 2 <= 139 * MiB && (size_t)FF2 * LDW * 2 <= 46 * MiB && (size_t)NINP * LDW * 2 <= 31 * MiB && (size_t)DM * LDW * 2 <= 9 * MiB, "d_ws map");
constexpr int CW_BAR = 4096;

constexpr int RING_OFF = 0, RING_BYTES = 131072;
constexpr int LDS_BYTES = 155648;
constexpr int LDSCTL_OFF = LDS_BYTES - 512, MISC_OFF = LDSCTL_OFF + 320;

#define GAS __attribute__((address_space(1)))
#define LAS __attribute__((address_space(3)))
typedef unsigned short bf16;
typedef unsigned v4u __attribute__((ext_vector_type(4)));
typedef unsigned v2u __attribute__((ext_vector_type(2)));
typedef float f32x4 __attribute__((ext_vector_type(4)));
typedef float f32x16 __attribute__((ext_vector_type(16)));
typedef short bf16x8 __attribute__((ext_vector_type(8)));
typedef short s16x4 __attribute__((ext_vector_type(4)));
typedef GAS unsigned gu32;
#define RLX_AGENT __ATOMIC_RELAXED, __HIP_MEMORY_SCOPE_AGENT
#define LDS_WAIT() asm volatile("s_waitcnt lgkmcnt(0)" ::: "memory")
#define VM_WAIT() asm volatile("s_waitcnt vmcnt(0)" ::: "memory")
__device__ __forceinline__ float bf2f(unsigned short b) { return __uint_as_float((unsigned)b << 16); }
__device__ __forceinline__ unsigned pk2(float lo, float hi) { return pg8::cvt_pk_bf16(lo, hi); }
__device__ __forceinline__ unsigned short f2bf(float f) { return (unsigned short)(pg8::cvt_pk_bf16(f, 0.f) & 0xffffu); }
__device__ __forceinline__ int crow(int r, int hi) { return (r & 3) + 8 * (r >> 2) + 4 * hi; }
__device__ __forceinline__ float wave_sum(float v) {
#pragma unroll
    for (int o = 1; o < 64; o <<= 1) v += __shfl_xor(v, o);
    return v;
}
__device__ __forceinline__ float wave_max(float v) {
#pragma unroll
    for (int o = 1; o < 64; o <<= 1) v = fmaxf(v, __shfl_xor(v, o));
    return v;
}
#define MFMA32(a, b, c) __builtin_amdgcn_mfma_f32_32x32x16_bf16(a, b, c, 0, 0, 0)
__device__ __forceinline__ void halves32(float x, float& lo, float& hi) {
    const auto rr = __builtin_amdgcn_permlane32_swap(__float_as_uint(x), __float_as_uint(x), false, false);
    lo = __uint_as_float(rr[0]); hi = __uint_as_float(rr[1]);
}
__device__ __forceinline__ float sum_halves32(float x) { float lo, hi; halves32(x, lo, hi); return lo + hi; }

#define XB_TMO      128
#define XB_XCNT(j)  (256  + 64 * (j))
#define XB_XSUB(j)  (1280 + 64 * (j))
#define XB_XGEN(j)  (2304 + 64 * (j))
#define XB_TOP      3328
#define XB_TOPGEN   3392
#define XCD_BAR_WORDS 3456
#define XB_SPIN_CAP (1u << 18)

__device__ __forceinline__ unsigned xb_ld(unsigned* p)              { return __hip_atomic_load(p, __ATOMIC_RELAXED, __HIP_MEMORY_SCOPE_AGENT); }
__device__ __forceinline__ unsigned xb_add(unsigned* p, unsigned v) { return __hip_atomic_fetch_add(p, v, __ATOMIC_RELAXED, __HIP_MEMORY_SCOPE_AGENT); }
__device__ __forceinline__ unsigned xb_xcc_id() { return (unsigned)__builtin_amdgcn_s_getreg((3 << 11) | 20) & 0xFu; }
#define XB_SPIN(cond, bar) do { unsigned _sp = 0; while (cond) { __builtin_amdgcn_s_sleep(1); \
    if ((++_sp & 255u) == 0u) { if (xb_ld(&(bar)[XB_TMO])) break; if (_sp > XB_SPIN_CAP) { atomicAdd(&(bar)[XB_TMO], 1u); break; } } } } while (0)

struct XcdBarrier {
    unsigned* bar; unsigned x;
    volatile LAS unsigned* st;
};

__device__ __forceinline__ XcdBarrier xcd_barrier_post(unsigned* bar, volatile LAS unsigned* st) {
    XcdBarrier b; b.bar = bar; b.x = xb_xcc_id(); b.st = st;
    if (threadIdx.x == 0) (void)xb_add(&bar[XB_XCNT(b.x)], 1u);
    return b;
}
__device__ __forceinline__ void xcd_barrier_complete(unsigned* bar, unsigned x, unsigned& nloc, unsigned& nx) {
    const unsigned G = gridDim.x * gridDim.y * gridDim.z;
    unsigned sum, cnt, mine, sp = 0u;
    for (;;) {
        sum = 0u; cnt = 0u; mine = 0u;
#pragma unroll
        for (unsigned j = 0; j < 16; ++j) { const unsigned c = xb_ld(&bar[XB_XCNT(j)]); sum += c; cnt += (c > 0u) ? 1u : 0u; mine = (j == x) ? c : mine; }
        if (sum == G) break;
        __builtin_amdgcn_s_sleep(1);
        if ((++sp & 255u) == 0u) { if (xb_ld(&bar[XB_TMO])) break; if (sp > XB_SPIN_CAP) { atomicAdd(&bar[XB_TMO], 1u); break; } }
    }
    nloc = mine > 0u ? mine : 1u; nx = cnt > 0u ? cnt : 1u;
}

__device__ __forceinline__ void xcd_barrier(const XcdBarrier& b) {
    asm volatile("s_waitcnt vmcnt(0)" ::: "memory");
    __syncthreads();
    if (threadIdx.x == 0) {
        unsigned* bar = b.bar;
        __builtin_amdgcn_s_waitcnt(0);
        unsigned nloc = b.st[0], nx = b.st[1];
        if (nloc == 0u) { xcd_barrier_complete(bar, b.x, nloc, nx); b.st[0] = nloc; b.st[1] = nx; }
        const unsigned old = xb_add(&bar[XB_XSUB(b.x)], 1u);
        const unsigned gen = old / nloc;
        if (old + 1u == (gen + 1u) * nloc) {
            __builtin_amdgcn_fence(__ATOMIC_RELEASE, "agent");
            asm volatile("s_waitcnt vmcnt(0)" ::: "memory");
            const unsigned og = xb_add(&bar[XB_TOP], 1u);
            const unsigned tg = og / nx;
            if (og + 1u == (tg + 1u) * nx) xb_add(&bar[XB_TOPGEN], 1u);
            else XB_SPIN(xb_ld(&bar[XB_TOPGEN]) == tg, bar);
            __builtin_amdgcn_fence(__ATOMIC_ACQUIRE, "agent");
            xb_add(&bar[XB_XGEN(b.x)], 1u);
            asm volatile("s_waitcnt vmcnt(0)" ::: "memory");
        } else {
            XB_SPIN(xb_ld(&bar[XB_XGEN(b.x)]) == gen, bar);
            __builtin_amdgcn_fence(__ATOMIC_ACQUIRE, "agent");
            asm volatile("s_waitcnt vmcnt(0)" ::: "memory");
        }
    }
    __syncthreads();
}

struct Args {
    const float* in[26]; float* out; unsigned char* ws; int ph_lo, ph_hi;
};
enum { I_XP = 0, I_XS, I_CK, I_CV, I_SC, I_SN, I_SM, I_SCONV, I_G1, I_F1W1, I_F1W3, I_F1W2, I_GM, I_WIN, I_BIG, I_BFG, I_CONVW, I_CONVB, I_SBG, I_MLG, I_WOUT, I_G2, I_F2W1, I_F2W3, I_F2W2, I_GF };

struct CvtItem { const float* W; const float* gain; bf16* WT; int N, nKT, dst_row0, k0, n0; };
__device__ __forceinline__ void cvt_load(const CvtItem& d, int lane, f32x4 (&v)[8]) {
    const int r8 = lane >> 3, n = d.n0 + 4 * (lane & 7);
#pragma unroll
    for (int i = 0; i < 8; ++i) { const int kk = 8 * i + r8; f32x4 t = (f32x4){0.f, 0.f, 0.f, 0.f};
        if (n < d.N) t = __builtin_nontemporal_load((const f32x4*)(d.W + (size_t)(d.k0 + kk) * d.N + n));
        if (d.gain) t *= d.gain[d.k0 + kk];
        v[i] = t; }
}
__device__ __forceinline__ void cvt_store(const CvtItem& d, LAS float* scr, int lane, const f32x4 (&v)[8]) {
    const int r8 = lane >> 3, c4 = 4 * (lane & 7);
#pragma unroll
    for (int i = 0; i < 8; ++i) { LAS float* s = scr + (8 * i + r8) * 33 + c4; s[0] = v[i][0]; s[1] = v[i][1]; s[2] = v[i][2]; s[3] = v[i][3]; }
    LDS_WAIT(); asm volatile("" ::: "memory");
    const int c = lane & 7;
#pragma unroll
    for (int j = 0; j < 4; ++j) { const int nn = (lane >> 3) + 8 * j; const LAS float* s = scr + (8 * c) * 33 + nn;
        v4u o; o.x = pk2(s[0 * 33], s[1 * 33]); o.y = pk2(s[2 * 33], s[3 * 33]); o.z = pk2(s[4 * 33], s[5 * 33]); o.w = pk2(s[6 * 33], s[7 * 33]);
        *(GAS v4u*)(d.WT + pg8::tiled_elem_b(d.dst_row0 + nn, d.k0 + 8 * c, d.nKT)) = o; }
    LDS_WAIT(); asm volatile("" ::: "memory");
}
__device__ __forceinline__ CvtItem cvt_item(const Args& a, int part, int it) {
    unsigned char* ws = a.ws;
    constexpr int I_UP = (DM / 64) * (FF / 32);
    constexpr int I_DN = (FF / 64) * (DM / 32);
    constexpr int I_IN = (DM / 64) * (NINP / 32);
    const int n_up = part == 2 ? 0 : 2 * I_UP, n_dn = part == 1 ? 0 : I_DN;
    CvtItem d; int r = it;
    if (r < n_up) {
        const int which = r / I_UP; r -= which * I_UP; const int nblk = FF / 32, kb = r / nblk, nb = r % nblk, n0 = 32 * nb;
        d.W = a.in[part == 0 ? (which == 0 ? I_F1W1 : I_F1W3) : (which == 0 ? I_F2W1 : I_F2W3)]; d.gain = a.in[part == 0 ? I_G1 : I_G2];
        d.WT = (bf16*)(ws + (part == 0 ? WS_W13A : WS_W13B)); d.N = FF; d.nKT = DM / 64; d.dst_row0 = 256 * (n0 / 128) + (n0 % 128) + 128 * which; d.k0 = 64 * kb; d.n0 = n0; return d; }
    r -= n_up;
    if (r < n_dn) { const int nblk = DM / 32, kb = r / nblk, nb = r % nblk;
        d.W = a.in[part ? I_F2W2 : I_F1W2]; d.gain = nullptr; d.WT = (bf16*)(ws + (part ? WS_W2B : WS_W2A)); d.N = DM; d.nKT = FF / 64; d.dst_row0 = 32 * nb; d.k0 = 64 * kb; d.n0 = 32 * nb; return d; }
    r -= n_dn;
    if (r < I_IN) { const int nblk = NINP / 32, kb = r / nblk, nb = r % nblk;
        d.W = a.in[I_WIN]; d.gain = a.in[I_GM]; d.WT = (bf16*)(ws + WS_WIN); d.N = NIN; d.nKT = DM / 64; d.dst_row0 = 32 * nb; d.k0 = 64 * kb; d.n0 = 32 * nb; return d; }
    r -= I_IN; { const int nblk = DM / 32, kb = r / nblk, nb = r % nblk;
        d.W = a.in[I_WOUT]; d.gain = nullptr; d.WT = (bf16*)(ws + WS_WOUT); d.N = DM; d.nKT = DM / 64; d.dst_row0 = 32 * nb; d.k0 = 64 * kb; d.n0 = 32 * nb; return d; }
}
__device__ __forceinline__ void convert_weights(const Args& a, LAS unsigned char* lds, int part, int gw, int NGW, int wave, int lane, int it_lo = 0, int it_hi = 1 << 30) {
    LAS float* scr = (LAS float*)(lds + RING_OFF + wave * 16384);
    constexpr int I_UP = (DM / 64) * (FF / 32), I_DN = (FF / 64) * (DM / 32), I_IN = (DM / 64) * (NINP / 32), I_OUT = (DM / 64) * (DM / 32);
    const int full = (part == 2 ? 0 : 2 * I_UP) + (part == 1 ? 0 : I_DN) + (part == 1 ? I_IN + I_OUT : 0), total = it_hi < full ? it_hi : full;
    int it = it_lo + gw; if (it >= total) return;
    CvtItem d = cvt_item(a, part, it); f32x4 v[8]; cvt_load(d, lane, v);
    for (;;) {
        const int itn = it + NGW; const bool more = itn < total;
        CvtItem dn = d; f32x4 vn[8];
#pragma unroll
        for (int i = 0; i < 8; ++i) vn[i] = v[i];
        if (more) { dn = cvt_item(a, part, itn); cvt_load(dn, lane, vn); }
        cvt_store(d, scr, lane, v);
        if (!more) break;
        d = dn; it = itn;
#pragma unroll
        for (int i = 0; i < 8; ++i) v[i] = vn[i];
    }
}
__device__ __forceinline__ void p0_prologue(const Args& a, LAS unsigned char* lds, int vcu, int G, int wave, int lane) {
    const int gw = vcu * 8 + wave, NGW = G * 8;
    unsigned char* ws = a.ws;
    convert_weights(a, lds, 0, gw, NGW, wave, lane);
    bf16* XB = (bf16*)(ws + WS_XB); float* SS0 = (float*)(ws + WS_SS);
    for (int m = gw; m < MROWS; m += NGW) {
        const float* xrow = (m < MP) ? a.in[I_XP] + (size_t)m * DM : a.in[I_XS] + (size_t)(m - MP) * DM;
        const GAS f32x4* xr = (const GAS f32x4*)xrow + lane;
        f32x4 v[8]; float s = 0.f;
#pragma unroll
        for (int j = 0; j < 8; ++j) { v[j] = __builtin_nontemporal_load(xr + 64 * j); s += (v[j].x * v[j].x + v[j].y * v[j].y) + (v[j].z * v[j].z + v[j].w * v[j].w); }
        s = wave_sum(s);
#pragma unroll
        for (int j = 0; j < 8; ++j) { v2u w; w.x = pk2(v[j].x, v[j].y); w.y = pk2(v[j].z, v[j].w); *(GAS v2u*)(XB + pg8::tiled_elem(m, 4 * lane + 256 * j, DM / 64)) = w; }
        if (lane == 0) SS0[m] = 1.0f / sqrtf(s * (1.0f / DM) + EPS);
    }
}

__device__ __forceinline__ void finalize_rstd(const float* SS, float* RS, int gw, int NGW, int lane, int nrows = MROWS) {
    const int hl = lane & 31, hf = lane >> 5;
    constexpr int NB = 9;
    for (int mb = 2 * gw; mb < nrows; mb += NB * 2 * NGW) {
        float s[NB];
#pragma unroll
        for (int k = 0; k < NB; ++k) { const int m = mb + k * 2 * NGW + hf; s[k] = m < nrows ? SS[(size_t)m * 32 + hl] : 0.f; }
#pragma unroll
        for (int k = 0; k < NB; ++k) {
            const int m = mb + k * 2 * NGW + hf;
            float v = s[k];
#pragma unroll
            for (int o = 1; o < 32; o <<= 1) v += __shfl_xor(v, o);
            if (hl == 0 && m < nrows) RS[m] = 1.0f / sqrtf(v * (1.0f / DM) + EPS);
        }
    }
}

__device__ __forceinline__ void final_norm_sample_rows(const Args& a, const float* PART, int gw, int NGW, int lane) {
    const bf16* XB = (const bf16*)(a.ws + WS_XB); const float* gf = a.in[I_GF];
    for (int r = gw; r < MS; r += NGW) {
        const int m = MP + r;
        pg8::f32x4 v[4][2]; float ss = 0.f;
#pragma unroll
        for (int j = 0; j < 4; ++j) {
            const int col = 8 * lane + 512 * j;
            const v4u w = *(const v4u*)(XB + pg8::tiled_elem(m, col, DM / 64));
            const float* p = PART + (size_t)r * DM + col;
            const pg8::f32x4 s0 = *(const pg8::f32x4*)p + *(const pg8::f32x4*)(p + (size_t)MS * DM), s1 = *(const pg8::f32x4*)(p + 4) + *(const pg8::f32x4*)(p + 4 + (size_t)MS * DM);
            v[j][0] = pg8::bf_lo4(w.x, w.y) + s0 * 0.5f; v[j][1] = pg8::bf_lo4(w.z, w.w) + s1 * 0.5f;
#pragma unroll
            for (int e = 0; e < 4; ++e) ss += v[j][0][e] * v[j][0][e] + v[j][1][e] * v[j][1][e];
        }
        const float rstd = 1.0f / sqrtf(wave_sum(ss) * (1.0f / DM) + EPS);
        float* yr = a.out + O_Y + (size_t)m * DM + 8 * lane;
#pragma unroll
        for (int j = 0; j < 4; ++j) { const pg8::f32x4 g0 = *(const pg8::f32x4*)(gf + 8 * lane + 512 * j), g1 = *(const pg8::f32x4*)(gf + 8 * lane + 512 * j + 4);
            *(pg8::f32x4*)(yr + 512 * j) = v[j][0] * rstd * g0; *(pg8::f32x4*)(yr + 512 * j + 4) = v[j][1] * rstd * g1; }
    }
}

template <int NS> __device__ __forceinline__ void reduce_sample_rows(const Args& a, const float* PART, float scale, float* RS, int gw, int NGW, int lane) {
    bf16* XB = (bf16*)(a.ws + WS_XB);
    for (int r = gw; r < MS; r += NGW) {
        const int m = MP + r;
        pg8::f32x4 v[4][2]; float ss = 0.f;
#pragma unroll
        for (int j = 0; j < 4; ++j) {
            const int col = 8 * lane + 512 * j;
            const v4u w = *(const v4u*)(XB + pg8::tiled_elem(m, col, DM / 64));
            const float* p = PART + (size_t)r * DM + col;
            pg8::f32x4 s0 = *(const pg8::f32x4*)p, s1 = *(const pg8::f32x4*)(p + 4);
#pragma unroll
            for (int q = 1; q < NS; ++q) { s0 += *(const pg8::f32x4*)(p + (size_t)q * MS * DM); s1 += *(const pg8::f32x4*)(p + 4 + (size_t)q * MS * DM); }
            v[j][0] = pg8::bf_lo4(w.x, w.y) + s0 * scale; v[j][1] = pg8::bf_lo4(w.z, w.w) + s1 * scale;
#pragma unroll
            for (int e = 0; e < 4; ++e) ss += v[j][0][e] * v[j][0][e] + v[j][1][e] * v[j][1][e];
        }
        const float rstd = 1.0f / sqrtf(wave_sum(ss) * (1.0f / DM) + EPS);
#pragma unroll
        for (int j = 0; j < 4; ++j) *(pg8::u32x4*)(XB + pg8::tiled_elem(m, 8 * lane + 512 * j, DM / 64)) = pg8::pack8(v[j][0], v[j][1]);
        if (lane == 0) RS[m] = rstd;
    }
}

constexpr float CP_EXIT = 8.8817841970012523e-16f;
constexpr int KS_PITCH = 272;
__device__ __forceinline__ float ex2(float x) { return __builtin_amdgcn_exp2f(x); }
__device__ __forceinline__ void sb_tile(f32x16& p0, f32x16& p1, float& cp, bool diag, int kv0, int qpos, int hh) {
    float om0[16], om1[16];
#pragma unroll
    for (int i = 0; i < 16; ++i) {
        { const float E = ex2(fminf(p0[i], 60.f)), rr = __builtin_amdgcn_rcpf(1.f + E); om0[i] = rr; p0[i] = E * rr; }
        { const float E = ex2(fminf(p1[i], 60.f)), rr = __builtin_amdgcn_rcpf(1.f + E); om1[i] = rr; p1[i] = E * rr; }
    }
    if (diag) {
        int rel = qpos - kv0 - 4 * hh; asm volatile("" : "+v"(rel));
#pragma unroll
        for (int i = 0; i < 16; ++i) { const int kvr = (i & 3) + 8 * (i >> 2);
            if (kvr >= rel) { om0[i] = 1.f; p0[i] = 0.f; }
            if (kvr + 32 >= rel) { om1[i] = 1.f; p1[i] = 0.f; } }
    }
    float gp[8], pp[8], T[8], E[8];
#pragma unroll
    for (int g = 0; g < 4; ++g) { gp[g] = (om0[4 * g] * om0[4 * g + 1]) * (om0[4 * g + 2] * om0[4 * g + 3]); gp[4 + g] = (om1[4 * g] * om1[4 * g + 1]) * (om1[4 * g + 2] * om1[4 * g + 3]); }
#pragma unroll
    for (int o = 0; o < 8; ++o) { float lo, hi; halves32(gp[o], lo, hi); pp[o] = hh == 0 ? hi : lo; T[o] = lo * hi; }
    E[7] = cp;
#pragma unroll
    for (int o = 6; o >= 0; --o) E[o] = E[o + 1] * T[o + 1];
    cp = E[0] * T[0];
#pragma unroll
    for (int g = 0; g < 4; ++g) {
        { const float off = E[g] * (hh == 0 ? pp[g] : 1.f); const float s3 = off, s2 = s3 * om0[4 * g + 3], s1 = s2 * om0[4 * g + 2], s0 = s1 * om0[4 * g + 1];
          p0[4 * g + 3] *= s3; p0[4 * g + 2] *= s2; p0[4 * g + 1] *= s1; p0[4 * g] *= s0; }
        { const float off = E[4 + g] * (hh == 0 ? pp[4 + g] : 1.f); const float s3 = off, s2 = s3 * om1[4 * g + 3], s1 = s2 * om1[4 * g + 2], s0 = s1 * om1[4 * g + 1];
          p1[4 * g + 3] *= s3; p1[4 * g + 2] *= s2; p1[4 * g + 1] *= s1; p1[4 * g] *= s0; }
    }
}
__device__ __forceinline__ bf16x8 pack_frag(const f32x16& p, int half) {
    v4u w; w.x = pk2(p[8 * half + 0], p[8 * half + 1]); w.y = pk2(p[8 * half + 2], p[8 * half + 3]); w.z = pk2(p[8 * half + 4], p[8 * half + 5]); w.w = pk2(p[8 * half + 6], p[8 * half + 7]);
    return __builtin_bit_cast(bf16x8, w);
}
constexpr int RP = 320;
__device__ __forceinline__ s16x4 trd(const LAS unsigned char* blk, int pitch, int lane) {
    typedef short v4i16_t __attribute__((ext_vector_type(4)));
    const int i = lane & 15;
    return __builtin_bit_cast(s16x4, __builtin_amdgcn_ds_read_tr16_b64_v4i16((LAS v4i16_t*)(blk + (i >> 2) * pitch + 8 * (i & 3))));
}
__device__ __forceinline__ bf16x8 tr_frag(const LAS unsigned char* tile, int ra, int rb, int cbase, int lane) {
    const int g = (lane >> 4) & 1;
    const s16x4 lo = trd(tile + ra * RP + (cbase + 16 * g) * 2, RP, lane), hi = trd(tile + rb * RP + (cbase + 16 * g) * 2, RP, lane);
    return (bf16x8){lo[0], lo[1], lo[2], lo[3], hi[0], hi[1], hi[2], hi[3]};
}
__device__ __forceinline__ void attn_prompt_pair(const Args& a, LAS unsigned char* lds, int b, int h, int j, int tid, int wave, int lane, int pnext = -1) {
    const bf16* QA = (const bf16*)(a.ws + WS_QA); const bf16* KA = (const bf16*)(a.ws + WS_KA); const bf16* VA = (const bf16*)(a.ws + WS_VA);
    float tq = 0.f, tk = 0.f, tv = 0.f;
    if (pnext >= 0) { const int bhn = pnext >> 5, jn = pnext & 31; const size_t off = ((size_t)(bhn >> 3) * TP + jn * 256 + (tid >> 1)) * GW + (bhn & 7) * HD + (tid & 1) * 64;
        tq = *(const float*)(QA + off); tk = *(const float*)(KA + off); tv = *(const float*)(VA + off); }
    bf16* MRG = (bf16*)(a.out + O_Y);
    const int r = lane & 31, hh = lane >> 5, half = wave >> 2, hw = wave & 3;
    const int t0w = (2 * j + half) * 128 + hw * 32;
    const size_t mrow = (size_t)b * TP + t0w + r;
    f32x16 o[4];
#pragma unroll
    for (int k = 0; k < 4; ++k)
#pragma unroll
        for (int i = 0; i < 16; ++i) o[k][i] = 0.f;
    float cp = 1.f;
    constexpr int ABUF = 64 * KS_PITCH + 64 * RP + 128 * KS_PITCH;
    LAS unsigned char* Ks = lds + half * ABUF; LAS unsigned char* VS = Ks + 64 * KS_PITCH; LAS unsigned char* QS = VS + 64 * RP;
    static_assert(2 * ABUF + 64 <= LDSCTL_OFF, "attention LDS");
    LAS unsigned* DONE = (LAS unsigned*)(lds + 2 * ABUF);
    bool wdone = false;
    const int htid = tid & 255, srow = htid >> 4, sc8 = htid & 15;
    {
        const bf16* qg = QA + ((size_t)b * TP + (2 * j + half) * 128 + srow) * GW + h * HD + 8 * sc8;
#pragma unroll
        for (int i = 0; i < 8; ++i) *(LAS v4u*)(QS + (srow + 16 * i) * KS_PITCH + 16 * sc8) = *(const v4u*)(qg + (size_t)(16 * i) * GW);
    }
    const LAS unsigned char* qrow = QS + (hw * 32 + r) * KS_PITCH + hh * 16;
    const bf16* kg = KA + ((size_t)b * TP + srow) * GW + h * HD + 8 * sc8; const bf16* vg = VA + ((size_t)b * TP + srow) * GW + h * HD + 8 * sc8;
    v4u pk[4], pv[4];
    { const int jt0 = 2 * (2 * j + half) + 1;
#pragma unroll
      for (int i = 0; i < 4; ++i) { pk[i] = *(const v4u*)(kg + (size_t)(64 * jt0 + 16 * i) * GW); pv[i] = *(const v4u*)(vg + (size_t)(64 * jt0 + 16 * i) * GW); } }
    for (int jt = 2 * (2 * j + half) + 1;; --jt) {
        if (jt < 0) wdone = true;
        if (lane == 0) DONE[wave] = wdone ? 1u : 0u;
        __syncthreads();
        { const v4u d0 = *(const LAS v4u*)DONE, d1 = *(const LAS v4u*)(DONE + 4); if ((d0.x & d0.y & d0.z & d0.w & d1.x & d1.y & d1.z & d1.w) != 0u) break; }
        if (jt >= 0) {
            LAS unsigned char* kd = Ks + srow * KS_PITCH + 16 * sc8; LAS unsigned char* vd = VS + srow * RP + 16 * sc8;
#pragma unroll
            for (int i = 0; i < 4; ++i) { *(LAS v4u*)(kd + 16 * i * KS_PITCH) = pk[i]; *(LAS v4u*)(vd + 16 * i * RP) = pv[i]; }
        }
        if (jt >= 1) {
#pragma unroll
            for (int i = 0; i < 4; ++i) { pk[i] = *(const v4u*)(kg + (size_t)(64 * (jt - 1) + 16 * i) * GW); pv[i] = *(const v4u*)(vg + (size_t)(64 * (jt - 1) + 16 * i) * GW); }
        }
        __syncthreads();
        if (!wdone && 64 * jt <= t0w + 30) {
            f32x16 p0, p1;
#pragma unroll
            for (int i = 0; i < 16; ++i) { p0[i] = 0.f; p1[i] = 0.f; }
#pragma unroll
            for (int ks = 0; ks < 8; ++ks) {
                const bf16x8 k0 = *(const LAS bf16x8*)(Ks + r * KS_PITCH + (ks * 16 + hh * 8) * 2);
                const bf16x8 k1 = *(const LAS bf16x8*)(Ks + (32 + r) * KS_PITCH + (ks * 16 + hh * 8) * 2);
                const bf16x8 qf = *(const LAS bf16x8*)(qrow + ks * 32);
                p0 = MFMA32(k0, qf, p0); p1 = MFMA32(k1, qf, p1);
            }
            sb_tile(p0, p1, cp, 64 * jt + 63 >= t0w, 64 * jt, t0w + r, hh);
            bf16x8 af[4]; af[0] = pack_frag(p0, 0); af[1] = pack_frag(p0, 1); af[2] = pack_frag(p1, 0); af[3] = pack_frag(p1, 1);
#pragma unroll
            for (int blk = 0; blk < 4; ++blk)
#pragma unroll
                for (int s = 0; s < 4; ++s) {
                    o[blk] = MFMA32(tr_frag(VS, 16 * s + 4 * hh, 16 * s + 8 + 4 * hh, 32 * blk, lane), af[s], o[blk]);
                }
            wdone = __ballot(cp >= CP_EXIT) == 0ull;
        }
    }
    asm volatile("" :: "v"(tq), "v"(tk), "v"(tv));
    __syncthreads();
    float ss = 0.f;
#pragma unroll
    for (int k = 0; k < 4; ++k)
#pragma unroll
        for (int i = 0; i < 16; ++i) ss += o[k][i] * o[k][i];
    ss = sum_halves32(ss);
    const float rstd = 1.0f / sqrtf(ss * (1.0f / 128.0f) + EPS);
    const float* sbg = a.in[I_SBG] + h * HD;
#pragma unroll
    for (int k = 0; k < 4; ++k)
#pragma unroll
        for (int g = 0; g < 4; ++g) { const int d = 32 * k + 8 * g + 4 * hh; const f32x4 gv = *(const f32x4*)(sbg + d);
            v2u w; w.x = pk2(o[k][4 * g] * rstd * gv[0], o[k][4 * g + 1] * rstd * gv[1]); w.y = pk2(o[k][4 * g + 2] * rstd * gv[2], o[k][4 * g + 3] * rstd * gv[3]);
            *(v2u*)(MRG + pg8::tiled_elem((int)mrow, h * HD + d, DM / 64)) = w; }
}
__device__ __forceinline__ void attn_prompt_phase(const Args& a, LAS unsigned char* lds, int vcu, int G, int tid, int wave, int lane) {
    for (int p = vcu; p < NBP * NH * (TP / 256); p += G) {
        const int bh = p >> 5, j = p & 31;
        attn_prompt_pair(a, lds, bh >> 3, bh & 7, j, tid, wave, lane, p + G < NBP * NH * (TP / 256) ? p + G : -1);
    }
}

constexpr int SEGK = 128;
__device__ __forceinline__ void attn_sample_unit(const Args& a, LAS unsigned char* lds, int b, int h, int tid, int wave, int lane) {
    LAS float* Qs = (LAS float*)lds;
    LAS float* OM = (LAS float*)(lds + 8192);
    LAS float* BT = (LAS float*)(lds + 16384);
    LAS float* RED = (LAS float*)(lds + 24576);
    LAS float* CAR = (LAS float*)(lds + 24576 + 256);
    const bf16* QA = (const bf16*)(a.ws + WS_QA); bf16* MRG = (bf16*)(a.out + O_Y);
    __syncthreads();
    for (int i = tid; i < 16 * 128; i += 512) { const int q = i >> 7, d = i & 127; Qs[i] = bf2f(QA[(size_t)(MP + b * TS + q) * GW + h * HD + d]); }
    __syncthreads();
    const int dch = tid & 127, qg = tid >> 7;
    float oacc[4] = {0.f, 0.f, 0.f, 0.f};
    float carry0 = 1.f, carry1 = 1.f;
    for (int seg = 0; seg <= PAST / SEGK; ++seg) {
        const bool isnew = seg == 0; const int seglen = isnew ? TS : SEGK, kstart = isnew ? 0 : PAST - seg * SEGK;
        {
            float om[4] = {1.f, 1.f, 1.f, 1.f}, bt[4] = {0.f, 0.f, 0.f, 0.f};
            if (dch < seglen) {
                const float* krow = isnew ? a.out + O_KS + ((size_t)(b * TS + dch) * NH + h) * HD : a.in[I_CK] + (((size_t)b * PAST + kstart + dch) * NH + h) * HD;
                float z[4] = {0.f, 0.f, 0.f, 0.f};
#pragma unroll 8
                for (int d4 = 0; d4 < 32; ++d4) { const f32x4 kv = *(const f32x4*)(krow + 4 * d4);
#pragma unroll
                    for (int q = 0; q < 4; ++q) { const f32x4 qv = *(const LAS f32x4*)(Qs + (4 * qg + q) * 128 + 4 * d4); z[q] += (kv[0] * qv[0] + kv[1] * qv[1]) + (kv[2] * qv[2] + kv[3] * qv[3]); } }
#pragma unroll
                for (int q = 0; q < 4; ++q) { const float E = ex2(fminf(z[q], 60.f)), rr = __builtin_amdgcn_rcpf(1.f + E); om[q] = rr; bt[q] = E * rr;
                    if (isnew && dch >= 4 * qg + q) { om[q] = 1.f; bt[q] = 0.f; } }
            }
#pragma unroll
            for (int q = 0; q < 4; ++q) { OM[(4 * qg + q) * SEGK + dch] = om[q]; BT[(4 * qg + q) * SEGK + dch] = bt[q]; }
        }
        __syncthreads();
#pragma unroll
        for (int rr2 = 0; rr2 < 2; ++rr2) { const int q = 2 * wave + rr2; float& carry = rr2 ? carry1 : carry0;
            const float om0 = OM[q * SEGK + 2 * lane], om1 = OM[q * SEGK + 2 * lane + 1], bt0 = BT[q * SEGK + 2 * lane], bt1 = BT[q * SEGK + 2 * lane + 1];
            float inc = om0 * om1;
#pragma unroll
            for (int off = 1; off < 64; off <<= 1) { const float v = __shfl_down(inc, off); if (lane + off < 64) inc *= v; }
            float exc = __shfl_down(inc, 1); if (lane == 63) exc = 1.f;
            const float suf = carry * exc;
            BT[q * SEGK + 2 * lane + 1] = bt1 * suf; BT[q * SEGK + 2 * lane] = bt0 * suf * om1;
            carry = carry * __shfl(inc, 0);
            if (lane == 0) CAR[q] = carry;
        }
        __syncthreads();
        {
            const float* vbase = isnew ? a.out + O_VS + ((size_t)(b * TS) * NH + h) * HD + dch : a.in[I_CV] + (((size_t)b * PAST + kstart) * NH + h) * HD + dch;
            for (int k4 = 0; k4 < seglen; k4 += 4) {
                float v[4];
#pragma unroll
                for (int e = 0; e < 4; ++e) v[e] = vbase[(size_t)(k4 + e) * (NH * HD)];
#pragma unroll
                for (int i = 0; i < 4; ++i) { const f32x4 aw = *(const LAS f32x4*)(BT + (4 * qg + i) * SEGK + k4); oacc[i] += (aw[0] * v[0] + aw[1] * v[1]) + (aw[2] * v[2] + aw[3] * v[3]); }
            }
        }
        float cmax = 0.f;
#pragma unroll
        for (int q4 = 0; q4 < 4; ++q4) { const f32x4 cv = *(const LAS f32x4*)(CAR + 4 * q4); cmax = fmaxf(fmaxf(cmax, fmaxf(cv[0], cv[1])), fmaxf(cv[2], cv[3])); }
        __syncthreads();
        if (cmax < CP_EXIT) break;
    }
#pragma unroll
    for (int i = 0; i < 4; ++i) { const float s = wave_sum(oacc[i] * oacc[i]); if (lane == 0) RED[(4 * qg + i) * 4 + (wave & 1)] = s; }
    __syncthreads();
    const float gsb = a.in[I_SBG][h * HD + dch];
#pragma unroll
    for (int i = 0; i < 4; ++i) { const int q = 4 * qg + i; const float ss = RED[q * 4] + RED[q * 4 + 1]; const float rstd = 1.0f / sqrtf(ss * (1.0f / 128.0f) + EPS);
        MRG[pg8::tiled_elem(MP + b * TS + q, h * HD + dch, DM / 64)] = f2bf(oacc[i] * rstd * gsb); }
}

constexpr int SEGC = 16, NSEGB = (TP / 64) / SEGC, NSEGP = NBP * NH * NSEGB;
constexpr int C0_PITCH = 272;
typedef float f32x2v __attribute__((ext_vector_type(2)));
constexpr int ML_QS = 0, ML_KS = 17408, ML_KT = 34816  , ML_VT = ML_KT + 64 * RP  , ML_C0 = 76288, ML_CWL = 119808, ML_PS = 127520, ML_MLG = 128544, ML_NST = 129056  ;
constexpr int ML_TAB = 132096, TAB_GS = ML_TAB, TAB_CM = ML_TAB + 4096, TAB_BS = ML_TAB + 8192, TAB_WA = ML_TAB + 12288, TAB_SC = ML_TAB + 16384, TAB_M = TAB_SC + 256, ML_TAB_END = TAB_M + 128;
static_assert(ML_TAB >= RING_BYTES && ML_TAB_END <= LDSCTL_OFF, "mLSTM gate tables");
static_assert(ML_VT + 64 * RP <= ML_C0 && ML_C0 + 2 * 64 * RP <= ML_CWL && ML_NST + 512 <= RING_BYTES, "mLSTM LDS map");

struct MUnit { int b, h, nvalid, nch, samp, sid, sg, t0; size_t row0; };
__device__ __forceinline__ MUnit munit_prompt(int seg) { MUnit u; const int bh = seg / NSEGB; u.sg = seg % NSEGB; u.b = bh >> 3; u.h = bh & 7; u.nvalid = 64; u.nch = SEGC; u.samp = 0; u.sid = seg;
    u.t0 = u.sg * SEGC * 64; u.row0 = (size_t)u.b * TP + u.t0; return u; }
__device__ __forceinline__ MUnit munit_sample(int sid) { MUnit u; u.b = sid >> 3; u.h = sid & 7; u.sg = 0; u.nvalid = TS; u.nch = 1; u.samp = 1; u.sid = sid; u.t0 = 0; u.row0 = (size_t)MP + u.b * TS; return u; }

__device__ __forceinline__ void unpack8(const v4u w, float (&x)[8]) {
    x[0] = __uint_as_float(w.x << 16); x[1] = __uint_as_float(w.x & 0xffff0000u); x[2] = __uint_as_float(w.y << 16); x[3] = __uint_as_float(w.y & 0xffff0000u);
    x[4] = __uint_as_float(w.z << 16); x[5] = __uint_as_float(w.z & 0xffff0000u); x[6] = __uint_as_float(w.w << 16); x[7] = __uint_as_float(w.w & 0xffff0000u);
}
__device__ __forceinline__ void load_taps(const bf16* src, int tpos, v4u (&raw)[5]) {
#pragma unroll
    for (int j = 0; j < 5; ++j) { raw[j] = (v4u){0u, 0u, 0u, 0u}; if (tpos + j - 3 >= 0) raw[j] = *(const v4u*)(src + (long)(j - 3) * 2048); }
}
__device__ __forceinline__ void conv8x2(const v4u (&raw)[5], int tpos  , bool samp, const float* hist  , const LAS float* cwl  ,
                                        float sc, float (&o0)[8], float (&o1)[8], float (&x3)[8], float (&x4)[8]) {
    float x[5][8];
#pragma unroll
    for (int j = 0; j < 5; ++j) {
        const int tt = tpos + j - 3;
        unpack8(raw[j], x[j]);
        if (tt < 0 && samp) { const float* sp = hist + (size_t)(3 + tt) * 2048; const f32x4 s0 = *(const f32x4*)sp, s1 = *(const f32x4*)(sp + 4); x[j][0] = s0[0]; x[j][1] = s0[1]; x[j][2] = s0[2]; x[j][3] = s0[3]; x[j][4] = s1[0]; x[j][5] = s1[1]; x[j][6] = s1[2]; x[j][7] = s1[3]; }
    }
    { const f32x4 b0 = *(const LAS f32x4*)(cwl + 4 * 128), b1 = *(const LAS f32x4*)(cwl + 4 * 128 + 4);
#pragma unroll
      for (int e = 0; e < 4; ++e) { o0[e] = b0[e]; o0[4 + e] = b1[e]; o1[e] = b0[e]; o1[4 + e] = b1[e]; } }
#pragma unroll
    for (int j = 0; j < 4; ++j) { const f32x4 w0 = *(const LAS f32x4*)(cwl + j * 128), w1 = *(const LAS f32x4*)(cwl + j * 128 + 4);
#pragma unroll
        for (int e = 0; e < 4; ++e) { o0[e] += w0[e] * x[j][e]; o0[4 + e] += w1[e] * x[j][4 + e]; o1[e] += w0[e] * x[j + 1][e]; o1[4 + e] += w1[e] * x[j + 1][4 + e]; } }
#pragma unroll
    for (int e = 0; e < 8; ++e) { o0[e] = o0[e] * pg8::sigmoid_f(o0[e]) * sc; o1[e] = o1[e] * pg8::sigmoid_f(o1[e]) * sc; x3[e] = x[3][e]; x4[e] = x[4][e]; }
}
__device__ __forceinline__ v4u pack8f(const float (&v)[8]) { v4u w; w.x = pk2(v[0], v[1]); w.y = pk2(v[2], v[3]); w.z = pk2(v[4], v[5]); w.w = pk2(v[6], v[7]); return w; }
__device__ __forceinline__ v4u pack8fs(const float (&v)[8], float s) { v4u w; w.x = pk2(v[0] * s, v[1] * s); w.y = pk2(v[2] * s, v[3] * s); w.z = pk2(v[4] * s, v[5] * s); w.w = pk2(v[6] * s, v[7] * s); return w; }
template <bool OUT> __device__ __forceinline__ void stage_chunk(const Args& a, LAS unsigned char* lds, const MUnit& u, int c, int wkoff, int tid) {
    const LAS float* WA = (const LAS float*)(lds + TAB_WA) + 64 * c;
    const bf16* QKB = (const bf16*)(a.ws + WS_QKB); const bf16* VB = (const bf16*)(a.ws + WS_VB);
    const size_t rowc = u.row0 + 64 * c; const int tc = u.t0 + 64 * c;
    const int c8 = tid & 15, s0 = 2 * (tid >> 4);
    const LAS float* cwq = (const LAS float*)(lds + ML_CWL) + 8 * c8; const LAS float* cwk = cwq + 5 * 128;
    const float* histq = a.in[I_SCONV] + (size_t)u.b * 3 * 2048 + u.h * HD + 8 * c8; const float* histk = histq + 1024;
    const bool lastchunk = OUT && (u.samp || (u.sg == NSEGB - 1 && c == SEGC - 1));
    const v4u z4 = (v4u){0u, 0u, 0u, 0u};
    const bool valid = s0 < u.nvalid;
    LAS unsigned char* qsb = lds + ML_QS + s0 * KS_PITCH + 16 * c8;
    LAS unsigned char* wkb = lds + wkoff + s0 * RP + 16 * c8;
    float* ob = a.out + (u.samp ? O_CVS : O_CVP) + (size_t)u.b * 3 * 2048 + u.h * HD + 8 * c8;
    const bool w0 = lastchunk && s0 >= u.nvalid - 3, w1 = lastchunk && s0 + 1 >= u.nvalid - 3;
    v4u rk[5], rq[5], v0 = z4, v1 = z4;
#pragma unroll
    for (int j = 0; j < 5; ++j) { rk[j] = z4; rq[j] = z4; }
    if (valid) {
        load_taps(QKB + (rowc + s0) * 2048 + 1024 + u.h * HD + 8 * c8, tc + s0, rk);
        if (OUT) load_taps(QKB + (rowc + s0) * 2048 + u.h * HD + 8 * c8, tc + s0, rq);
        v0 = *(const v4u*)(VB + (rowc + s0) * GW + u.h * HD + 8 * c8); v1 = *(const v4u*)(VB + (rowc + s0 + 1) * GW + u.h * HD + 8 * c8);
    }
    {
        v4u k0 = z4, k1 = z4, wk0 = z4, wk1 = z4;
        if (valid) { float o0[8], o1[8], x3[8], x4[8];
            conv8x2(rk, tc + s0, u.samp != 0, histk, cwk, KSCALE, o0, o1, x3, x4);
            wk0 = pack8fs(o0, WA[s0]); wk1 = pack8fs(o1, WA[s0 + 1]);
            if (OUT) { k0 = pack8f(o0); k1 = pack8f(o1);
                if (w0) { float* o = ob + (size_t)(s0 - (u.nvalid - 3)) * 2048 + 1024; *(f32x4*)o = (f32x4){x3[0], x3[1], x3[2], x3[3]}; *(f32x4*)(o + 4) = (f32x4){x3[4], x3[5], x3[6], x3[7]}; }
                if (w1) { float* o = ob + (size_t)(s0 + 1 - (u.nvalid - 3)) * 2048 + 1024; *(f32x4*)o = (f32x4){x4[0], x4[1], x4[2], x4[3]}; *(f32x4*)(o + 4) = (f32x4){x4[4], x4[5], x4[6], x4[7]}; } } }
        if (OUT) { *(LAS v4u*)(qsb + (ML_KS - ML_QS)) = k0; *(LAS v4u*)(qsb + (ML_KS - ML_QS) + KS_PITCH) = k1; }
        *(LAS v4u*)wkb = wk0; *(LAS v4u*)(wkb + RP) = wk1;
        *(LAS v4u*)(wkb + 64 * RP) = v0; *(LAS v4u*)(wkb + 64 * RP + RP) = v1;
    }
    if (OUT) {
        __builtin_amdgcn_sched_barrier(0);
        v4u q0 = z4, q1 = z4;
        if (valid) { float o0[8], o1[8], x3[8], x4[8];
            conv8x2(rq, tc + s0, u.samp != 0, histq, cwq, 1.0f, o0, o1, x3, x4);
            q0 = pack8f(o0); q1 = pack8f(o1);
            if (w0) { float* o = ob + (size_t)(s0 - (u.nvalid - 3)) * 2048; *(f32x4*)o = (f32x4){x3[0], x3[1], x3[2], x3[3]}; *(f32x4*)(o + 4) = (f32x4){x3[4], x3[5], x3[6], x3[7]}; }
            if (w1) { float* o = ob + (size_t)(s0 + 1 - (u.nvalid - 3)) * 2048; *(f32x4*)o = (f32x4){x4[0], x4[1], x4[2], x4[3]}; *(f32x4*)(o + 4) = (f32x4){x4[4], x4[5], x4[6], x4[7]}; } }
        *(LAS v4u*)qsb = q0; *(LAS v4u*)(qsb + KS_PITCH) = q1;
    }
}
__device__ __forceinline__ void load_kv(const Args& a, const MUnit& u, int c, int tid, v4u (&t)[7]) {
    const bf16* QKB = (const bf16*)(a.ws + WS_QKB); const bf16* VB = (const bf16*)(a.ws + WS_VB);
    const size_t rowc = u.row0 + 64 * c; const int tc = u.t0 + 64 * c;
    const int c8 = tid & 15, s0 = 2 * (tid >> 4);
    v4u rk[5]; load_taps(QKB + (rowc + s0) * 2048 + 1024 + u.h * HD + 8 * c8, tc + s0, rk);
#pragma unroll
    for (int j = 0; j < 5; ++j) t[j] = rk[j];
    t[5] = *(const v4u*)(VB + (rowc + s0) * GW + u.h * HD + 8 * c8); t[6] = *(const v4u*)(VB + (rowc + s0 + 1) * GW + u.h * HD + 8 * c8);
}
__device__ __forceinline__ void process_kv(const Args& a, LAS unsigned char* lds, const MUnit& u, int c, int wkoff, int tid, const v4u (&t)[7]) {
    const LAS float* WA = (const LAS float*)(lds + TAB_WA) + 64 * c;
    const int tc = u.t0 + 64 * c, c8 = tid & 15, s0 = 2 * (tid >> 4);
    const LAS float* cwk = (const LAS float*)(lds + ML_CWL) + 8 * c8 + 5 * 128;
    const float* histk = a.in[I_SCONV] + (size_t)u.b * 3 * 2048 + u.h * HD + 8 * c8 + 1024;
    v4u rk[5];
#pragma unroll
    for (int j = 0; j < 5; ++j) rk[j] = t[j];
    float o0[8], o1[8], x3[8], x4[8];
    conv8x2(rk, tc + s0, u.samp != 0, histk, cwk, KSCALE, o0, o1, x3, x4);
    LAS unsigned char* wkb = lds + wkoff + s0 * RP + 16 * c8;
    *(LAS v4u*)wkb = pack8fs(o0, WA[s0]); *(LAS v4u*)(wkb + RP) = pack8fs(o1, WA[s0 + 1]);
    *(LAS v4u*)(wkb + 64 * RP) = t[5]; *(LAS v4u*)(wkb + 64 * RP + RP) = t[6];
}
__device__ __forceinline__ void munit_setup(const Args& a, LAS unsigned char* lds, const MUnit& u, int tid, bool both  ) {
    LAS float* cwl = (LAS float*)(lds + ML_CWL);
    for (int i = tid; i < 2 * 5 * 128; i += 512) { const int qk = i / 640, j = (i % 640) >> 7, d = i & 127;
        cwl[i] = j < 4 ? a.in[I_CONVW][(size_t)j * 2048 + qk * 1024 + u.h * HD + d] : a.in[I_CONVB][qk * 1024 + u.h * HD + d]; }
    for (int i = tid; i < 64 * 4; i += 512) { const int row = i >> 2, q = i & 3; const v4u w = (v4u){q == 0 ? 0x3f80u : 0u, 0u, 0u, 0u};
        *(LAS v4u*)(lds + ML_VT + row * RP + 256 + 16 * q) = w; if (both) *(LAS v4u*)(lds + ML_C0 + 64 * RP + row * RP + 256 + 16 * q) = w; }
    if (tid < 128) ((LAS float*)(lds + ML_MLG))[tid] = a.in[I_MLG][u.h * HD + tid];
}
__device__ __forceinline__ float lane_read(float v, int src) { return __int_as_float(__builtin_amdgcn_ds_bpermute(src << 2, __float_as_int(v))); }
__device__ __forceinline__ void chunk_gates(const float* G, size_t rowc, int nvalid, int h, int lane, float& bs, float& gs, float& Btot, float& Gmax) {
    float ig = -INFINITY, lf = 0.f;
    if (lane < nvalid) { ig = G[(rowc + lane) * 16 + h]; lf = G[(rowc + lane) * 16 + 8 + h]; }
    float x = lf;
#pragma unroll
    for (int off = 1; off < 64; off <<= 1) { const float v = lane_read(x, lane >= off ? lane - off : lane); if (lane >= off) x += v; }
    bs = x; gs = ig - x; Btot = lane_read(x, 63 | (lane & 0));
    float mxv = gs;
#pragma unroll
    for (int off = 1; off < 64; off <<= 1) mxv = fmaxf(mxv, lane_read(mxv, lane ^ off));
    Gmax = mxv;
}
__device__ __forceinline__ void gate_tables(const float* G, LAS unsigned char* lds, const MUnit& u, float m0, int tid, int wave, int lane) {
    for (int c = wave; c < u.nch; c += 8) {
        float bs, gs, Bt, Gm; chunk_gates(G, u.row0 + 64 * c, u.nvalid, u.h, lane, bs, gs, Bt, Gm);
        float cm = gs;
#pragma unroll
        for (int off = 1; off < 64; off <<= 1) { const float v = lane_read(cm, lane >= off ? lane - off : lane); if (lane >= off) cm = fmaxf(cm, v); }
        ((LAS float*)(lds + TAB_GS))[64 * c + lane] = gs; ((LAS float*)(lds + TAB_CM))[64 * c + lane] = cm; ((LAS float*)(lds + TAB_BS))[64 * c + lane] = bs; ((LAS float*)(lds + TAB_WA))[64 * c + lane] = __expf(gs - Gm);
        if (lane == 0) { ((LAS float*)(lds + TAB_SC))[4 * c] = Bt; ((LAS float*)(lds + TAB_SC))[4 * c + 1] = Gm; }
    }
    __syncthreads();
    if (tid == 0) { float m = m0; LAS float* SC = (LAS float*)(lds + TAB_SC); LAS float* M = (LAS float*)(lds + TAB_M); float bsum = 0.f;
        for (int c = 0; c < u.nch; ++c) { M[c] = m; const float Bt = SC[4 * c], Gm = SC[4 * c + 1], mx = fmaxf(m, Gm); SC[4 * c + 2] = __expf(m - mx); SC[4 * c + 3] = __expf(Gm - mx); m = Bt + mx; bsum += Bt; }
        M[u.nch] = m; M[u.nch + 1] = bsum; }
    __syncthreads();
}
__device__ __forceinline__ void state_update(LAS unsigned char* lds, int wkoff, f32x16 (&R)[2], float& nst, float al, float be, int wave, int lane) {
    const int hh = lane >> 5, dkb = wave & 3, dvh = wave >> 2;
    const LAS unsigned char* WK = lds + wkoff; const LAS unsigned char* VS = WK + 64 * RP;
    bf16x8 kf[4];
#pragma unroll
    for (int ks = 0; ks < 4; ++ks) kf[ks] = tr_frag(WK, 16 * ks + 8 * hh, 16 * ks + 8 * hh + 4, dkb * 32, lane);
#pragma unroll
    for (int t = 0; t < 2; ++t) {
        const int dvb = 2 * dvh + t; f32x16 U;
#pragma unroll
        for (int i = 0; i < 16; ++i) U[i] = 0.f;
#pragma unroll
        for (int ks = 0; ks < 4; ++ks) U = MFMA32(tr_frag(VS, 16 * ks + 8 * hh, 16 * ks + 8 * hh + 4, dvb * 32, lane), kf[ks], U);
#pragma unroll
        for (int i = 0; i < 16; ++i) R[t][i] = al * R[t][i] + be * U[i];
    }
    if (dvh == 0) { f32x16 U;
#pragma unroll
        for (int i = 0; i < 16; ++i) U[i] = 0.f;
#pragma unroll
        for (int ks = 0; ks < 4; ++ks) U = MFMA32(tr_frag(VS, 16 * ks + 8 * hh, 16 * ks + 8 * hh + 4, 128, lane), kf[ks], U);
        nst = al * nst + be * U[0]; }
}
__device__ __forceinline__ void mlstm_summary_unit(const Args& a, LAS unsigned char* lds, int seg, int tid, int wave, int lane) {
    asm volatile("" : "+v"(tid), "+v"(lane));
    const MUnit u = munit_prompt(seg);
    const float* G = (const float*)(a.ws + WS_G);
    __syncthreads();
    munit_setup(a, lds, u, tid, true);
    gate_tables(G, lds, u, -INFINITY, tid, wave, lane);
    f32x16 R[2]; float nst = 0.f;
#pragma unroll
    for (int t = 0; t < 2; ++t)
#pragma unroll
        for (int i = 0; i < 16; ++i) R[t][i] = 0.f;
    v4u cur[7]; load_kv(a, u, 0, tid, cur);
    for (int cl = 0; cl < SEGC; ++cl) {
        int c = cl; asm volatile("" : "+s"(c));
        int tidc = tid, lanec = lane; asm volatile("" : "+v"(tidc), "+v"(lanec));
        const int tid = tidc, lane = lanec;
        const int ktoff = (c & 1) ? ML_C0 : ML_KT;
        v4u nxt[7];
#pragma unroll
        for (int j = 0; j < 7; ++j) nxt[j] = cur[j];
        if (c + 1 < SEGC) load_kv(a, u, c + 1, tid, nxt);
        process_kv(a, lds, u, c, ktoff, tid, cur);
#pragma unroll
        for (int j = 0; j < 7; ++j) cur[j] = nxt[j];
        __syncthreads();
        const LAS float* SC = (const LAS float*)(lds + TAB_SC) + 4 * c;
        state_update(lds, ktoff, R, nst, SC[2], SC[3], wave, lane);
    }
    const float Bseg = ((const LAS float*)(lds + TAB_M))[SEGC + 1], m_run = ((const LAS float*)(lds + TAB_M))[SEGC];
    int r = lane & 31; asm volatile("" : "+v"(r));
    const int hh = lane >> 5, dkb = wave & 3, dvh = wave >> 2;
    float* RS = (float*)(a.ws + WS_RSEG) + (size_t)seg * 16384 + wave * 2048 + hh * 32 + r;
#pragma unroll
    for (int t = 0; t < 2; ++t)
#pragma unroll
        for (int i = 0; i < 16; ++i) RS[(t * 16 + i) * 64] = R[t][i];
    if (dvh == 0 && hh == 0) ((float*)(a.ws + WS_NSEG))[(size_t)seg * 128 + dkb * 32 + r] = nst;
    if (tid == 0) { float* SS = (float*)(a.ws + WS_SSEG); SS[2 * seg] = Bseg; SS[2 * seg + 1] = m_run; }
}
__device__ __forceinline__ void mlstm_out_unit(const Args& a, LAS unsigned char* lds, const MUnit u, int tid, int wave, int lane) {
    asm volatile("" : "+v"(tid), "+v"(lane));
    const float* G = (const float*)(a.ws + WS_G);
    LAS float* PS = (LAS float*)(lds + ML_PS);
    LAS unsigned char* C0 = lds + ML_C0; LAS unsigned char* VT = lds + ML_VT;
    const bf16* OB = (const bf16*)(a.ws + WS_OB); bf16* MRG = (bf16*)(a.out + O_Y);
    const int r = lane & 31, hh = lane >> 5, dkb = wave & 3, dvh = wave >> 2;
    __syncthreads();
    munit_setup(a, lds, u, tid, false);
    f32x16 R[2]; float nst = 0.f, m_run = 0.f;
#pragma unroll
    for (int t = 0; t < 2; ++t)
#pragma unroll
        for (int i = 0; i < 16; ++i) R[t][i] = 0.f;
    if (u.samp) {
        const float* c0p = a.in[I_SC] + (size_t)u.sid * 16384;
#pragma unroll
        for (int t = 0; t < 2; ++t)
#pragma unroll
            for (int g = 0; g < 4; ++g) { const f32x4 v = *(const f32x4*)(c0p + (size_t)(dkb * 32 + r) * HD + (2 * dvh + t) * 32 + 8 * g + 4 * hh); R[t][4 * g] = v[0]; R[t][4 * g + 1] = v[1]; R[t][4 * g + 2] = v[2]; R[t][4 * g + 3] = v[3]; }
        nst = a.in[I_SN][(size_t)u.sid * 128 + dkb * 32 + r]; m_run = a.in[I_SM][u.sid];
    } else {
        const float* SSG = (const float*)(a.ws + WS_SSEG);
        const float* RSb = (const float*)(a.ws + WS_RSEG) + (size_t)(u.sid - u.sg) * 16384 + wave * 2048 + lane;
        const float* NSb = (const float*)(a.ws + WS_NSEG) + (size_t)(u.sid - u.sg) * 128 + dkb * 32 + r;
        const float* SGb = SSG + 2 * (u.sid - u.sg);
        f32x16 Rs[2]; float ns = 0.f, Bs = 0.f, ml = 0.f;
        if (u.sg > 0) {
#pragma unroll
            for (int t = 0; t < 2; ++t)
#pragma unroll
                for (int i = 0; i < 16; ++i) Rs[t][i] = RSb[(t * 16 + i) * 64];
            ns = NSb[0]; Bs = SGb[0]; ml = SGb[1];
        }
        for (int sp = 0; sp < u.sg; ++sp) {
            f32x16 Rn[2]; float nsn = 0.f, Bsn = 0.f, mln = 0.f;
            if (sp + 1 < u.sg) {
                const float* RS = RSb + (size_t)(sp + 1) * 16384;
#pragma unroll
                for (int t = 0; t < 2; ++t)
#pragma unroll
                    for (int i = 0; i < 16; ++i) Rn[t][i] = RS[(t * 16 + i) * 64];
                nsn = NSb[(sp + 1) * 128]; Bsn = SGb[2 * (sp + 1)]; mln = SGb[2 * (sp + 1) + 1];
            } else {
#pragma unroll
                for (int t = 0; t < 2; ++t)
#pragma unroll
                    for (int i = 0; i < 16; ++i) Rn[t][i] = 0.f;
            }
            const float mx = fmaxf(Bs + m_run, ml), al = __expf(Bs + m_run - mx), be = __expf(ml - mx);
#pragma unroll
            for (int t = 0; t < 2; ++t)
#pragma unroll
                for (int i = 0; i < 16; ++i) R[t][i] = al * R[t][i] + be * Rs[t][i];
            nst = al * nst + be * ns; m_run = mx;
#pragma unroll
            for (int t = 0; t < 2; ++t)
#pragma unroll
                for (int i = 0; i < 16; ++i) Rs[t][i] = Rn[t][i];
            ns = nsn; Bs = Bsn; ml = mln;
        }
    }
    gate_tables(G, lds, u, m_run, tid, wave, lane);
#pragma unroll
    for (int t = 0; t < 2; ++t)
#pragma unroll
        for (int i = 0; i < 16; ++i) *(LAS unsigned short*)(C0 + ((2 * dvh + t) * 32 + crow(i, hh)) * C0_PITCH + (dkb * 32 + r) * 2) = f2bf(R[t][i]);
    if (dvh == 0 && hh == 0) ((LAS float*)(lds + ML_NST))[dkb * 32 + r] = nst;
    const int tt = wave & 1, dvb = wave >> 1;
    const int t = 32 * tt + r; const bool tvalid = t < u.nvalid;
    const LAS float* mlg = (const LAS float*)(lds + ML_MLG);
    for (int cl = 0; cl < u.nch; ++cl) {
        int c = cl; asm volatile("" : "+s"(c));
        int tidc = tid, lanec = lane; asm volatile("" : "+v"(tidc), "+v"(lanec));
        const int tid = tidc, lane = lanec, r = lane & 31, hh = lane >> 5, t = 32 * tt + r; const bool tvalid = t < u.nvalid;
        const size_t rowc = u.row0 + 64 * c;
        const LAS float* GS = (const LAS float*)(lds + TAB_GS) + 64 * c;
        stage_chunk<true>(a, lds, u, c, ML_KT, tid);
        float touch = 0.f;
        if (cl + 1 < u.nch) { const size_t rn = rowc + 64 + (tid & 63); const int part = tid >> 6;
            const bf16* tb = part < 4 ? (const bf16*)(a.ws + WS_QKB) + rn * 2048 + (part >> 1) * 1024 + u.h * HD : (part < 6 ? (const bf16*)(a.ws + WS_VB) : OB) + rn * GW + u.h * HD;
            touch = *(const float*)(tb + (part & 1) * 64); }
        v2u ow[4];
#pragma unroll
        for (int g = 0; g < 4; ++g) { ow[g] = (v2u){0u, 0u}; if (tvalid) ow[g] = *(const v2u*)(OB + (rowc + t) * GW + u.h * HD + 32 * dvb + 8 * g + 4 * hh); }
        __syncthreads();
        const float m0c = ((const LAS float*)(lds + TAB_M))[c]; const float Mt = fmaxf(m0c, ((const LAS float*)(lds + TAB_CM))[64 * c + t]), it = __expf(m0c - Mt), et = __expf(-(((const LAS float*)(lds + TAB_BS))[64 * c + t] + Mt));
        f32x16 S0, S1, Nn; float dq = 0.f;
#pragma unroll
        for (int i = 0; i < 16; ++i) { S0[i] = 0.f; S1[i] = 0.f; Nn[i] = 0.f; }
        {
#pragma unroll
            for (int ks = 0; ks < 8; ++ks) {
                const bf16x8 qf = *(const LAS bf16x8*)(lds + ML_QS + t * KS_PITCH + (ks * 16 + hh * 8) * 2);
                const bf16x8 k0 = *(const LAS bf16x8*)(lds + ML_KS + r * KS_PITCH + (ks * 16 + hh * 8) * 2);
                S0 = MFMA32(k0, qf, S0);
                if (tt == 1) { const bf16x8 k1 = *(const LAS bf16x8*)(lds + ML_KS + (32 + r) * KS_PITCH + (ks * 16 + hh * 8) * 2); S1 = MFMA32(k1, qf, S1); }
            }
#pragma unroll
            for (int ks = 0; ks < 8; ++ks) { float f[8]; unpack8(*(const LAS v4u*)(lds + ML_QS + t * KS_PITCH + (ks * 16 + hh * 8) * 2), f);
                const f32x4 n0 = *(const LAS f32x4*)(lds + ML_NST + (ks * 16 + hh * 8) * 4), n1 = *(const LAS f32x4*)(lds + ML_NST + (ks * 16 + hh * 8) * 4 + 16);
#pragma unroll
                for (int e = 0; e < 8; ++e) f[e] *= it;
                dq += ((f[0] * n0[0] + f[1] * n0[1]) + (f[2] * n0[2] + f[3] * n0[3])) + ((f[4] * n1[0] + f[5] * n1[1]) + (f[6] * n1[2] + f[7] * n1[3]));
                const bf16x8 qs = __builtin_bit_cast(bf16x8, pack8f(f));
                const bf16x8 c0 = *(const LAS bf16x8*)(C0 + (32 * dvb + r) * C0_PITCH + (ks * 16 + hh * 8) * 2); Nn = MFMA32(c0, qs, Nn);
                if (ks & 1) __builtin_amdgcn_sched_barrier(0); }
        }
#pragma unroll
        for (int i = 0; i < 16; ++i) { const int s = crow(i, hh);
            S0[i] = (s <= t) ? S0[i] * __expf(GS[s] - Mt) : 0.f;
            S1[i] = (s + 32 <= t) ? S1[i] * __expf(GS[s + 32] - Mt) : 0.f;
            dq += S0[i] + S1[i]; }
        {
            bf16x8 sf[4]; sf[0] = pack_frag(S0, 0); sf[1] = pack_frag(S0, 1); sf[2] = pack_frag(S1, 0); sf[3] = pack_frag(S1, 1);
            const int nks = tt == 1 ? 4 : 2;
#pragma unroll
            for (int s = 0; s < 4; ++s) if (s < nks) {
                Nn = MFMA32(tr_frag(VT, 16 * s + 4 * hh, 16 * s + 8 + 4 * hh, 32 * dvb, lane), sf[s], Nn);
            }
        }
        const float den = sum_halves32(dq);
        const float inv = 1.0f / fmaxf(fabsf(den), et);
        float y[16]; float ss = 0.f;
#pragma unroll
        for (int g = 0; g < 4; ++g) { const int dv = 32 * dvb + 8 * g + 4 * hh;
            y[4 * g] = Nn[4 * g] * inv * __uint_as_float(ow[g].x << 16); y[4 * g + 1] = Nn[4 * g + 1] * inv * __uint_as_float(ow[g].x & 0xffff0000u);
            y[4 * g + 2] = Nn[4 * g + 2] * inv * __uint_as_float(ow[g].y << 16); y[4 * g + 3] = Nn[4 * g + 3] * inv * __uint_as_float(ow[g].y & 0xffff0000u);
            ss += (y[4 * g] * y[4 * g] + y[4 * g + 1] * y[4 * g + 1]) + (y[4 * g + 2] * y[4 * g + 2] + y[4 * g + 3] * y[4 * g + 3]); }
        ss = sum_halves32(ss);
        if (hh == 0) PS[dvb * 64 + t] = ss;
        { const LAS float* SC = (const LAS float*)(lds + TAB_SC) + 4 * c; state_update(lds, ML_KT, R, nst, SC[2], SC[3], wave, lane); }
        asm volatile("" :: "v"(touch));
        __syncthreads();
        const float tot = (PS[t] + PS[64 + t]) + (PS[128 + t] + PS[192 + t]);
        const float rstd = 1.0f / sqrtf(tot * (1.0f / 128.0f) + EPS);
        if (tvalid) {
#pragma unroll
            for (int g = 0; g < 4; ++g) { const int dv = 32 * dvb + 8 * g + 4 * hh; const f32x4 gv = *(const LAS f32x4*)(mlg + dv);
                v2u w; w.x = pk2(y[4 * g] * rstd * gv[0], y[4 * g + 1] * rstd * gv[1]); w.y = pk2(y[4 * g + 2] * rstd * gv[2], y[4 * g + 3] * rstd * gv[3]);
                *(v2u*)(MRG + pg8::tiled_elem((int)(rowc + t), GW + u.h * HD + dv, DM / 64)) = w; }
        }
        if (c + 1 < u.nch) {
#pragma unroll
            for (int tI = 0; tI < 2; ++tI)
#pragma unroll
                for (int i = 0; i < 16; ++i) *(LAS unsigned short*)(C0 + ((2 * dvh + tI) * 32 + crow(i, hh)) * C0_PITCH + (dkb * 32 + r) * 2) = f2bf(R[tI][i]);
            if (dvh == 0 && hh == 0) ((LAS float*)(lds + ML_NST))[dkb * 32 + r] = nst;
        }
    }
    if (u.samp || u.sg == NSEGB - 1) {
        int lanef = lane; asm volatile("" : "+v"(lanef));
        const int r = lanef & 31, hh = lanef >> 5;
        float* oc = a.out + (u.samp ? O_CS + (size_t)u.sid * 16384 : O_CP + (size_t)(u.b * NH + u.h) * 16384);
#pragma unroll
        for (int tI = 0; tI < 2; ++tI)
#pragma unroll
            for (int g = 0; g < 4; ++g) *(f32x4*)(oc + (size_t)(dkb * 32 + r) * HD + (2 * dvh + tI) * 32 + 8 * g + 4 * hh) = (f32x4){R[tI][4 * g], R[tI][4 * g + 1], R[tI][4 * g + 2], R[tI][4 * g + 3]};
        if (dvh == 0 && hh == 0) a.out[(u.samp ? O_NS + (size_t)u.sid * 128 : O_NP + (size_t)(u.b * NH + u.h) * 128) + dkb * 32 + r] = nst;
        if (tid == 0) a.out[u.samp ? O_MS + u.sid : O_MP + u.b * NH + u.h] = ((const LAS float*)(lds + TAB_M))[u.nch];
    }
}

__device__ __forceinline__ void final_norm_rows(const Args& a, int row_lo, int row_hi, int gw, int NGW, int lane) {
    const float* gf = a.in[I_GF];
    const bf16* XB = (const bf16*)(a.ws + WS_XB); const float* SS3 = (const float*)(a.ws + WS_SS + 15 * MiB);
    for (int m = row_hi - 1 - gw; m >= row_lo; m -= NGW) {
        float s = lane < 32 ? SS3[(size_t)m * 32 + lane] : 0.f;
        const float rstd = 1.0f / sqrtf(wave_sum(s) * (1.0f / DM) + EPS);

        float* yr = a.out + O_Y + (size_t)m * DM + 8 * lane;
#pragma unroll
        for (int j = 0; j < 4; ++j) { const v4u w = __builtin_nontemporal_load((const v4u*)(XB + pg8::tiled_elem(m, 8 * lane + 512 * j, DM / 64))); const f32x4 g0 = *(const f32x4*)(gf + 8 * lane + 512 * j), g1 = *(const f32x4*)(gf + 8 * lane + 512 * j + 4);
            f32x4 o0, o1; o0[0] = __uint_as_float(w.x << 16); o0[1] = __uint_as_float(w.x & 0xffff0000u); o0[2] = __uint_as_float(w.y << 16); o0[3] = __uint_as_float(w.y & 0xffff0000u);
            o1[0] = __uint_as_float(w.z << 16); o1[1] = __uint_as_float(w.z & 0xffff0000u); o1[2] = __uint_as_float(w.w << 16); o1[3] = __uint_as_float(w.w & 0xffff0000u);
            __builtin_nontemporal_store(o0 * rstd * g0, (f32x4*)(yr + 512 * j)); __builtin_nontemporal_store(o1 * rstd * g1, (f32x4*)(yr + 512 * j + 4)); }
    }
}


#ifndef ORD_SHARED
#define ORD_SHARED true
#endif
#define ORD_C (ORD_SHARED ? ((G % 8 == 0) ? (bx % 8) * (G / 8) + bx / 8 : bx) : bx)
#ifndef ORD_REV
#define ORD_REV true
#endif
#ifndef SPLIT_P6
#define SPLIT_P6 true
#endif
#ifndef SPLIT_P2
#define SPLIT_P2 true
#endif
#ifndef WGM_UP
#define WGM_UP 4
#endif
#ifndef WGM_DN
#define WGM_DN 4
#endif
#ifndef WGM_IN
#define WGM_IN 4
#endif
template <bool DIRECT> __device__ __forceinline__ void ph_ffn_up(LAS unsigned char* lds, const bf16* A, const bf16* W13, bf16* H, const float* SS, int G, int bx, bool rev = ORD_REV) {
    pg8::Gemm g{A, W13, MROWS, FF2, DM}; pg8::StaticOrder S; S.init(MROWS, FF2, G, ORD_C, WGM_UP); S.shared_a = ORD_SHARED; S.rev = rev;
    pg8::EpiSwiGLU<DIRECT> E{H, FF, SS};
    pg8::gemm_phase<pg8::EpiSwiGLU<DIRECT>, pg8::StaticOrder, true, true>(lds + RING_OFF, g, S, E);
}
__device__ __forceinline__ void ph_resid(LAS unsigned char* lds, const bf16* A, const bf16* Wt, int K, bf16* X, float* SSout, float scale, int G, int bx) {
    pg8::Gemm g{A, Wt, MROWS, DM, K}; pg8::StaticOrder S; S.init(MROWS, DM, G, ORD_C, WGM_DN); S.shared_a = ORD_SHARED;
    pg8::EpiResid E{X, X, SSout, scale, DM};
    pg8::gemm_phase<pg8::EpiResid, pg8::StaticOrder, true, true>(lds + RING_OFF, g, S, E);
}
__device__ __forceinline__ void ph_resid_prompt(LAS unsigned char* lds, const bf16* A, const bf16* Wt, int K, bf16* X, float* SSout, float scale, int G, int bx) {
    pg8::Gemm g{A, Wt, MP, DM, K}; pg8::StaticOrder S; S.init(MP, DM, G, ORD_C, WGM_DN); S.shared_a = ORD_SHARED;
    pg8::EpiResid E{X, X, SSout, scale, DM};
    pg8::gemm_phase<pg8::EpiResid, pg8::StaticOrder, true, true>(lds + RING_OFF, g, S, E);
}
template <int NS> __device__ __forceinline__ void ph_tail_splitk(LAS unsigned char* lds, const bf16* A, const bf16* Wt, int K, float* PART, int q) {
    const int unit = q / NS, sp = q % NS, nkt = K / 64, per = (((nkt + NS - 1) / NS) + 1) & ~1, kt0 = sp * per;
    pg8::Gemm g{A, Wt, MROWS, DM, K, kt0, (nkt - kt0) < per ? (nkt - kt0) : per}; pg8::SingleOrder S{MP / 256 + (unit >> 3), unit & 7};
    pg8::EpiPartial E{PART + (size_t)sp * MS * DM, MP};
    pg8::gemm_phase<pg8::EpiPartial, pg8::SingleOrder, true, true>(lds + RING_OFF, g, S, E);
}
__device__ __forceinline__ void ph_inproj(const Args& args, LAS unsigned char* lds, const bf16* A, const float* SS, int G, int bx) {
    unsigned char* ws = args.ws;
    pg8::Gemm g{A, (const bf16*)(ws + WS_WIN), MROWS, NINP, DM}; pg8::StaticOrder S; S.init(MROWS, NINP, G, ORD_C, WGM_IN); S.shared_a = ORD_SHARED; S.rev = ORD_REV;
    pg8::EpiInProj E{SS, (bf16*)(ws + WS_QA), (bf16*)(ws + WS_KA), (bf16*)(ws + WS_VA), (bf16*)(ws + WS_QKB), (bf16*)(ws + WS_VB), (bf16*)(ws + WS_OB),
                     args.out + O_KP, args.out + O_VP, args.out + O_KS, args.out + O_VS, (float*)(ws + WS_G), args.in[I_BIG], args.in[I_BFG], MP, QSCALE};
    pg8::gemm_phase<pg8::EpiInProj, pg8::StaticOrder, true, true>(lds + RING_OFF, g, S, E);
}

__device__ __forceinline__ void ph_probe(LAS unsigned char* lds, const bf16* A, const bf16* Wt, int N, int K, float* sink, int flag, int G, int bx) {
    pg8::Gemm g{A, Wt, MROWS, N, K}; pg8::StaticOrder S; S.init(MROWS, N, G, bx);
    pg8::EpiProbe E{sink, flag};
    pg8::gemm_phase<pg8::EpiProbe, pg8::StaticOrder, true, true>(lds + RING_OFF, g, S, E);
}

constexpr int NPHASE = 10;
#ifndef PROBE_REP
#define PROBE_REP 0
#endif
#define NREP(k) (1 + ((PROBE_REP >> (k)) & 1))
#define BARX() do { if (MK_N_LAUNCHES == 1) xcd_barrier(bar); } while (0)
__global__ void __launch_bounds__(512, 2) hymba_fwd(Args args) {
    extern __shared__ __attribute__((aligned(16))) unsigned char lds_raw[];
    LAS unsigned char* lds = (LAS unsigned char*)lds_raw;
    volatile LAS unsigned* MISC = (volatile LAS unsigned*)(lds + MISC_OFF);
    const int tid = threadIdx.x, lane = tid & 63, wave = __builtin_amdgcn_readfirstlane(tid >> 6);
    const int G = gridDim.x; const int bx = blockIdx.x; const int vcu = (G % 8 == 0) ? (bx % 8) * (G / 8) + bx / 8 : bx;
    unsigned char* ws = args.ws;
    gu32* ctl = (gu32*)(ws + WS_CTL);
    for (int u = tid; u < (LDS_BYTES - LDSCTL_OFF) / 4; u += 512) ((LAS unsigned*)(lds + LDSCTL_OFF))[u] = 0u;
    __syncthreads();
    XcdBarrier bar; bar.bar = (unsigned*)(ctl + CW_BAR); bar.x = 0; bar.st = nullptr;
    if (MK_N_LAUNCHES == 1) bar = xcd_barrier_post((unsigned*)(ctl + CW_BAR), MISC + 8);
    const int lo = args.ph_lo, hi = args.ph_hi;
#define IN(k) (lo <= (k) && (k) < hi)
#define SEAM(k) do { if (MK_N_LAUNCHES == 1 && IN(k) && IN((k) + 1)) xcd_barrier(bar); } while (0)
    bf16* XB = (bf16*)(ws + WS_XB); bf16* HB = (bf16*)(ws + WS_HU); bf16* MRG = (bf16*)(args.out + O_Y);
    float* SS0 = (float*)(ws + WS_SS); float* SS1 = (float*)(ws + WS_SS + 5 * MiB); float* SS2 = (float*)(ws + WS_SS + 10 * MiB); float* SS3 = (float*)(ws + WS_SS + 15 * MiB);
    float* RS1 = SS1 + (size_t)MROWS * 32; float* RS2 = SS2 + (size_t)MROWS * 32;
    const bool SPLITK = (MK_N_LAUNCHES == 1 && G == 256);
    constexpr int NSPL2 = 4, NSPL6 = 4;
    const int tq_x = vcu >> 5, tq_j = vcu & 31;
#define TAIL_CU(NS) (tq_j < 2 * (NS))
#define TAIL_Q(NS) (tq_x * 2 * (NS) + tq_j)
#define SIDE_I(NS) (tq_x * (32 - 2 * (NS)) + tq_j - 2 * (NS))
#define NSIDE(NS) (256 - 16 * (NS))
    float* PART = (float*)(ws + WS_RSEG);

    if (IN(0)) { p0_prologue(args, lds, vcu, G, wave, lane); if (NREP(0) == 2) p0_prologue(args, lds, vcu, G, wave, lane); } SEAM(0);
    constexpr int CV1_UP = 1536, CV3_UP = 5504;
    if (IN(1)) { ph_ffn_up<true>(lds, XB, (const bf16*)(ws + WS_W13A), HB, SS0, G, bx);
                 if (SPLITK) { const int nun = (MROWS / 256) * (FF2 / 256), nlast = nun - (nun / G) * G;
                     if (nlast > 0 && vcu >= nlast) { convert_weights(args, lds, 1, (vcu - nlast) * 8 + wave, (G - nlast) * 8, wave, lane, 18432, 20480); convert_weights(args, lds, 1, (vcu - nlast) * 8 + wave, (G - nlast) * 8, wave, lane, 0, CV1_UP); } } if (NREP(12) == 2) ph_ffn_up<true>(lds, XB, (const bf16*)(ws + WS_W13A), HB, SS0, G, bx); if (NREP(1) == 2) ph_probe(lds, XB, (const bf16*)(ws + WS_W13A), FF2, DM, (float*)(ws + WS_RSEG), args.ph_lo < 0, G, bx); } SEAM(1);
    if (IN(2) && SPLITK && SPLIT_P2) { ph_resid_prompt(lds, HB, (const bf16*)(ws + WS_W2A), FF, XB, SS1, 0.5f, G, bx);
                 if (TAIL_CU(NSPL2)) ph_tail_splitk<NSPL2>(lds, HB, (const bf16*)(ws + WS_W2A), FF, PART, TAIL_Q(NSPL2));
                 else convert_weights(args, lds, 1, SIDE_I(NSPL2) * 8 + wave, NSIDE(NSPL2) * 8, wave, lane, CV1_UP + CV3_UP, 18432); }
    else if (IN(2)) { ph_resid(lds, HB, (const bf16*)(ws + WS_W2A), FF, XB, SS1, 0.5f, G, bx);
                 { const int nun = (MROWS / 256) * (DM / 256), nfull = nun / G, nlast = nun - nfull * G;
                   const int oc = ORD_C;
                   if (nlast > 0 && oc >= nlast) convert_weights(args, lds, 1, (oc - nlast) * 8 + wave, (G - nlast) * 8, wave, lane);
                   else if (nlast == 0) convert_weights(args, lds, 1, oc * 8 + wave, G * 8, wave, lane); }
                 if (NREP(2) == 2) { __syncthreads(); ph_probe(lds, HB, (const bf16*)(ws + WS_W2A), DM, FF, (float*)(ws + WS_RSEG), args.ph_lo < 0, G, bx); } } SEAM(2);
    if (IN(3)) { if (SPLITK && SPLIT_P2) { finalize_rstd(SS1, RS1, vcu * 8 + wave, G * 8, lane, MP); reduce_sample_rows<NSPL2>(args, PART, 0.5f, RS1, wave * G + vcu, G * 8, lane); } else finalize_rstd(SS1, RS1, vcu * 8 + wave, G * 8, lane);
                 if (MK_N_LAUNCHES == 1) xcd_barrier(bar); else if (lo == 3) {   finalize_rstd(SS1, RS1, wave, 8, lane); __syncthreads(); }
                 ph_inproj(args, lds, XB, RS1, G, bx);
                 if (SPLITK) { const int nun = (MROWS / 256) * (NINP / 256), nlast = nun - (nun / G) * G;
                     if (nlast > 0 && vcu >= nlast) convert_weights(args, lds, 1, (vcu - nlast) * 8 + wave, (G - nlast) * 8, wave, lane, CV1_UP, CV1_UP + CV3_UP); } if (NREP(13) == 2) ph_inproj(args, lds, XB, RS1, G, bx); if (NREP(3) == 2) ph_probe(lds, XB, (const bf16*)(ws + WS_WIN), NINP, DM, (float*)(ws + WS_RSEG), args.ph_lo < 0, G, bx); } SEAM(3);
    if (IN(4)) {
        for (int j = vcu; j < NBP * NH * (NSEGB - 1); j += G) mlstm_summary_unit(args, lds, (j / (NSEGB - 1)) * NSEGB + j % (NSEGB - 1), tid, wave, lane);
        attn_prompt_phase(args, lds, vcu, G, tid, wave, lane);
        for (int u = vcu; u < NBS * NH; u += G) attn_sample_unit(args, lds, u >> 3, u & 7, tid, wave, lane);
        if (NREP(4) == 2) { for (int j = vcu; j < NBP * NH * (NSEGB - 1); j += G) mlstm_summary_unit(args, lds, (j / (NSEGB - 1)) * NSEGB + j % (NSEGB - 1), tid, wave, lane); }
        if (NREP(10) == 2) attn_prompt_phase(args, lds, vcu, G, tid, wave, lane);
        if (NREP(11) == 2) { for (int u = vcu; u < NBS * NH; u += G) attn_sample_unit(args, lds, u >> 3, u & 7, tid, wave, lane); }
    } SEAM(4);
    if (IN(5)) {
        for (int rep = 0; rep < NREP(5); ++rep)
        for (int s = vcu; s < NSEGP + NBS * NH; s += G) mlstm_out_unit(args, lds, s < NSEGP ? munit_prompt(s) : munit_sample(s - NSEGP), tid, wave, lane);
    } SEAM(5);
    if (IN(6) && SPLITK && SPLIT_P6) { __syncthreads(); ph_resid_prompt(lds, MRG, (const bf16*)(ws + WS_WOUT), DM, XB, SS2, 1.0f, G, bx);
                 if (TAIL_CU(NSPL6)) ph_tail_splitk<NSPL6>(lds, MRG, (const bf16*)(ws + WS_WOUT), DM, PART, TAIL_Q(NSPL6));
                 else convert_weights(args, lds, 2, SIDE_I(NSPL6) * 8 + wave, NSIDE(NSPL6) * 8, wave, lane); }
    else if (IN(6)) { __syncthreads(); ph_resid(lds, MRG, (const bf16*)(ws + WS_WOUT), DM, XB, SS2, 1.0f, G, bx);
                 { const int nun = (MROWS / 256) * (DM / 256), nfull = nun / G, nlast = nun - nfull * G;
                   const int oc = ORD_C;
                   if (nlast > 0 && oc >= nlast) convert_weights(args, lds, 2, (oc - nlast) * 8 + wave, (G - nlast) * 8, wave, lane);
                   else if (nlast == 0) convert_weights(args, lds, 2, oc * 8 + wave, G * 8, wave, lane); }
                 if (NREP(6) == 2) ph_probe(lds, MRG, (const bf16*)(ws + WS_WOUT), DM, DM, (float*)(ws + WS_RSEG), args.ph_lo < 0, G, bx); } SEAM(6);
    if (IN(7)) { if (SPLITK && SPLIT_P6) { finalize_rstd(SS2, RS2, vcu * 8 + wave, G * 8, lane, MP); reduce_sample_rows<NSPL6>(args, PART, 1.0f, RS2, wave * G + vcu, G * 8, lane); } else finalize_rstd(SS2, RS2, vcu * 8 + wave, G * 8, lane);
                 if (MK_N_LAUNCHES == 1) xcd_barrier(bar); else if (lo == 7) { finalize_rstd(SS2, RS2, wave, 8, lane); __syncthreads(); }
                 ph_ffn_up<true>(lds, XB, (const bf16*)(ws + WS_W13B), HB, RS2, G, bx); if (NREP(7) == 2) ph_probe(lds, XB, (const bf16*)(ws + WS_W13B), FF2, DM, (float*)(ws + WS_RSEG), args.ph_lo < 0, G, bx); } SEAM(7);
    if (IN(8) && IN(9) && MK_N_LAUNCHES == 1 && G == 256) {
        { pg8::Gemm g{HB, (const bf16*)(ws + WS_W2B), MP, DM, FF}; pg8::StaticOrder S; S.init(MP, DM, G, ORD_C, WGM_DN); S.shared_a = ORD_SHARED;
          pg8::EpiResid E{XB, XB, SS3, 0.5f, DM};
          pg8::gemm_phase<pg8::EpiResid, pg8::StaticOrder, true, true>(lds + RING_OFF, g, S, E); }
        xcd_barrier(bar);
        { const int tq_x = vcu >> 5, tq_j = vcu & 31; float* PART = (float*)(ws + WS_RSEG);
          constexpr int NORM_SPLIT = 14336;
          if (tq_j < 4) { const int q = tq_x * 4 + tq_j, unit = q >> 1, sp = q & 1;
              pg8::Gemm g{HB, (const bf16*)(ws + WS_W2B), MROWS, DM, FF, sp * 44, sp ? 42 : 44}; pg8::SingleOrder S{MP / 256 + (unit >> 3), unit & 7};
              pg8::EpiPartial E{PART + (size_t)sp * MS * DM, MP};
              pg8::gemm_phase<pg8::EpiPartial, pg8::SingleOrder, true, true>(lds + RING_OFF, g, S, E); }
          else final_norm_rows(args, NORM_SPLIT, MP, (tq_x * 28 + tq_j - 4) * 8 + wave, 224 * 8, lane);
          final_norm_rows(args, 0, NORM_SPLIT, vcu * 8 + wave, G * 8, lane);
          xcd_barrier(bar);
          final_norm_sample_rows(args, PART, wave * G + vcu, G * 8, lane); }
    } else {
    if (IN(8)) { ph_resid(lds, HB, (const bf16*)(ws + WS_W2B), FF, XB, SS3, 0.5f, G, bx);
                 if (NREP(8) == 2) ph_probe(lds, HB, (const bf16*)(ws + WS_W2B), DM, FF, (float*)(ws + WS_RSEG), args.ph_lo < 0, G, bx); } SEAM(8);
    if (IN(9)) { final_norm_rows(args, 0, MROWS, vcu * 8 + wave, G * 8, lane); }
    }
#undef IN
#undef SEAM
}

extern "C" void kernel_launch(void* const* d_in, const int* in_sizes, int n_in, void* d_out, int out_size, void* d_ws, size_t ws_size, hipStream_t stream) {
    static int grid = 0;
    if (grid == 0) {
        if (n_in != 26 || (size_t)out_size != O_END || ws_size < WS_END) { fprintf(stderr, "kernel_launch: unexpected shapes: n_in %d out %d ws %zu (need %zu)\n", n_in, out_size, ws_size, (size_t)WS_END); grid = -1; return; }
        int dev = 0, cus = 0, per_cu = 0;
        if (hipGetDevice(&dev) != hipSuccess || hipDeviceGetAttribute(&cus, hipDeviceAttributeMultiprocessorCount, dev) != hipSuccess) { grid = -1; return; }
        if (hipFuncSetAttribute((const void*)hymba_fwd, hipFuncAttributeMaxDynamicSharedMemorySize, LDS_BYTES) != hipSuccess) { fprintf(stderr, "kernel_launch: hipFuncSetAttribute failed\n"); grid = -1; return; }
        if (hipOccupancyMaxActiveBlocksPerMultiprocessor(&per_cu, (const void*)hymba_fwd, 512, LDS_BYTES) != hipSuccess || per_cu < 1) { fprintf(stderr, "kernel_launch: occupancy query says %d\n", per_cu); (void)hipGetLastError(); grid = -1; return; }
        grid = cus;
    }
    if (grid < 0) return;
    if (hipMemsetAsync((char*)d_ws + WS_CTL, 0, CTL_ZERO_BYTES, stream) != hipSuccess) return;
    Args a{};
    for (int i = 0; i < 26; ++i) a.in[i] = (const float*)d_in[i];
    a.out = (float*)d_out; a.ws = (unsigned char*)d_ws;
    if (MK_N_LAUNCHES == 1) { a.ph_lo = 0; a.ph_hi = NPHASE; hipLaunchKernelGGL(hymba_fwd, dim3(grid), dim3(512), LDS_BYTES, stream, a); }
    else for (int p = 0; p < NPHASE; ++p) { a.ph_lo = p; a.ph_hi = p + 1; hipLaunchKernelGGL(hymba_fwd, dim3(grid), dim3(512), LDS_BYTES, stream, a); }
}
```

```cpp
#include <hip/hip_runtime.h>
#include <cstdio>
#include <cstdint>

#ifndef MK_N_LAUNCHES
#define MK_N_LAUNCHES 1
#endif

constexpr int DM = 2048, MP = 32768, MS = 512, MROWS = MP + MS, TP = 8192, TS = 16, NBP = 4, NBS = 32, PAST = 2048;
constexpr int FF = 5504, FF2 = 2 * FF, NIN = 7184, NINP = 7424, HD = 128, NH = 8, GW = 1024;
constexpr int NCHP = NBP * NH * (TP / 64), NCHS = NBS * NH, NCH = NCHP + NCHS;
constexpr int LDX = DM, LDW = DM;
constexpr float EPS = 1e-6f;
constexpr float QSCALE = 0.08838834764831845f * 1.4426950408889634f;
constexpr float KSCALE = 0.08838834764831845f;

constexpr size_t O_Y = 0, O_KP = 68157440, O_VP = 101711872, O_CP = 135266304, O_NP = 135790592, O_MP = 135794688, O_CVP = 135794720,
                 O_KS = 135819296, O_VS = 136343584, O_CS = 136867872, O_NS = 141062176, O_MS = 141094944, O_CVS = 141095200, O_END = 141291808;

namespace pg8 {
#define PG8_LAS __attribute__((address_space(3)))
typedef unsigned short bf16_t;
typedef short bf16x8 __attribute__((ext_vector_type(8)));
typedef float f32x4 __attribute__((ext_vector_type(4)));
typedef unsigned u32x4 __attribute__((ext_vector_type(4)));
constexpr int BM = 256, BK = 64, HALF = 128, HTB = HALF * BK * 2  , STAGE_BYTES = 8 * HTB, NXCD = 8, WGM = 4;

__host__ __device__ __forceinline__ int lds_byte(int r, int c) { const int st = (r >> 4) * 2 + (c >> 5), rr = r & 15, cc = c & 31, ob = rr * 64 + cc * 2; return st * 1024 + (ob ^ (((ob >> 9) & 1) << 5)); }
__host__ __device__ __forceinline__ void stage_rc(int b, int& R, int& C) { const int st = b / 1024, sb = b % 1024, swz = sb ^ (((sb >> 9) & 1) << 5); R = (st >> 1) * 16 + swz / 64; C = (st & 1) * 32 + (swz % 64) / 2; }
__host__ __device__ __forceinline__ int perm32(int rho) { const int n = rho >> 4, i = rho & 15; return 8 * (i >> 2) + 4 * n + (i & 3); }

struct Unit { int pm, pn; };
struct Gemm { const bf16_t* A; const bf16_t* Bt; int M, N, K; int kt0 = 0, ktn = 0;   };
__host__ __device__ __forceinline__ size_t tiled_elem(int row, int col, int nKT) {
    const size_t blk = ((size_t)(row >> 8) * nKT + (col >> 6)) * 2 + ((row >> 7) & 1);
    return blk * 8192 + (size_t)(lds_byte(row & 127, col & 63) >> 1);
}
__host__ __device__ __forceinline__ int perm32inv(int c) { return 16 * ((c >> 2) & 1) + 4 * (c >> 3) + (c & 3); }
__host__ __device__ __forceinline__ size_t tiled_elem_b(int n, int k, int nKT) { return tiled_elem((n & ~31) + perm32inv(n & 31), k, nKT); }

struct StaticOrder {
    bool rev = false;
    bool shared_a = false;
    int nM, nN, nwg, G, c, wgm;
    __host__ __device__ void init(int M, int N, int G_, int c_, int wgm_ = WGM) { nM = M / BM; nN = N / BM; nwg = nM * nN; G = G_; c = c_; wgm = wgm_; }
    __host__ __device__ bool next(int i, Unit& u) const {
        const long L = (long)i * G + c; if (L >= nwg) return false;
        int wgid = (int)L; if (!shared_a) { const int q = nwg / NXCD, r = nwg % NXCD, xcd = wgid % NXCD, off = wgid / NXCD; wgid = (xcd < r ? xcd * (q + 1) : r * (q + 1) + (xcd - r) * q) + off; }
        const int nig = wgm * nN, gid = wgid / nig, fm = gid * wgm, gsz = (nM - fm) < wgm ? (nM - fm) : wgm;
        u.pm = fm + ((wgid % nig) % gsz); u.pn = (wgid % nig) / gsz; if (rev) u.pm = nM - 1 - u.pm; return true;
    }
    __device__ __forceinline__ void a_ready(const Unit&) const {}
    __device__ __forceinline__ void done(const Unit&) const {}
};
struct SingleOrder {
    int pm, pn;
    __host__ __device__ bool next(int i, Unit& u) const { if (i != 0) return false; u.pm = pm; u.pn = pn; return true; }
    __device__ __forceinline__ void a_ready(const Unit&) const {}
    __device__ __forceinline__ void done(const Unit&) const {}
};


typedef float f32x2 __attribute__((ext_vector_type(2)));
typedef __bf16 bf16x2_t __attribute__((ext_vector_type(2)));
__device__ __forceinline__ unsigned cvt_pk_bf16(float lo, float hi) { f32x2 v = {lo, hi}; bf16x2_t b = __builtin_convertvector(v, bf16x2_t); return __builtin_bit_cast(unsigned, b); }
__device__ __forceinline__ u32x4 pack8(f32x4 a, f32x4 b) { u32x4 w; w.x = cvt_pk_bf16(a[0], a[1]); w.y = cvt_pk_bf16(a[2], a[3]); w.z = cvt_pk_bf16(b[0], b[1]); w.w = cvt_pk_bf16(b[2], b[3]); return w; }

__device__ __forceinline__ void row_rstd(const float* SS, const Unit& u, int wr, int fr, int fq, float (&r)[2][4]) {
#pragma unroll
    for (int ai = 0; ai < 2; ++ai)
#pragma unroll
        for (int m = 0; m < 4; ++m) {
            const int row = u.pm * BM + ai * HALF + wr * 64 + m * 16 + fr;
            const f32x4* p = (const f32x4*)(SS + (size_t)row * 32 + fq * 8);
            const f32x4 a = p[0], b = p[1];
            float s = ((a[0] + a[1]) + (a[2] + a[3])) + ((b[0] + b[1]) + (b[2] + b[3]));
            s += __shfl_xor(s, 16); s += __shfl_xor(s, 32);
            r[ai][m] = 1.0f / sqrtf(s * (1.0f / 2048.0f) + 1e-6f);
        }
}
__device__ __forceinline__ float logsig_f(float x) { return fminf(x, 0.f) - 0.6931471805599453f * __builtin_amdgcn_logf(1.0f + __builtin_amdgcn_exp2f(-1.4426950408889634f * fabsf(x))); }
__device__ __forceinline__ void row_rstd_direct(const float* RS, const Unit& u, int wr, int fr, float (&r)[2][4]) {
#pragma unroll
    for (int ai = 0; ai < 2; ++ai)
#pragma unroll
        for (int m = 0; m < 4; ++m) r[ai][m] = RS[u.pm * BM + ai * HALF + wr * 64 + m * 16 + fr];
}
__device__ __forceinline__ float sigmoid_f(float a) { return __builtin_amdgcn_rcpf(1.0f + __builtin_amdgcn_exp2f(-1.4426950408889634f * a)); }

template <bool DIRECT  > struct EpiSwiGLU {
    static constexpr bool PERM = true, AFTER_DRAIN = false;
    bf16_t* H; int ldh; const float* SS;
    __device__ __forceinline__ void operator()(const f32x4 (&acc)[2][2][4][2], const Unit& u, int wr, int wc, int fr, int fq) const {
        float r[2][4]; if (DIRECT) row_rstd_direct(SS, u, wr, fr, r); else row_rstd(SS, u, wr, fr, fq, r);
        const int col0 = u.pn * HALF + wc * 32 + 8 * fq;
#pragma unroll
        for (int ai = 0; ai < 2; ++ai)
#pragma unroll
            for (int m = 0; m < 4; ++m) {
                const float rs = r[ai][m], rsn = rs * -1.4426950408889634f;
                bf16_t* rowp = H + tiled_elem(u.pm * BM + ai * HALF + wr * 64 + m * 16 + fr, col0, ldh / BK);
                f32x4 o[2];
#pragma unroll
                for (int n = 0; n < 2; ++n)
#pragma unroll
                    for (int hv = 0; hv < 2; ++hv) {
                        const f32x2 av = (f32x2){acc[ai][0][m][n][2 * hv], acc[ai][0][m][n][2 * hv + 1]}, bv = (f32x2){acc[ai][1][m][n][2 * hv], acc[ai][1][m][n][2 * hv + 1]};
                        const f32x2 t = av * rsn; f32x2 e; e.x = __builtin_amdgcn_exp2f(t.x); e.y = __builtin_amdgcn_exp2f(t.y);
                        const f32x2 d = e + 1.0f; f32x2 q; q.x = __builtin_amdgcn_rcpf(d.x); q.y = __builtin_amdgcn_rcpf(d.y);
                        const f32x2 h = (av * (rs * rs)) * (bv * q);
                        o[n][2 * hv] = h.x; o[n][2 * hv + 1] = h.y; }
                *(u32x4*)rowp = pack8(o[0], o[1]);
            }
    }
};

__device__ __forceinline__ f32x4 bf_lo4(unsigned a, unsigned b) { return (f32x4){__uint_as_float(a << 16), __uint_as_float(a & 0xffff0000u), __uint_as_float(b << 16), __uint_as_float(b & 0xffff0000u)}; }
struct EpiResid {
    static constexpr bool PERM = true, AFTER_DRAIN = false;
    const bf16_t* base; bf16_t* out; float* SSout; float scale; int ldx;
    __device__ __forceinline__ void operator()(const f32x4 (&acc)[2][2][4][2], const Unit& u, int wr, int wc, int fr, int fq) const {
        const int colb = u.pn * BM + wc * 32 + 8 * fq;
        const size_t row0 = (size_t)(u.pm * BM + wr * 64 + fr);
        u32x4 bv[2][4][2];
#pragma unroll
        for (int ai = 0; ai < 2; ++ai)
#pragma unroll
            for (int m = 0; m < 4; ++m)
#pragma unroll
                for (int bj = 0; bj < 2; ++bj) bv[ai][m][bj] = *(const u32x4*)(base + tiled_elem((int)row0 + ai * HALF + m * 16, colb + bj * HALF, 2048 / BK));
#pragma unroll
        for (int ai = 0; ai < 2; ++ai)
#pragma unroll
            for (int m = 0; m < 4; ++m) {
                const size_t row = row0 + ai * HALF + m * 16;
                float ss = 0.f;
#pragma unroll
                for (int bj = 0; bj < 2; ++bj) {
                    const u32x4 b = bv[ai][m][bj];
                    const f32x4 v0 = bf_lo4(b.x, b.y) + acc[ai][bj][m][0] * scale, v1 = bf_lo4(b.z, b.w) + acc[ai][bj][m][1] * scale;
                    *(u32x4*)(out + tiled_elem((int)row, colb + bj * HALF, 2048 / BK)) = pack8(v0, v1);
                    ss += ((v0[0] * v0[0] + v0[1] * v0[1]) + (v0[2] * v0[2] + v0[3] * v0[3])) + ((v1[0] * v1[0] + v1[1] * v1[1]) + (v1[2] * v1[2] + v1[3] * v1[3]));
                }
                { const auto r16 = __builtin_amdgcn_permlane16_swap(__float_as_uint(ss), __float_as_uint(ss), false, false); ss = __uint_as_float(r16[0]) + __uint_as_float(r16[1]);
                  const auto r32 = __builtin_amdgcn_permlane32_swap(__float_as_uint(ss), __float_as_uint(ss), false, false); ss = __uint_as_float(r32[0]) + __uint_as_float(r32[1]); }
                if (fq == 0) SSout[row * 32 + u.pn * 4 + wc] = ss;
            }
    }
};

struct EpiInProj {
    static constexpr bool PERM = true, AFTER_DRAIN = false;
    const float* SS;        bf16_t *QA, *KA, *VA, *QKB, *VB, *OB; float *outKP, *outVP, *outKS, *outVS; float* G; const float *b_ig, *b_fg; int splitRow; float qscale;
    __device__ __forceinline__ void operator()(const f32x4 (&acc)[2][2][4][2], const Unit& u, int wr, int wc, int fr, int fq) const {
        float r[2][4]; row_rstd_direct(SS, u, wr, fr, r);
        const int pn = u.pn;
        if (pn == 28) {
            if (wc == 0 && fq < 2) {
                const float* bias = fq == 0 ? b_ig : b_fg;
                const f32x4 bv0 = *(const f32x4*)bias, bv1 = *(const f32x4*)(bias + 4);
#pragma unroll
                for (int ai = 0; ai < 2; ++ai)
#pragma unroll
                    for (int m = 0; m < 4; ++m) {
                        const int row = u.pm * BM + ai * HALF + wr * 64 + m * 16 + fr;
                        f32x4 v0 = acc[ai][0][m][0] * r[ai][m] + bv0, v1 = acc[ai][0][m][1] * r[ai][m] + bv1;
                        if (fq == 1) {
#pragma unroll
                            for (int j = 0; j < 4; ++j) { v0[j] = logsig_f(v0[j]); v1[j] = logsig_f(v1[j]); }
                        }
                        *(f32x4*)(G + (size_t)row * 16 + 8 * fq) = v0; *(f32x4*)(G + (size_t)row * 16 + 8 * fq + 4) = v1;
                    }
            }
            return;
        }
        bf16_t* dst; int ld = 1024, ct = pn & 3; float sc = 1.f; float *fP = nullptr, *fS = nullptr; bool sig = false;
        if (pn < 4) { dst = QA; sc = qscale; }
        else if (pn < 8) { dst = KA; fP = outKP; fS = outKS; }
        else if (pn < 12) { dst = VA; fP = outVP; fS = outVS; }
        else if (pn < 20) { dst = QKB; ld = 2048; ct = pn - 12; }
        else if (pn < 24) { dst = VB; }
        else { dst = OB; sig = true; }
        const int colb = ct * BM + wc * 32 + 8 * fq;
#pragma unroll
        for (int ai = 0; ai < 2; ++ai)
#pragma unroll
            for (int m = 0; m < 4; ++m) {
                const int row = u.pm * BM + ai * HALF + wr * 64 + m * 16 + fr;
                const float rs = r[ai][m] * sc;
                float* fp = nullptr;
                if (fP) fp = (row >= splitRow) ? fS + (size_t)(row - splitRow) * 1024 : fP + (size_t)row * 1024;
#pragma unroll
                for (int bj = 0; bj < 2; ++bj) {
                    const int col = colb + bj * HALF;
                    f32x4 v0 = acc[ai][bj][m][0] * rs, v1 = acc[ai][bj][m][1] * rs;
                    if (sig) {
#pragma unroll
                        for (int j = 0; j < 4; ++j) { v0[j] = sigmoid_f(v0[j]); v1[j] = sigmoid_f(v1[j]); }
                    }
                    if (fp) { *(f32x4*)(fp + col) = v0; *(f32x4*)(fp + col + 4) = v1; }
                    *(u32x4*)(dst + (size_t)row * ld + col) = pack8(v0, v1);
                }
            }
    }
};


struct EpiPartial {
    static constexpr bool PERM = true, AFTER_DRAIN = false;
    float* P; int row_base;
    __device__ __forceinline__ void operator()(const f32x4 (&acc)[2][2][4][2], const Unit& u, int wr, int wc, int fr, int fq) const {
        const int colb = u.pn * BM + wc * 32 + 8 * fq;
        const int row0 = u.pm * BM - row_base + wr * 64 + fr;
#pragma unroll
        for (int ai = 0; ai < 2; ++ai)
#pragma unroll
            for (int m = 0; m < 4; ++m)
#pragma unroll
                for (int bj = 0; bj < 2; ++bj) {
                    float* p = P + (size_t)(row0 + ai * HALF + m * 16) * 2048 + colb + bj * HALF;
                    *(f32x4*)p = acc[ai][bj][m][0]; *(f32x4*)(p + 4) = acc[ai][bj][m][1];
                }
    }
};

struct EpiProbe {
    static constexpr bool PERM = true, AFTER_DRAIN = false;
    float* sink; int flag;
    __device__ __forceinline__ void operator()(const f32x4 (&acc)[2][2][4][2], const Unit& u, int wr, int wc, int fr, int fq) const {
        if (flag) {
            f32x4 s = (f32x4){0.f, 0.f, 0.f, 0.f};
#pragma unroll
            for (int ai = 0; ai < 2; ++ai)
#pragma unroll
                for (int bj = 0; bj < 2; ++bj)
#pragma unroll
                    for (int m = 0; m < 4; ++m)
#pragma unroll
                        for (int n = 0; n < 2; ++n) s += acc[ai][bj][m][n];
            *(f32x4*)(sink + (size_t)(u.pm * 8 + u.pn) * 2048 + threadIdx.x * 4) = s;
        }
    }
};
template <class Epi, class Sched, bool ALIGN_EPI = false, bool SP2 = false>
__device__ __forceinline__ void gemm_phase(PG8_LAS unsigned char* lds, const Gemm g, const Sched& S, const Epi& E) {
    const int tid = threadIdx.x, wid = __builtin_amdgcn_readfirstlane(tid >> 6), lane = tid & 63, wr = wid >> 2, wc = wid & 3, fr = lane & 15, fq = lane >> 4;
    const int K = g.K, nt = g.ktn > 0 ? g.ktn : K / BK;
    unsigned voffA[2], voffB[2];
#pragma unroll
    for (int i = 0; i < 2; ++i) { voffA[i] = (unsigned)(wid * 2048 + lane * 16); voffB[i] = voffA[i]; }
    static_assert(Epi::PERM, "the tiled weight copies carry the PERM row order");
    const size_t kstep = 32768;
    const size_t hstepA = 16384, hstepB = 16384;
    const size_t tstepA = (size_t)(K / BK) * 32768, tstepB = tstepA;
    const unsigned ldsw = (unsigned)wid * 2048u;
    const int aoff = lds_byte(wr * 64 + fr, fq * 8), boff = lds_byte(wc * 32 + fr, fq * 8);
#ifndef PG8_DMA_AUX
#define PG8_DMA_AUX 16
#endif
#define PG8_SA(b, h) (((b) * 2 + (h)) * HTB)
#define PG8_SB(b, h) ((4 + (b) * 2 + (h)) * HTB)
#define PG8_STAGE(bufoff, gbase, voff) do { const unsigned* _g = (const unsigned*)((const char*)(gbase) + (voff)[0]); PG8_LAS unsigned* _l = (PG8_LAS unsigned*)(lds + (bufoff) + ldsw); \
        __builtin_amdgcn_global_load_lds(_g, _l, 16, 0, PG8_DMA_AUX); __builtin_amdgcn_global_load_lds(_g, _l, 16, 1024, PG8_DMA_AUX); } while (0)
#define PG8_LDA(dst, b, h) do { _Pragma("unroll") for (int m = 0; m < 4; ++m) _Pragma("unroll") for (int k = 0; k < 2; ++k) dst[m][k] = *(const PG8_LAS bf16x8*)(lds + PG8_SA(b, h) + aoff + m * 2048 + k * 1024); } while (0)
#define PG8_LDB(dst, b, h) do { _Pragma("unroll") for (int n = 0; n < 2; ++n) _Pragma("unroll") for (int k = 0; k < 2; ++k) dst[n][k] = *(const PG8_LAS bf16x8*)(lds + PG8_SB(b, h) + boff + n * 2048 + k * 1024); } while (0)
#define PG8_MMA(ai, bj, At, Bt) do { __builtin_amdgcn_s_setprio(1); _Pragma("unroll") for (int m = 0; m < 4; ++m) _Pragma("unroll") for (int n = 0; n < 2; ++n) _Pragma("unroll") for (int k = 0; k < 2; ++k) \
        acc[ai][bj][m][n] = __builtin_amdgcn_mfma_f32_16x16x32_bf16(Bt[n][k], At[m][k], acc[ai][bj][m][n], 0, 0, 0); __builtin_amdgcn_s_setprio(0); } while (0)
#define PG8_WAIT_V(n) asm volatile("s_waitcnt vmcnt(" #n ")" ::: "memory")
#define PG8_WAIT_L(n) asm volatile("s_waitcnt lgkmcnt(" #n ")" ::: "memory")
#define PG8_BAR __builtin_amdgcn_s_barrier()
#define PG8_SCHED __builtin_amdgcn_sched_barrier(0)
    Unit cur, nxt; int ui = 0;
    if (!S.next(0, cur)) return;
    f32x4 acc[2][2][4][2];
#pragma unroll
    for (int a = 0; a < 2; ++a)
#pragma unroll
        for (int b = 0; b < 2; ++b)
#pragma unroll
            for (int m = 0; m < 4; ++m)
#pragma unroll
                for (int n = 0; n < 2; ++n) acc[a][b][m][n] = (f32x4){0.f, 0.f, 0.f, 0.f};
    bf16x8 At[4][2], B0[2][2], B1[2][2];
    const size_t koff = (size_t)g.kt0 * kstep;
    const char* cA = (const char*)g.A + (size_t)cur.pm * tstepA + koff; const char* cB = (const char*)g.Bt + (size_t)cur.pn * tstepB + koff;
    S.a_ready(cur);
    if constexpr (SP2) {
        PG8_STAGE(PG8_SB(0, 0), cB, voffB); PG8_STAGE(PG8_SB(0, 1), cB + hstepB, voffB); PG8_STAGE(PG8_SA(0, 0), cA, voffA); PG8_STAGE(PG8_SA(0, 1), cA + hstepA, voffA);
        if (wr == 1) PG8_BAR;
        PG8_WAIT_V(2); PG8_BAR;
        PG8_STAGE(PG8_SB(1, 0), cB + kstep, voffB); PG8_STAGE(PG8_SA(1, 0), cA + kstep, voffA); PG8_STAGE(PG8_SB(1, 1), cB + hstepB + kstep, voffB);
        PG8_WAIT_V(6); PG8_BAR;
    } else {
        PG8_STAGE(PG8_SB(0, 0), cB, voffB); PG8_STAGE(PG8_SA(0, 0), cA, voffA); PG8_STAGE(PG8_SB(0, 1), cB + hstepB, voffB); PG8_STAGE(PG8_SA(0, 1), cA + hstepA, voffA);
        if (wr == 1) PG8_BAR;
        PG8_WAIT_V(4); PG8_BAR;
        PG8_STAGE(PG8_SB(1, 0), cB + kstep, voffB); PG8_STAGE(PG8_SA(1, 0), cA + kstep, voffA); PG8_STAGE(PG8_SB(1, 1), cB + hstepB + kstep, voffB);
        PG8_WAIT_V(6); PG8_BAR;
    }
    for (;;) {
        const bool has_next = S.next(ui + 1, nxt);
        const char* nA = has_next ? (const char*)g.A + (size_t)nxt.pm * tstepA + koff : cA; const char* nB = has_next ? (const char*)g.Bt + (size_t)nxt.pn * tstepB + koff : cB;
        for (int t = 0; t < nt; t += 2) {
            const bool last = (t == nt - 2);
            const char* a1 = cA + (size_t)(t + 1) * kstep;
            const char* a2 = last ? nA : cA + (size_t)(t + 2) * kstep; const char* b2 = last ? nB : cB + (size_t)(t + 2) * kstep;
            const char* a3 = a2 + kstep; const char* b3 = b2 + kstep;
            if (last && has_next) S.a_ready(nxt);
            if constexpr (SP2) {
            PG8_LDB(B0, 0, 0); PG8_LDB(B1, 0, 1); PG8_SCHED; PG8_LDA(At, 0, 0); PG8_STAGE(PG8_SA(1, 1), a1 + hstepA, voffA);
            PG8_WAIT_V(8); PG8_WAIT_L(0); PG8_BAR; PG8_MMA(0, 0, At, B0); PG8_MMA(0, 1, At, B1); PG8_BAR; PG8_SCHED;
            PG8_LDA(At, 0, 1); PG8_STAGE(PG8_SB(0, 0), b2, voffB); PG8_STAGE(PG8_SB(0, 1), b2 + hstepB, voffB); PG8_STAGE(PG8_SA(0, 0), a2, voffA);
            PG8_WAIT_V(8); PG8_WAIT_L(0); PG8_BAR; PG8_MMA(1, 0, At, B0); PG8_MMA(1, 1, At, B1); PG8_BAR; PG8_SCHED;
            PG8_LDB(B0, 1, 0); PG8_LDB(B1, 1, 1); PG8_SCHED; PG8_LDA(At, 1, 0); PG8_STAGE(PG8_SA(0, 1), a2 + hstepA, voffA);
            PG8_WAIT_V(8); PG8_WAIT_L(0); PG8_BAR; PG8_MMA(0, 0, At, B0); PG8_MMA(0, 1, At, B1); PG8_BAR; PG8_SCHED;
            PG8_LDA(At, 1, 1); PG8_STAGE(PG8_SB(1, 0), b3, voffB); PG8_STAGE(PG8_SB(1, 1), b3 + hstepB, voffB); PG8_STAGE(PG8_SA(1, 0), a3, voffA);
            PG8_WAIT_V(8); PG8_WAIT_L(0); PG8_BAR; PG8_MMA(1, 0, At, B0); PG8_MMA(1, 1, At, B1); PG8_BAR; PG8_SCHED;
            } else {
            PG8_LDB(B0, 0, 0); PG8_SCHED; PG8_LDA(At, 0, 0); PG8_STAGE(PG8_SA(1, 1), a1 + hstepA, voffA);
            PG8_WAIT_L(8); PG8_BAR; PG8_WAIT_L(0); PG8_MMA(0, 0, At, B0); PG8_BAR; PG8_SCHED;
            PG8_LDB(B1, 0, 1); PG8_STAGE(PG8_SB(0, 0), b2, voffB);
            PG8_BAR; PG8_WAIT_L(0); PG8_MMA(0, 1, At, B1); PG8_BAR;
            PG8_LDA(At, 0, 1); PG8_STAGE(PG8_SA(0, 0), a2, voffA);
            PG8_BAR; PG8_WAIT_L(0); PG8_MMA(1, 0, At, B0); PG8_BAR; PG8_SCHED;
            PG8_STAGE(PG8_SB(0, 1), b2 + hstepB, voffB);
            PG8_WAIT_V(6); PG8_BAR; PG8_MMA(1, 1, At, B1); PG8_BAR;
            PG8_LDB(B0, 1, 0); PG8_SCHED; PG8_LDA(At, 1, 0); PG8_STAGE(PG8_SA(0, 1), a2 + hstepA, voffA);
            PG8_WAIT_L(8); PG8_BAR; PG8_WAIT_L(0); PG8_MMA(0, 0, At, B0); PG8_BAR; PG8_SCHED;
            PG8_LDB(B1, 1, 1); PG8_STAGE(PG8_SB(1, 0), b3, voffB);
            PG8_BAR; PG8_WAIT_L(0); PG8_MMA(0, 1, At, B1); PG8_BAR;
            PG8_LDA(At, 1, 1); PG8_STAGE(PG8_SA(1, 0), a3, voffA);
            PG8_BAR; PG8_WAIT_L(0); PG8_MMA(1, 0, At, B0); PG8_BAR; PG8_SCHED;
            PG8_STAGE(PG8_SB(1, 1), b3 + hstepB, voffB);
            PG8_WAIT_V(6); PG8_BAR; PG8_MMA(1, 1, At, B1); PG8_BAR;
            }
        }
        if constexpr (ALIGN_EPI) { if (wr == 0) PG8_BAR; }
        if constexpr (!Epi::AFTER_DRAIN) { E(acc, cur, wr, wc, fr, fq); S.done(cur); }
        if (!has_next) break;
#pragma unroll
        for (int a = 0; a < 2; ++a)
#pragma unroll
            for (int b = 0; b < 2; ++b)
#pragma unroll
                for (int m = 0; m < 4; ++m)
#pragma unroll
                    for (int n = 0; n < 2; ++n) acc[a][b][m][n] = (f32x4){0.f, 0.f, 0.f, 0.f};
        cur = nxt; cA = nA; cB = nB; ++ui;
        if constexpr (ALIGN_EPI) { if (wr == 1) PG8_BAR; }
    }
    PG8_WAIT_V(0);
    if constexpr (!ALIGN_EPI) { if (wr == 0) PG8_BAR; }
    PG8_BAR;
    if constexpr (Epi::AFTER_DRAIN) { E.fused(acc, cur, wr, wc, fr, fq, lds, wid, lane); S.done(cur); }
#undef PG8_SA
#undef PG8_SB
#undef PG8_STAGE
#undef PG8_LDA
#undef PG8_LDB
#undef PG8_MMA
#undef PG8_WAIT_V
#undef PG8_WAIT_L
#undef PG8_BAR
#undef PG8_SCHED
}
}

constexpr size_t MiB = 1u << 20;
constexpr size_t WS_CTL = 0, CTL_ZERO_BYTES = 1 * MiB;
constexpr size_t WS_W13A = 1 * MiB;
constexpr size_t WS_W2A = WS_W13A + 46 * MiB;
constexpr size_t WS_WIN = WS_W2A + 22 * MiB;
constexpr size_t WS_WOUT = WS_WIN + 31 * MiB;
constexpr size_t WS_W13B = WS_WOUT + 9 * MiB;
constexpr size_t WS_W2B = WS_W13B + 46 * MiB;
constexpr size_t WS_XB = WS_W2B + 22 * MiB;
constexpr size_t WS_SS = WS_XB + 139 * MiB;
constexpr size_t WS_G = WS_SS + 20 * MiB;
constexpr size_t WS_SSEG = WS_G + 3 * MiB;
constexpr size_t WS_NSEG = WS_SSEG + 1 * MiB;
constexpr size_t WS_RSEG = WS_NSEG + 1 * MiB;
constexpr size_t WS_HU = WS_RSEG + 16 * MiB;
constexpr size_t WS_QA = WS_HU, WS_KA = WS_QA + 65 * MiB, WS_VA = WS_KA + 65 * MiB, WS_QKB = WS_VA + 65 * MiB, WS_VB = WS_QKB + 130 * MiB, WS_OB = WS_VB + 65 * MiB;
constexpr size_t WS_END = WS_OB + 65 * MiB;
static_assert((size_t)MROWS * FF * 2 <= 350 * MiB && (size_t)MROWS * LDX * 2 <= 139 * MiB && (size_t)FF2 * LDW * 2 <= 46 * MiB && (size_t)NINP * LDW * 2 <= 31 * MiB && (size_t)DM * LDW * 2 <= 9 * MiB, "d_ws map");
constexpr int CW_BAR = 4096;

constexpr int RING_OFF = 0, RING_BYTES = 131072;
constexpr int LDS_BYTES = 155648;
constexpr int LDSCTL_OFF = LDS_BYTES - 512, MISC_OFF = LDSCTL_OFF + 320;

#define GAS __attribute__((address_space(1)))
#define LAS __attribute__((address_space(3)))
typedef unsigned short bf16;
typedef unsigned v4u __attribute__((ext_vector_type(4)));
typedef unsigned v2u __attribute__((ext_vector_type(2)));
typedef float f32x4 __attribute__((ext_vector_type(4)));
typedef float f32x16 __attribute__((ext_vector_type(16)));
typedef short bf16x8 __attribute__((ext_vector_type(8)));
typedef short s16x4 __attribute__((ext_vector_type(4)));
typedef GAS unsigned gu32;
#define RLX_AGENT __ATOMIC_RELAXED, __HIP_MEMORY_SCOPE_AGENT
#define LDS_WAIT() asm volatile("s_waitcnt lgkmcnt(0)" ::: "memory")
#define VM_WAIT() asm volatile("s_waitcnt vmcnt(0)" ::: "memory")
__device__ __forceinline__ float bf2f(unsigned short b) { return __uint_as_float((unsigned)b << 16); }
__device__ __forceinline__ unsigned pk2(float lo, float hi) { return pg8::cvt_pk_bf16(lo, hi); }
__device__ __forceinline__ unsigned short f2bf(float f) { return (unsigned short)(pg8::cvt_pk_bf16(f, 0.f) & 0xffffu); }
__device__ __forceinline__ int crow(int r, int hi) { return (r & 3) + 8 * (r >> 2) + 4 * hi; }
__device__ __forceinline__ float wave_sum(float v) {
#pragma unroll
    for (int o = 1; o < 64; o <<= 1) v += __shfl_xor(v, o);
    return v;
}
__device__ __forceinline__ float wave_max(float v) {
#pragma unroll
    for (int o = 1; o < 64; o <<= 1) v = fmaxf(v, __shfl_xor(v, o));
    return v;
}
#define MFMA32(a, b, c) __builtin_amdgcn_mfma_f32_32x32x16_bf16(a, b, c, 0, 0, 0)
__device__ __forceinline__ void halves32(float x, float& lo, float& hi) {
    const auto rr = __builtin_amdgcn_permlane32_swap(__float_as_uint(x), __float_as_uint(x), false, false);
    lo = __uint_as_float(rr[0]); hi = __uint_as_float(rr[1]);
}
__device__ __forceinline__ float sum_halves32(float x) { float lo, hi; halves32(x, lo, hi); return lo + hi; }

#define XB_TMO      128
#define XB_XCNT(j)  (256  + 64 * (j))
#define XB_XSUB(j)  (1280 + 64 * (j))
#define XB_XGEN(j)  (2304 + 64 * (j))
#define XB_TOP      3328
#define XB_TOPGEN   3392
#define XCD_BAR_WORDS 3456
#define XB_SPIN_CAP (1u << 18)

__device__ __forceinline__ unsigned xb_ld(unsigned* p)              { return __hip_atomic_load(p, __ATOMIC_RELAXED, __HIP_MEMORY_SCOPE_AGENT); }
__device__ __forceinline__ unsigned xb_add(unsigned* p, unsigned v) { return __hip_atomic_fetch_add(p, v, __ATOMIC_RELAXED, __HIP_MEMORY_SCOPE_AGENT); }
__device__ __forceinline__ unsigned xb_xcc_id() { return (unsigned)__builtin_amdgcn_s_getreg((3 << 11) | 20) & 0xFu; }
#define XB_SPIN(cond, bar) do { unsigned _sp = 0; while (cond) { __builtin_amdgcn_s_sleep(1); \
    if ((++_sp & 255u) == 0u) { if (xb_ld(&(bar)[XB_TMO])) break; if (_sp > XB_SPIN_CAP) { atomicAdd(&(bar)[XB_TMO], 1u); break; } } } } while (0)

struct XcdBarrier {
    unsigned* bar; unsigned x;
    volatile LAS unsigned* st;
};

__device__ __forceinline__ XcdBarrier xcd_barrier_post(unsigned* bar, volatile LAS unsigned* st) {
    XcdBarrier b; b.bar = bar; b.x = xb_xcc_id(); b.st = st;
    if (threadIdx.x == 0) (void)xb_add(&bar[XB_XCNT(b.x)], 1u);
    return b;
}
__device__ __forceinline__ void xcd_barrier_complete(unsigned* bar, unsigned x, unsigned& nloc, unsigned& nx) {
    const unsigned G = gridDim.x * gridDim.y * gridDim.z;
    unsigned sum, cnt, mine, sp = 0u;
    for (;;) {
        sum = 0u; cnt = 0u; mine = 0u;
#pragma unroll
        for (unsigned j = 0; j < 16; ++j) { const unsigned c = xb_ld(&bar[XB_XCNT(j)]); sum += c; cnt += (c > 0u) ? 1u : 0u; mine = (j == x) ? c : mine; }
        if (sum == G) break;
        __builtin_amdgcn_s_sleep(1);
        if ((++sp & 255u) == 0u) { if (xb_ld(&bar[XB_TMO])) break; if (sp > XB_SPIN_CAP) { atomicAdd(&bar[XB_TMO], 1u); break; } }
    }
    nloc = mine > 0u ? mine : 1u; nx = cnt > 0u ? cnt : 1u;
}

__device__ __forceinline__ void xcd_barrier(const XcdBarrier& b) {
    asm volatile("s_waitcnt vmcnt(0)" ::: "memory");
    __syncthreads();
    if (threadIdx.x == 0) {
        unsigned* bar = b.bar;
        __builtin_amdgcn_s_waitcnt(0);
        unsigned nloc = b.st[0], nx = b.st[1];
        if (nloc == 0u) { xcd_barrier_complete(bar, b.x, nloc, nx); b.st[0] = nloc; b.st[1] = nx; }
        const unsigned old = xb_add(&bar[XB_XSUB(b.x)], 1u);
        const unsigned gen = old / nloc;
        if (old + 1u == (gen + 1u) * nloc) {
            __builtin_amdgcn_fence(__ATOMIC_RELEASE, "agent");
            asm volatile("s_waitcnt vmcnt(0)" ::: "memory");
            const unsigned og = xb_add(&bar[XB_TOP], 1u);
            const unsigned tg = og / nx;
            if (og + 1u == (tg + 1u) * nx) xb_add(&bar[XB_TOPGEN], 1u);
            else XB_SPIN(xb_ld(&bar[XB_TOPGEN]) == tg, bar);
            __builtin_amdgcn_fence(__ATOMIC_ACQUIRE, "agent");
            xb_add(&bar[XB_XGEN(b.x)], 1u);
            asm volatile("s_waitcnt vmcnt(0)" ::: "memory");
        } else {
            XB_SPIN(xb_ld(&bar[XB_XGEN(b.x)]) == gen, bar);
            __builtin_amdgcn_fence(__ATOMIC_ACQUIRE, "agent");
            asm volatile("s_waitcnt vmcnt(0)" ::: "memory");
        }
    }
    __syncthreads();
}

struct Args {
    const float* in[26]; float* out; unsigned char* ws; int ph_lo, ph_hi;
};
enum { I_XP = 0, I_XS, I_CK, I_CV, I_SC, I_SN, I_SM, I_SCONV, I_G1, I_F1W1, I_F1W3, I_F1W2, I_GM, I_WIN, I_BIG, I_BFG, I_CONVW, I_CONVB, I_SBG, I_MLG, I_WOUT, I_G2, I_F2W1, I_F2W3, I_F2W2, I_GF };

struct CvtItem { const float* W; const float* gain; bf16* WT; int N, nKT, dst_row0, k0, n0; };
__device__ __forceinline__ void cvt_load(const CvtItem& d, int lane, f32x4 (&v)[8]) {
    const int r8 = lane >> 3, n = d.n0 + 4 * (lane & 7);
#pragma unroll
    for (int i = 0; i < 8; ++i) { const int kk = 8 * i + r8; f32x4 t = (f32x4){0.f, 0.f, 0.f, 0.f};
        if (n < d.N) t = __builtin_nontemporal_load((const f32x4*)(d.W + (size_t)(d.k0 + kk) * d.N + n));
        if (d.gain) t *= d.gain[d.k0 + kk];
        v[i] = t; }
}
__device__ __forceinline__ void cvt_store(const CvtItem& d, LAS float* scr, int lane, const f32x4 (&v)[8]) {
    const int r8 = lane >> 3, c4 = 4 * (lane & 7);
#pragma unroll
    for (int i = 0; i < 8; ++i) { LAS float* s = scr + (8 * i + r8) * 33 + c4; s[0] = v[i][0]; s[1] = v[i][1]; s[2] = v[i][2]; s[3] = v[i][3]; }
    LDS_WAIT(); asm volatile("" ::: "memory");
    const int c = lane & 7;
#pragma unroll
    for (int j = 0; j < 4; ++j) { const int nn = (lane >> 3) + 8 * j; const LAS float* s = scr + (8 * c) * 33 + nn;
        v4u o; o.x = pk2(s[0 * 33], s[1 * 33]); o.y = pk2(s[2 * 33], s[3 * 33]); o.z = pk2(s[4 * 33], s[5 * 33]); o.w = pk2(s[6 * 33], s[7 * 33]);
        *(GAS v4u*)(d.WT + pg8::tiled_elem_b(d.dst_row0 + nn, d.k0 + 8 * c, d.nKT)) = o; }
    LDS_WAIT(); asm volatile("" ::: "memory");
}
__device__ __forceinline__ CvtItem cvt_item(const Args& a, int part, int it) {
    unsigned char* ws = a.ws;
    constexpr int I_UP = (DM / 64) * (FF / 32);
    constexpr int I_DN = (FF / 64) * (DM / 32);
    constexpr int I_IN = (DM / 64) * (NINP / 32);
    const int n_up = part == 2 ? 0 : 2 * I_UP, n_dn = part == 1 ? 0 : I_DN;
    CvtItem d; int r = it;
    if (r < n_up) {
        const int which = r / I_UP; r -= which * I_UP; const int nblk = FF / 32, kb = r / nblk, nb = r % nblk, n0 = 32 * nb;
        d.W = a.in[part == 0 ? (which == 0 ? I_F1W1 : I_F1W3) : (which == 0 ? I_F2W1 : I_F2W3)]; d.gain = a.in[part == 0 ? I_G1 : I_G2];
        d.WT = (bf16*)(ws + (part == 0 ? WS_W13A : WS_W13B)); d.N = FF; d.nKT = DM / 64; d.dst_row0 = 256 * (n0 / 128) + (n0 % 128) + 128 * which; d.k0 = 64 * kb; d.n0 = n0; return d; }
    r -= n_up;
    if (r < n_dn) { const int nblk = DM / 32, kb = r / nblk, nb = r % nblk;
        d.W = a.in[part ? I_F2W2 : I_F1W2]; d.gain = nullptr; d.WT = (bf16*)(ws + (part ? WS_W2B : WS_W2A)); d.N = DM; d.nKT = FF / 64; d.dst_row0 = 32 * nb; d.k0 = 64 * kb; d.n0 = 32 * nb; return d; }
    r -= n_dn;
    if (r < I_IN) { const int nblk = NINP / 32, kb = r / nblk, nb = r % nblk;
        d.W = a.in[I_WIN]; d.gain = a.in[I_GM]; d.WT = (bf16*)(ws + WS_WIN); d.N = NIN; d.nKT = DM / 64; d.dst_row0 = 32 * nb; d.k0 = 64 * kb; d.n0 = 32 * nb; return d; }
    r -= I_IN; { const int nblk = DM / 32, kb = r / nblk, nb = r % nblk;
        d.W = a.in[I_WOUT]; d.gain = nullptr; d.WT = (bf16*)(ws + WS_WOUT); d.N = DM; d.nKT = DM / 64; d.dst_row0 = 32 * nb; d.k0 = 64 * kb; d.n0 = 32 * nb; return d; }
}
__device__ __forceinline__ void convert_weights(const Args& a, LAS unsigned char* lds, int part, int gw, int NGW, int wave, int lane, int it_lo = 0, int it_hi = 1 << 30) {
    LAS float* scr = (LAS float*)(lds + RING_OFF + wave * 16384);
    constexpr int I_UP = (DM / 64) * (FF / 32), I_DN = (FF / 64) * (DM / 32), I_IN = (DM / 64) * (NINP / 32), I_OUT = (DM / 64) * (DM / 32);
    const int full = (part == 2 ? 0 : 2 * I_UP) + (part == 1 ? 0 : I_DN) + (part == 1 ? I_IN + I_OUT : 0), total = it_hi < full ? it_hi : full;
    int it = it_lo + gw; if (it >= total) return;
    CvtItem d = cvt_item(a, part, it); f32x4 v[8]; cvt_load(d, lane, v);
    for (;;) {
        const int itn = it + NGW; const bool more = itn < total;
        CvtItem dn = d; f32x4 vn[8];
#pragma unroll
        for (int i = 0; i < 8; ++i) vn[i] = v[i];
        if (more) { dn = cvt_item(a, part, itn); cvt_load(dn, lane, vn); }
        cvt_store(d, scr, lane, v);
        if (!more) break;
        d = dn; it = itn;
#pragma unroll
        for (int i = 0; i < 8; ++i) v[i] = vn[i];
    }
}
__device__ __forceinline__ void p0_prologue(const Args& a, LAS unsigned char* lds, int vcu, int G, int wave, int lane) {
    const int gw = vcu * 8 + wave, NGW = G * 8;
    unsigned char* ws = a.ws;
    convert_weights(a, lds, 0, gw, NGW, wave, lane);
    bf16* XB = (bf16*)(ws + WS_XB); float* SS0 = (float*)(ws + WS_SS);
    for (int m = gw; m < MROWS; m += NGW) {
        const float* xrow = (m < MP) ? a.in[I_XP] + (size_t)m * DM : a.in[I_XS] + (size_t)(m - MP) * DM;
        const GAS f32x4* xr = (const GAS f32x4*)xrow + lane;
        f32x4 v[8]; float s = 0.f;
#pragma unroll
        for (int j = 0; j < 8; ++j) { v[j] = __builtin_nontemporal_load(xr + 64 * j); s += (v[j].x * v[j].x + v[j].y * v[j].y) + (v[j].z * v[j].z + v[j].w * v[j].w); }
        s = wave_sum(s);
#pragma unroll
        for (int j = 0; j < 8; ++j) { v2u w; w.x = pk2(v[j].x, v[j].y); w.y = pk2(v[j].z, v[j].w); *(GAS v2u*)(XB + pg8::tiled_elem(m, 4 * lane + 256 * j, DM / 64)) = w; }
        if (lane == 0) SS0[m] = 1.0f / sqrtf(s * (1.0f / DM) + EPS);
    }
}

__device__ __forceinline__ void finalize_rstd(const float* SS, float* RS, int gw, int NGW, int lane, int nrows = MROWS) {
    const int hl = lane & 31, hf = lane >> 5;
    constexpr int NB = 9;
    for (int mb = 2 * gw; mb < nrows; mb += NB * 2 * NGW) {
        float s[NB];
#pragma unroll
        for (int k = 0; k < NB; ++k) { const int m = mb + k * 2 * NGW + hf; s[k] = m < nrows ? SS[(size_t)m * 32 + hl] : 0.f; }
#pragma unroll
        for (int k = 0; k < NB; ++k) {
            const int m = mb + k * 2 * NGW + hf;
            float v = s[k];
#pragma unroll
            for (int o = 1; o < 32; o <<= 1) v += __shfl_xor(v, o);
            if (hl == 0 && m < nrows) RS[m] = 1.0f / sqrtf(v * (1.0f / DM) + EPS);
        }
    }
}

__device__ __forceinline__ void final_norm_sample_rows(const Args& a, const float* PART, int gw, int NGW, int lane) {
    const bf16* XB = (const bf16*)(a.ws + WS_XB); const float* gf = a.in[I_GF];
    for (int r = gw; r < MS; r += NGW) {
        const int m = MP + r;
        pg8::f32x4 v[4][2]; float ss = 0.f;
#pragma unroll
        for (int j = 0; j < 4; ++j) {
            const int col = 8 * lane + 512 * j;
            const v4u w = *(const v4u*)(XB + pg8::tiled_elem(m, col, DM / 64));
            const float* p = PART + (size_t)r * DM + col;
            const pg8::f32x4 s0 = *(const pg8::f32x4*)p + *(const pg8::f32x4*)(p + (size_t)MS * DM), s1 = *(const pg8::f32x4*)(p + 4) + *(const pg8::f32x4*)(p + 4 + (size_t)MS * DM);
            v[j][0] = pg8::bf_lo4(w.x, w.y) + s0 * 0.5f; v[j][1] = pg8::bf_lo4(w.z, w.w) + s1 * 0.5f;
#pragma unroll
            for (int e = 0; e < 4; ++e) ss += v[j][0][e] * v[j][0][e] + v[j][1][e] * v[j][1][e];
        }
        const float rstd = 1.0f / sqrtf(wave_sum(ss) * (1.0f / DM) + EPS);
        float* yr = a.out + O_Y + (size_t)m * DM + 8 * lane;
#pragma unroll
        for (int j = 0; j < 4; ++j) { const pg8::f32x4 g0 = *(const pg8::f32x4*)(gf + 8 * lane + 512 * j), g1 = *(const pg8::f32x4*)(gf + 8 * lane + 512 * j + 4);
            *(pg8::f32x4*)(yr + 512 * j) = v[j][0] * rstd * g0; *(pg8::f32x4*)(yr + 512 * j + 4) = v[j][1] * rstd * g1; }
    }
}

template <int NS> __device__ __forceinline__ void reduce_sample_rows(const Args& a, const float* PART, float scale, float* RS, int gw, int NGW, int lane) {
    bf16* XB = (bf16*)(a.ws + WS_XB);
    for (int r = gw; r < MS; r += NGW) {
        const int m = MP + r;
        pg8::f32x4 v[4][2]; float ss = 0.f;
#pragma unroll
        for (int j = 0; j < 4; ++j) {
            const int col = 8 * lane + 512 * j;
            const v4u w = *(const v4u*)(XB + pg8::tiled_elem(m, col, DM / 64));
            const float* p = PART + (size_t)r * DM + col;
            pg8::f32x4 s0 = *(const pg8::f32x4*)p, s1 = *(const pg8::f32x4*)(p + 4);
#pragma unroll
            for (int q = 1; q < NS; ++q) { s0 += *(const pg8::f32x4*)(p + (size_t)q * MS * DM); s1 += *(const pg8::f32x4*)(p + 4 + (size_t)q * MS * DM); }
            v[j][0] = pg8::bf_lo4(w.x, w.y) + s0 * scale; v[j][1] = pg8::bf_lo4(w.z, w.w) + s1 * scale;
#pragma unroll
            for (int e = 0; e < 4; ++e) ss += v[j][0][e] * v[j][0][e] + v[j][1][e] * v[j][1][e];
        }
        const float rstd = 1.0f / sqrtf(wave_sum(ss) * (1.0f / DM) + EPS);
#pragma unroll
        for (int j = 0; j < 4; ++j) *(pg8::u32x4*)(XB + pg8::tiled_elem(m, 8 * lane + 512 * j, DM / 64)) = pg8::pack8(v[j][0], v[j][1]);
        if (lane == 0) RS[m] = rstd;
    }
}

constexpr float CP_EXIT = 8.8817841970012523e-16f;
constexpr int KS_PITCH = 272;
__device__ __forceinline__ float ex2(float x) { return __builtin_amdgcn_exp2f(x); }
__device__ __forceinline__ void sb_tile(f32x16& p0, f32x16& p1, float& cp, bool diag, int kv0, int qpos, int hh) {
    float om0[16], om1[16];
#pragma unroll
    for (int i = 0; i < 16; ++i) {
        { const float E = ex2(fminf(p0[i], 60.f)), rr = __builtin_amdgcn_rcpf(1.f + E); om0[i] = rr; p0[i] = E * rr; }
        { const float E = ex2(fminf(p1[i], 60.f)), rr = __builtin_amdgcn_rcpf(1.f + E); om1[i] = rr; p1[i] = E * rr; }
    }
    if (diag) {
        int rel = qpos - kv0 - 4 * hh; asm volatile("" : "+v"(rel));
#pragma unroll
        for (int i = 0; i < 16; ++i) { const int kvr = (i & 3) + 8 * (i >> 2);
            if (kvr >= rel) { om0[i] = 1.f; p0[i] = 0.f; }
            if (kvr + 32 >= rel) { om1[i] = 1.f; p1[i] = 0.f; } }
    }
    float gp[8], pp[8], T[8], E[8];
#pragma unroll
    for (int g = 0; g < 4; ++g) { gp[g] = (om0[4 * g] * om0[4 * g + 1]) * (om0[4 * g + 2] * om0[4 * g + 3]); gp[4 + g] = (om1[4 * g] * om1[4 * g + 1]) * (om1[4 * g + 2] * om1[4 * g + 3]); }
#pragma unroll
    for (int o = 0; o < 8; ++o) { float lo, hi; halves32(gp[o], lo, hi); pp[o] = hh == 0 ? hi : lo; T[o] = lo * hi; }
    E[7] = cp;
#pragma unroll
    for (int o = 6; o >= 0; --o) E[o] = E[o + 1] * T[o + 1];
    cp = E[0] * T[0];
#pragma unroll
    for (int g = 0; g < 4; ++g) {
        { const float off = E[g] * (hh == 0 ? pp[g] : 1.f); const float s3 = off, s2 = s3 * om0[4 * g + 3], s1 = s2 * om0[4 * g + 2], s0 = s1 * om0[4 * g + 1];
          p0[4 * g + 3] *= s3; p0[4 * g + 2] *= s2; p0[4 * g + 1] *= s1; p0[4 * g] *= s0; }
        { const float off = E[4 + g] * (hh == 0 ? pp[4 + g] : 1.f); const float s3 = off, s2 = s3 * om1[4 * g + 3], s1 = s2 * om1[4 * g + 2], s0 = s1 * om1[4 * g + 1];
          p1[4 * g + 3] *= s3; p1[4 * g + 2] *= s2; p1[4 * g + 1] *= s1; p1[4 * g] *= s0; }
    }
}
__device__ __forceinline__ bf16x8 pack_frag(const f32x16& p, int half) {
    v4u w; w.x = pk2(p[8 * half + 0], p[8 * half + 1]); w.y = pk2(p[8 * half + 2], p[8 * half + 3]); w.z = pk2(p[8 * half + 4], p[8 * half + 5]); w.w = pk2(p[8 * half + 6], p[8 * half + 7]);
    return __builtin_bit_cast(bf16x8, w);
}
constexpr int RP = 320;
__device__ __forceinline__ s16x4 trd(const LAS unsigned char* blk, int pitch, int lane) {
    typedef short v4i16_t __attribute__((ext_vector_type(4)));
    const int i = lane & 15;
    return __builtin_bit_cast(s16x4, __builtin_amdgcn_ds_read_tr16_b64_v4i16((LAS v4i16_t*)(blk + (i >> 2) * pitch + 8 * (i & 3))));
}
__device__ __forceinline__ bf16x8 tr_frag(const LAS unsigned char* tile, int ra, int rb, int cbase, int lane) {
    const int g = (lane >> 4) & 1;
    const s16x4 lo = trd(tile + ra * RP + (cbase + 16 * g) * 2, RP, lane), hi = trd(tile + rb * RP + (cbase + 16 * g) * 2, RP, lane);
    return (bf16x8){lo[0], lo[1], lo[2], lo[3], hi[0], hi[1], hi[2], hi[3]};
}
__device__ __forceinline__ void attn_prompt_pair(const Args& a, LAS unsigned char* lds, int b, int h, int j, int tid, int wave, int lane, int pnext = -1) {
    const bf16* QA = (const bf16*)(a.ws + WS_QA); const bf16* KA = (const bf16*)(a.ws + WS_KA); const bf16* VA = (const bf16*)(a.ws + WS_VA);
    float tq = 0.f, tk = 0.f, tv = 0.f;
    if (pnext >= 0) { const int bhn = pnext >> 5, jn = pnext & 31; const size_t off = ((size_t)(bhn >> 3) * TP + jn * 256 + (tid >> 1)) * GW + (bhn & 7) * HD + (tid & 1) * 64;
        tq = *(const float*)(QA + off); tk = *(const float*)(KA + off); tv = *(const float*)(VA + off); }
    bf16* MRG = (bf16*)(a.out + O_Y);
    const int r = lane & 31, hh = lane >> 5, half = wave >> 2, hw = wave & 3;
    const int t0w = (2 * j + half) * 128 + hw * 32;
    const size_t mrow = (size_t)b * TP + t0w + r;
    f32x16 o[4];
#pragma unroll
    for (int k = 0; k < 4; ++k)
#pragma unroll
        for (int i = 0; i < 16; ++i) o[k][i] = 0.f;
    float cp = 1.f;
    constexpr int ABUF = 64 * KS_PITCH + 64 * RP + 128 * KS_PITCH;
    LAS unsigned char* Ks = lds + half * ABUF; LAS unsigned char* VS = Ks + 64 * KS_PITCH; LAS unsigned char* QS = VS + 64 * RP;
    static_assert(2 * ABUF + 64 <= LDSCTL_OFF, "attention LDS");
    LAS unsigned* DONE = (LAS unsigned*)(lds + 2 * ABUF);
    bool wdone = false;
    const int htid = tid & 255, srow = htid >> 4, sc8 = htid & 15;
    {
        const bf16* qg = QA + ((size_t)b * TP + (2 * j + half) * 128 + srow) * GW + h * HD + 8 * sc8;
#pragma unroll
        for (int i = 0; i < 8; ++i) *(LAS v4u*)(QS + (srow + 16 * i) * KS_PITCH + 16 * sc8) = *(const v4u*)(qg + (size_t)(16 * i) * GW);
    }
    const LAS unsigned char* qrow = QS + (hw * 32 + r) * KS_PITCH + hh * 16;
    const bf16* kg = KA + ((size_t)b * TP + srow) * GW + h * HD + 8 * sc8; const bf16* vg = VA + ((size_t)b * TP + srow) * GW + h * HD + 8 * sc8;
    v4u pk[4], pv[4];
    { const int jt0 = 2 * (2 * j + half) + 1;
#pragma unroll
      for (int i = 0; i < 4; ++i) { pk[i] = *(const v4u*)(kg + (size_t)(64 * jt0 + 16 * i) * GW); pv[i] = *(const v4u*)(vg + (size_t)(64 * jt0 + 16 * i) * GW); } }
    for (int jt = 2 * (2 * j + half) + 1;; --jt) {
        if (jt < 0) wdone = true;
        if (lane == 0) DONE[wave] = wdone ? 1u : 0u;
        __syncthreads();
        { const v4u d0 = *(const LAS v4u*)DONE, d1 = *(const LAS v4u*)(DONE + 4); if ((d0.x & d0.y & d0.z & d0.w & d1.x & d1.y & d1.z & d1.w) != 0u) break; }
        if (jt >= 0) {
            LAS unsigned char* kd = Ks + srow * KS_PITCH + 16 * sc8; LAS unsigned char* vd = VS + srow * RP + 16 * sc8;
#pragma unroll
            for (int i = 0; i < 4; ++i) { *(LAS v4u*)(kd + 16 * i * KS_PITCH) = pk[i]; *(LAS v4u*)(vd + 16 * i * RP) = pv[i]; }
        }
        if (jt >= 1) {
#pragma unroll
            for (int i = 0; i < 4; ++i) { pk[i] = *(const v4u*)(kg + (size_t)(64 * (jt - 1) + 16 * i) * GW); pv[i] = *(const v4u*)(vg + (size_t)(64 * (jt - 1) + 16 * i) * GW); }
        }
        __syncthreads();
        if (!wdone && 64 * jt <= t0w + 30) {
            f32x16 p0, p1;
#pragma unroll
            for (int i = 0; i < 16; ++i) { p0[i] = 0.f; p1[i] = 0.f; }
#pragma unroll
            for (int ks = 0; ks < 8; ++ks) {
                const bf16x8 k0 = *(const LAS bf16x8*)(Ks + r * KS_PITCH + (ks * 16 + hh * 8) * 2);
                const bf16x8 k1 = *(const LAS bf16x8*)(Ks + (32 + r) * KS_PITCH + (ks * 16 + hh * 8) * 2);
                const bf16x8 qf = *(const LAS bf16x8*)(qrow + ks * 32);
                p0 = MFMA32(k0, qf, p0); p1 = MFMA32(k1, qf, p1);
            }
            sb_tile(p0, p1, cp, 64 * jt + 63 >= t0w, 64 * jt, t0w + r, hh);
            bf16x8 af[4]; af[0] = pack_frag(p0, 0); af[1] = pack_frag(p0, 1); af[2] = pack_frag(p1, 0); af[3] = pack_frag(p1, 1);
#pragma unroll
            for (int blk = 0; blk < 4; ++blk)
#pragma unroll
                for (int s = 0; s < 4; ++s) {
                    o[blk] = MFMA32(tr_frag(VS, 16 * s + 4 * hh, 16 * s + 8 + 4 * hh, 32 * blk, lane), af[s], o[blk]);
                }
            wdone = __ballot(cp >= CP_EXIT) == 0ull;
        }
    }
    asm volatile("" :: "v"(tq), "v"(tk), "v"(tv));
    __syncthreads();
    float ss = 0.f;
#pragma unroll
    for (int k = 0; k < 4; ++k)
#pragma unroll
        for (int i = 0; i < 16; ++i) ss += o[k][i] * o[k][i];
    ss = sum_halves32(ss);
    const float rstd = 1.0f / sqrtf(ss * (1.0f / 128.0f) + EPS);
    const float* sbg = a.in[I_SBG] + h * HD;
#pragma unroll
    for (int k = 0; k < 4; ++k)
#pragma unroll
        for (int g = 0; g < 4; ++g) { const int d = 32 * k + 8 * g + 4 * hh; const f32x4 gv = *(const f32x4*)(sbg + d);
            v2u w; w.x = pk2(o[k][4 * g] * rstd * gv[0], o[k][4 * g + 1] * rstd * gv[1]); w.y = pk2(o[k][4 * g + 2] * rstd * gv[2], o[k][4 * g + 3] * rstd * gv[3]);
            *(v2u*)(MRG + pg8::tiled_elem((int)mrow, h * HD + d, DM / 64)) = w; }
}
__device__ __forceinline__ void attn_prompt_phase(const Args& a, LAS unsigned char* lds, int vcu, int G, int tid, int wave, int lane) {
    for (int p = vcu; p < NBP * NH * (TP / 256); p += G) {
        const int bh = p >> 5, j = p & 31;
        attn_prompt_pair(a, lds, bh >> 3, bh & 7, j, tid, wave, lane, p + G < NBP * NH * (TP / 256) ? p + G : -1);
    }
}

constexpr int SEGK = 128;
__device__ __forceinline__ void attn_sample_unit(const Args& a, LAS unsigned char* lds, int b, int h, int tid, int wave, int lane) {
    LAS float* Qs = (LAS float*)lds;
    LAS float* OM = (LAS float*)(lds + 8192);
    LAS float* BT = (LAS float*)(lds + 16384);
    LAS float* RED = (LAS float*)(lds + 24576);
    LAS float* CAR = (LAS float*)(lds + 24576 + 256);
    const bf16* QA = (const bf16*)(a.ws + WS_QA); bf16* MRG = (bf16*)(a.out + O_Y);
    __syncthreads();
    for (int i = tid; i < 16 * 128; i += 512) { const int q = i >> 7, d = i & 127; Qs[i] = bf2f(QA[(size_t)(MP + b * TS + q) * GW + h * HD + d]); }
    __syncthreads();
    const int dch = tid & 127, qg = tid >> 7;
    float oacc[4] = {0.f, 0.f, 0.f, 0.f};
    float carry0 = 1.f, carry1 = 1.f;
    for (int seg = 0; seg <= PAST / SEGK; ++seg) {
        const bool isnew = seg == 0; const int seglen = isnew ? TS : SEGK, kstart = isnew ? 0 : PAST - seg * SEGK;
        {
            float om[4] = {1.f, 1.f, 1.f, 1.f}, bt[4] = {0.f, 0.f, 0.f, 0.f};
            if (dch < seglen) {
                const float* krow = isnew ? a.out + O_KS + ((size_t)(b * TS + dch) * NH + h) * HD : a.in[I_CK] + (((size_t)b * PAST + kstart + dch) * NH + h) * HD;
                float z[4] = {0.f, 0.f, 0.f, 0.f};
#pragma unroll 8
                for (int d4 = 0; d4 < 32; ++d4) { const f32x4 kv = *(const f32x4*)(krow + 4 * d4);
#pragma unroll
                    for (int q = 0; q < 4; ++q) { const f32x4 qv = *(const LAS f32x4*)(Qs + (4 * qg + q) * 128 + 4 * d4); z[q] += (kv[0] * qv[0] + kv[1] * qv[1]) + (kv[2] * qv[2] + kv[3] * qv[3]); } }
#pragma unroll
                for (int q = 0; q < 4; ++q) { const float E = ex2(fminf(z[q], 60.f)), rr = __builtin_amdgcn_rcpf(1.f + E); om[q] = rr; bt[q] = E * rr;
                    if (isnew && dch >= 4 * qg + q) { om[q] = 1.f; bt[q] = 0.f; } }
            }
#pragma unroll
            for (int q = 0; q < 4; ++q) { OM[(4 * qg + q) * SEGK + dch] = om[q]; BT[(4 * qg + q) * SEGK + dch] = bt[q]; }
        }
        __syncthreads();
#pragma unroll
        for (int rr2 = 0; rr2 < 2; ++rr2) { const int q = 2 * wave + rr2; float& carry = rr2 ? carry1 : carry0;
            const float om0 = OM[q * SEGK + 2 * lane], om1 = OM[q * SEGK + 2 * lane + 1], bt0 = BT[q * SEGK + 2 * lane], bt1 = BT[q * SEGK + 2 * lane + 1];
            float inc = om0 * om1;
#pragma unroll
            for (int off = 1; off < 64; off <<= 1) { const float v = __shfl_down(inc, off); if (lane + off < 64) inc *= v; }
            float exc = __shfl_down(inc, 1); if (lane == 63) exc = 1.f;
            const float suf = carry * exc;
            BT[q * SEGK + 2 * lane + 1] = bt1 * suf; BT[q * SEGK + 2 * lane] = bt0 * suf * om1;
            carry = carry * __shfl(inc, 0);
            if (lane == 0) CAR[q] = carry;
        }
        __syncthreads();
        {
            const float* vbase = isnew ? a.out + O_VS + ((size_t)(b * TS) * NH + h) * HD + dch : a.in[I_CV] + (((size_t)b * PAST + kstart) * NH + h) * HD + dch;
            for (int k4 = 0; k4 < seglen; k4 += 4) {
                float v[4];
#pragma unroll
                for (int e = 0; e < 4; ++e) v[e] = vbase[(size_t)(k4 + e) * (NH * HD)];
#pragma unroll
                for (int i = 0; i < 4; ++i) { const f32x4 aw = *(const LAS f32x4*)(BT + (4 * qg + i) * SEGK + k4); oacc[i] += (aw[0] * v[0] + aw[1] * v[1]) + (aw[2] * v[2] + aw[3] * v[3]); }
            }
        }
        float cmax = 0.f;
#pragma unroll
        for (int q4 = 0; q4 < 4; ++q4) { const f32x4 cv = *(const LAS f32x4*)(CAR + 4 * q4); cmax = fmaxf(fmaxf(cmax, fmaxf(cv[0], cv[1])), fmaxf(cv[2], cv[3])); }
        __syncthreads();
        if (cmax < CP_EXIT) break;
    }
#pragma unroll
    for (int i = 0; i < 4; ++i) { const float s = wave_sum(oacc[i] * oacc[i]); if (lane == 0) RED[(4 * qg + i) * 4 + (wave & 1)] = s; }
    __syncthreads();
    const float gsb = a.in[I_SBG][h * HD + dch];
#pragma unroll
    for (int i = 0; i < 4; ++i) { const int q = 4 * qg + i; const float ss = RED[q * 4] + RED[q * 4 + 1]; const float rstd = 1.0f / sqrtf(ss * (1.0f / 128.0f) + EPS);
        MRG[pg8::tiled_elem(MP + b * TS + q, h * HD + dch, DM / 64)] = f2bf(oacc[i] * rstd * gsb); }
}

constexpr int SEGC = 16, NSEGB = (TP / 64) / SEGC, NSEGP = NBP * NH * NSEGB;
constexpr int C0_PITCH = 272;
typedef float f32x2v __attribute__((ext_vector_type(2)));
constexpr int ML_QS = 0, ML_KS = 17408, ML_KT = 34816  , ML_VT = ML_KT + 64 * RP  , ML_C0 = 76288, ML_CWL = 119808, ML_PS = 127520, ML_MLG = 128544, ML_NST = 129056  ;
constexpr int ML_TAB = 132096, TAB_GS = ML_TAB, TAB_CM = ML_TAB + 4096, TAB_BS = ML_TAB + 8192, TAB_WA = ML_TAB + 12288, TAB_SC = ML_TAB + 16384, TAB_M = TAB_SC + 256, ML_TAB_END = TAB_M + 128;
static_assert(ML_TAB >= RING_BYTES && ML_TAB_END <= LDSCTL_OFF, "mLSTM gate tables");
static_assert(ML_VT + 64 * RP <= ML_C0 && ML_C0 + 2 * 64 * RP <= ML_CWL && ML_NST + 512 <= RING_BYTES, "mLSTM LDS map");

struct MUnit { int b, h, nvalid, nch, samp, sid, sg, t0; size_t row0; };
__device__ __forceinline__ MUnit munit_prompt(int seg) { MUnit u; const int bh = seg / NSEGB; u.sg = seg % NSEGB; u.b = bh >> 3; u.h = bh & 7; u.nvalid = 64; u.nch = SEGC; u.samp = 0; u.sid = seg;
    u.t0 = u.sg * SEGC * 64; u.row0 = (size_t)u.b * TP + u.t0; return u; }
__device__ __forceinline__ MUnit munit_sample(int sid) { MUnit u; u.b = sid >> 3; u.h = sid & 7; u.sg = 0; u.nvalid = TS; u.nch = 1; u.samp = 1; u.sid = sid; u.t0 = 0; u.row0 = (size_t)MP + u.b * TS; return u; }

__device__ __forceinline__ void unpack8(const v4u w, float (&x)[8]) {
    x[0] = __uint_as_float(w.x << 16); x[1] = __uint_as_float(w.x & 0xffff0000u); x[2] = __uint_as_float(w.y << 16); x[3] = __uint_as_float(w.y & 0xffff0000u);
    x[4] = __uint_as_float(w.z << 16); x[5] = __uint_as_float(w.z & 0xffff0000u); x[6] = __uint_as_float(w.w << 16); x[7] = __uint_as_float(w.w & 0xffff0000u);
}
__device__ __forceinline__ void load_taps(const bf16* src, int tpos, v4u (&raw)[5]) {
#pragma unroll
    for (int j = 0; j < 5; ++j) { raw[j] = (v4u){0u, 0u, 0u, 0u}; if (tpos + j - 3 >= 0) raw[j] = *(const v4u*)(src + (long)(j - 3) * 2048); }
}
__device__ __forceinline__ void conv8x2(const v4u (&raw)[5], int tpos  , bool samp, const float* hist  , const LAS float* cwl  ,
                                        float sc, float (&o0)[8], float (&o1)[8], float (&x3)[8], float (&x4)[8]) {
    float x[5][8];
#pragma unroll
    for (int j = 0; j < 5; ++j) {
        const int tt = tpos + j - 3;
        unpack8(raw[j], x[j]);
        if (tt < 0 && samp) { const float* sp = hist + (size_t)(3 + tt) * 2048; const f32x4 s0 = *(const f32x4*)sp, s1 = *(const f32x4*)(sp + 4); x[j][0] = s0[0]; x[j][1] = s0[1]; x[j][2] = s0[2]; x[j][3] = s0[3]; x[j][4] = s1[0]; x[j][5] = s1[1]; x[j][6] = s1[2]; x[j][7] = s1[3]; }
    }
    { const f32x4 b0 = *(const LAS f32x4*)(cwl + 4 * 128), b1 = *(const LAS f32x4*)(cwl + 4 * 128 + 4);
#pragma unroll
      for (int e = 0; e < 4; ++e) { o0[e] = b0[e]; o0[4 + e] = b1[e]; o1[e] = b0[e]; o1[4 + e] = b1[e]; } }
#pragma unroll
    for (int j = 0; j < 4; ++j) { const f32x4 w0 = *(const LAS f32x4*)(cwl + j * 128), w1 = *(const LAS f32x4*)(cwl + j * 128 + 4);
#pragma unroll
        for (int e = 0; e < 4; ++e) { o0[e] += w0[e] * x[j][e]; o0[4 + e] += w1[e] * x[j][4 + e]; o1[e] += w0[e] * x[j + 1][e]; o1[4 + e] += w1[e] * x[j + 1][4 + e]; } }
#pragma unroll
    for (int e = 0; e < 8; ++e) { o0[e] = o0[e] * pg8::sigmoid_f(o0[e]) * sc; o1[e] = o1[e] * pg8::sigmoid_f(o1[e]) * sc; x3[e] = x[3][e]; x4[e] = x[4][e]; }
}
__device__ __forceinline__ v4u pack8f(const float (&v)[8]) { v4u w; w.x = pk2(v[0], v[1]); w.y = pk2(v[2], v[3]); w.z = pk2(v[4], v[5]); w.w = pk2(v[6], v[7]); return w; }
__device__ __forceinline__ v4u pack8fs(const float (&v)[8], float s) { v4u w; w.x = pk2(v[0] * s, v[1] * s); w.y = pk2(v[2] * s, v[3] * s); w.z = pk2(v[4] * s, v[5] * s); w.w = pk2(v[6] * s, v[7] * s); return w; }
template <bool OUT> __device__ __forceinline__ void stage_chunk(const Args& a, LAS unsigned char* lds, const MUnit& u, int c, int wkoff, int tid) {
    const LAS float* WA = (const LAS float*)(lds + TAB_WA) + 64 * c;
    const bf16* QKB = (const bf16*)(a.ws + WS_QKB); const bf16* VB = (const bf16*)(a.ws + WS_VB);
    const size_t rowc = u.row0 + 64 * c; const int tc = u.t0 + 64 * c;
    const int c8 = tid & 15, s0 = 2 * (tid >> 4);
    const LAS float* cwq = (const LAS float*)(lds + ML_CWL) + 8 * c8; const LAS float* cwk = cwq + 5 * 128;
    const float* histq = a.in[I_SCONV] + (size_t)u.b * 3 * 2048 + u.h * HD + 8 * c8; const float* histk = histq + 1024;
    const bool lastchunk = OUT && (u.samp || (u.sg == NSEGB - 1 && c == SEGC - 1));
    const v4u z4 = (v4u){0u, 0u, 0u, 0u};
    const bool valid = s0 < u.nvalid;
    LAS unsigned char* qsb = lds + ML_QS + s0 * KS_PITCH + 16 * c8;
    LAS unsigned char* wkb = lds + wkoff + s0 * RP + 16 * c8;
    float* ob = a.out + (u.samp ? O_CVS : O_CVP) + (size_t)u.b * 3 * 2048 + u.h * HD + 8 * c8;
    const bool w0 = lastchunk && s0 >= u.nvalid - 3, w1 = lastchunk && s0 + 1 >= u.nvalid - 3;
    v4u rk[5], rq[5], v0 = z4, v1 = z4;
#pragma unroll
    for (int j = 0; j < 5; ++j) { rk[j] = z4; rq[j] = z4; }
    if (valid) {
        load_taps(QKB + (rowc + s0) * 2048 + 1024 + u.h * HD + 8 * c8, tc + s0, rk);
        if (OUT) load_taps(QKB + (rowc + s0) * 2048 + u.h * HD + 8 * c8, tc + s0, rq);
        v0 = *(const v4u*)(VB + (rowc + s0) * GW + u.h * HD + 8 * c8); v1 = *(const v4u*)(VB + (rowc + s0 + 1) * GW + u.h * HD + 8 * c8);
    }
    {
        v4u k0 = z4, k1 = z4, wk0 = z4, wk1 = z4;
        if (valid) { float o0[8], o1[8], x3[8], x4[8];
            conv8x2(rk, tc + s0, u.samp != 0, histk, cwk, KSCALE, o0, o1, x3, x4);
            wk0 = pack8fs(o0, WA[s0]); wk1 = pack8fs(o1, WA[s0 + 1]);
            if (OUT) { k0 = pack8f(o0); k1 = pack8f(o1);
                if (w0) { float* o = ob + (size_t)(s0 - (u.nvalid - 3)) * 2048 + 1024; *(f32x4*)o = (f32x4){x3[0], x3[1], x3[2], x3[3]}; *(f32x4*)(o + 4) = (f32x4){x3[4], x3[5], x3[6], x3[7]}; }
                if (w1) { float* o = ob + (size_t)(s0 + 1 - (u.nvalid - 3)) * 2048 + 1024; *(f32x4*)o = (f32x4){x4[0], x4[1], x4[2], x4[3]}; *(f32x4*)(o + 4) = (f32x4){x4[4], x4[5], x4[6], x4[7]}; } } }
        if (OUT) { *(LAS v4u*)(qsb + (ML_KS - ML_QS)) = k0; *(LAS v4u*)(qsb + (ML_KS - ML_QS) + KS_PITCH) = k1; }
        *(LAS v4u*)wkb = wk0; *(LAS v4u*)(wkb + RP) = wk1;
        *(LAS v4u*)(wkb + 64 * RP) = v0; *(LAS v4u*)(wkb + 64 * RP + RP) = v1;
    }
    if (OUT) {
        __builtin_amdgcn_sched_barrier(0);
        v4u q0 = z4, q1 = z4;
        if (valid) { float o0[8], o1[8], x3[8], x4[8];
            conv8x2(rq, tc + s0, u.samp != 0, histq, cwq, 1.0f, o0, o1, x3, x4);
            q0 = pack8f(o0); q1 = pack8f(o1);
            if (w0) { float* o = ob + (size_t)(s0 - (u.nvalid - 3)) * 2048; *(f32x4*)o = (f32x4){x3[0], x3[1], x3[2], x3[3]}; *(f32x4*)(o + 4) = (f32x4){x3[4], x3[5], x3[6], x3[7]}; }
            if (w1) { float* o = ob + (size_t)(s0 + 1 - (u.nvalid - 3)) * 2048; *(f32x4*)o = (f32x4){x4[0], x4[1], x4[2], x4[3]}; *(f32x4*)(o + 4) = (f32x4){x4[4], x4[5], x4[6], x4[7]}; } }
        *(LAS v4u*)qsb = q0; *(LAS v4u*)(qsb + KS_PITCH) = q1;
    }
}
__device__ __forceinline__ void load_kv(const Args& a, const MUnit& u, int c, int tid, v4u (&t)[7]) {
    const bf16* QKB = (const bf16*)(a.ws + WS_QKB); const bf16* VB = (const bf16*)(a.ws + WS_VB);
    const size_t rowc = u.row0 + 64 * c; const int tc = u.t0 + 64 * c;
    const int c8 = tid & 15, s0 = 2 * (tid >> 4);
    v4u rk[5]; load_taps(QKB + (rowc + s0) * 2048 + 1024 + u.h * HD + 8 * c8, tc + s0, rk);
#pragma unroll
    for (int j = 0; j < 5; ++j) t[j] = rk[j];
    t[5] = *(const v4u*)(VB + (rowc + s0) * GW + u.h * HD + 8 * c8); t[6] = *(const v4u*)(VB + (rowc + s0 + 1) * GW + u.h * HD + 8 * c8);
}
__device__ __forceinline__ void process_kv(const Args& a, LAS unsigned char* lds, const MUnit& u, int c, int wkoff, int tid, const v4u (&t)[7]) {
    const LAS float* WA = (const LAS float*)(lds + TAB_WA) + 64 * c;
    const int tc = u.t0 + 64 * c, c8 = tid & 15, s0 = 2 * (tid >> 4);
    const LAS float* cwk = (const LAS float*)(lds + ML_CWL) + 8 * c8 + 5 * 128;
    const float* histk = a.in[I_SCONV] + (size_t)u.b * 3 * 2048 + u.h * HD + 8 * c8 + 1024;
    v4u rk[5];
#pragma unroll
    for (int j = 0; j < 5; ++j) rk[j] = t[j];
    float o0[8], o1[8], x3[8], x4[8];
    conv8x2(rk, tc + s0, u.samp != 0, histk, cwk, KSCALE, o0, o1, x3, x4);
    LAS unsigned char* wkb = lds + wkoff + s0 * RP + 16 * c8;
    *(LAS v4u*)wkb = pack8fs(o0, WA[s0]); *(LAS v4u*)(wkb + RP) = pack8fs(o1, WA[s0 + 1]);
    *(LAS v4u*)(wkb + 64 * RP) = t[5]; *(LAS v4u*)(wkb + 64 * RP + RP) = t[6];
}
__device__ __forceinline__ void munit_setup(const Args& a, LAS unsigned char* lds, const MUnit& u, int tid, bool both  ) {
    LAS float* cwl = (LAS float*)(lds + ML_CWL);
    for (int i = tid; i < 2 * 5 * 128; i += 512) { const int qk = i / 640, j = (i % 640) >> 7, d = i & 127;
        cwl[i] = j < 4 ? a.in[I_CONVW][(size_t)j * 2048 + qk * 1024 + u.h * HD + d] : a.in[I_CONVB][qk * 1024 + u.h * HD + d]; }
    for (int i = tid; i < 64 * 4; i += 512) { const int row = i >> 2, q = i & 3; const v4u w = (v4u){q == 0 ? 0x3f80u : 0u, 0u, 0u, 0u};
        *(LAS v4u*)(lds + ML_VT + row * RP + 256 + 16 * q) = w; if (both) *(LAS v4u*)(lds + ML_C0 + 64 * RP + row * RP + 256 + 16 * q) = w; }
    if (tid < 128) ((LAS float*)(lds + ML_MLG))[tid] = a.in[I_MLG][u.h * HD + tid];
}
__device__ __forceinline__ float lane_read(float v, int src) { return __int_as_float(__builtin_amdgcn_ds_bpermute(src << 2, __float_as_int(v))); }
__device__ __forceinline__ void chunk_gates(const float* G, size_t rowc, int nvalid, int h, int lane, float& bs, float& gs, float& Btot, float& Gmax) {
    float ig = -INFINITY, lf = 0.f;
    if (lane < nvalid) { ig = G[(rowc + lane) * 16 + h]; lf = G[(rowc + lane) * 16 + 8 + h]; }
    float x = lf;
#pragma unroll
    for (int off = 1; off < 64; off <<= 1) { const float v = lane_read(x, lane >= off ? lane - off : lane); if (lane >= off) x += v; }
    bs = x; gs = ig - x; Btot = lane_read(x, 63 | (lane & 0));
    float mxv = gs;
#pragma unroll
    for (int off = 1; off < 64; off <<= 1) mxv = fmaxf(mxv, lane_read(mxv, lane ^ off));
    Gmax = mxv;
}
__device__ __forceinline__ void gate_tables(const float* G, LAS unsigned char* lds, const MUnit& u, float m0, int tid, int wave, int lane) {
    for (int c = wave; c < u.nch; c += 8) {
        float bs, gs, Bt, Gm; chunk_gates(G, u.row0 + 64 * c, u.nvalid, u.h, lane, bs, gs, Bt, Gm);
        float cm = gs;
#pragma unroll
        for (int off = 1; off < 64; off <<= 1) { const float v = lane_read(cm, lane >= off ? lane - off : lane); if (lane >= off) cm = fmaxf(cm, v); }
        ((LAS float*)(lds + TAB_GS))[64 * c + lane] = gs; ((LAS float*)(lds + TAB_CM))[64 * c + lane] = cm; ((LAS float*)(lds + TAB_BS))[64 * c + lane] = bs; ((LAS float*)(lds + TAB_WA))[64 * c + lane] = __expf(gs - Gm);
        if (lane == 0) { ((LAS float*)(lds + TAB_SC))[4 * c] = Bt; ((LAS float*)(lds + TAB_SC))[4 * c + 1] = Gm; }
    }
    __syncthreads();
    if (tid == 0) { float m = m0; LAS float* SC = (LAS float*)(lds + TAB_SC); LAS float* M = (LAS float*)(lds + TAB_M); float bsum = 0.f;
        for (int c = 0; c < u.nch; ++c) { M[c] = m; const float Bt = SC[4 * c], Gm = SC[4 * c + 1], mx = fmaxf(m, Gm); SC[4 * c + 2] = __expf(m - mx); SC[4 * c + 3] = __expf(Gm - mx); m = Bt + mx; bsum += Bt; }
        M[u.nch] = m; M[u.nch + 1] = bsum; }
    __syncthreads();
}
__device__ __forceinline__ void state_update(LAS unsigned char* lds, int wkoff, f32x16 (&R)[2], float& nst, float al, float be, int wave, int lane) {
    const int hh = lane >> 5, dkb = wave & 3, dvh = wave >> 2;
    const LAS unsigned char* WK = lds + wkoff; const LAS unsigned char* VS = WK + 64 * RP;
    bf16x8 kf[4];
#pragma unroll
    for (int ks = 0; ks < 4; ++ks) kf[ks] = tr_frag(WK, 16 * ks + 8 * hh, 16 * ks + 8 * hh + 4, dkb * 32, lane);
#pragma unroll
    for (int t = 0; t < 2; ++t) {
        const int dvb = 2 * dvh + t; f32x16 U;
#pragma unroll
        for (int i = 0; i < 16; ++i) U[i] = 0.f;
#pragma unroll
        for (int ks = 0; ks < 4; ++ks) U = MFMA32(tr_frag(VS, 16 * ks + 8 * hh, 16 * ks + 8 * hh + 4, dvb * 32, lane), kf[ks], U);
#pragma unroll
        for (int i = 0; i < 16; ++i) R[t][i] = al * R[t][i] + be * U[i];
    }
    if (dvh == 0) { f32x16 U;
#pragma unroll
        for (int i = 0; i < 16; ++i) U[i] = 0.f;
#pragma unroll
        for (int ks = 0; ks < 4; ++ks) U = MFMA32(tr_frag(VS, 16 * ks + 8 * hh, 16 * ks + 8 * hh + 4, 128, lane), kf[ks], U);
        nst = al * nst + be * U[0]; }
}
__device__ __forceinline__ void mlstm_summary_unit(const Args& a, LAS unsigned char* lds, int seg, int tid, int wave, int lane) {
    asm volatile("" : "+v"(tid), "+v"(lane));
    const MUnit u = munit_prompt(seg);
    const float* G = (const float*)(a.ws + WS_G);
    __syncthreads();
    munit_setup(a, lds, u, tid, true);
    gate_tables(G, lds, u, -INFINITY, tid, wave, lane);
    f32x16 R[2]; float nst = 0.f;
#pragma unroll
    for (int t = 0; t < 2; ++t)
#pragma unroll
        for (int i = 0; i < 16; ++i) R[t][i] = 0.f;
    v4u cur[7]; load_kv(a, u, 0, tid, cur);
    for (int cl = 0; cl < SEGC; ++cl) {
        int c = cl; asm volatile("" : "+s"(c));
        int tidc = tid, lanec = lane; asm volatile("" : "+v"(tidc), "+v"(lanec));
        const int tid = tidc, lane = lanec;
        const int ktoff = (c & 1) ? ML_C0 : ML_KT;
        v4u nxt[7];
#pragma unroll
        for (int j = 0; j < 7; ++j) nxt[j] = cur[j];
        if (c + 1 < SEGC) load_kv(a, u, c + 1, tid, nxt);
        process_kv(a, lds, u, c, ktoff, tid, cur);
#pragma unroll
        for (int j = 0; j < 7; ++j) cur[j] = nxt[j];
        __syncthreads();
        const LAS float* SC = (const LAS float*)(lds + TAB_SC) + 4 * c;
        state_update(lds, ktoff, R, nst, SC[2], SC[3], wave, lane);
    }
    const float Bseg = ((const LAS float*)(lds + TAB_M))[SEGC + 1], m_run = ((const LAS float*)(lds + TAB_M))[SEGC];
    int r = lane & 31; asm volatile("" : "+v"(r));
    const int hh = lane >> 5, dkb = wave & 3, dvh = wave >> 2;
    float* RS = (float*)(a.ws + WS_RSEG) + (size_t)seg * 16384 + wave * 2048 + hh * 32 + r;
#pragma unroll
    for (int t = 0; t < 2; ++t)
#pragma unroll
        for (int i = 0; i < 16; ++i) RS[(t * 16 + i) * 64] = R[t][i];
    if (dvh == 0 && hh == 0) ((float*)(a.ws + WS_NSEG))[(size_t)seg * 128 + dkb * 32 + r] = nst;
    if (tid == 0) { float* SS = (float*)(a.ws + WS_SSEG); SS[2 * seg] = Bseg; SS[2 * seg + 1] = m_run; }
}
__device__ __forceinline__ void mlstm_out_unit(const Args& a, LAS unsigned char* lds, const MUnit u, int tid, int wave, int lane) {
    asm volatile("" : "+v"(tid), "+v"(lane));
    const float* G = (const float*)(a.ws + WS_G);
    LAS float* PS = (LAS float*)(lds + ML_PS);
    LAS unsigned char* C0 = lds + ML_C0; LAS unsigned char* VT = lds + ML_VT;
    const bf16* OB = (const bf16*)(a.ws + WS_OB); bf16* MRG = (bf16*)(a.out + O_Y);
    const int r = lane & 31, hh = lane >> 5, dkb = wave & 3, dvh = wave >> 2;
    __syncthreads();
    munit_setup(a, lds, u, tid, false);
    f32x16 R[2]; float nst = 0.f, m_run = 0.f;
#pragma unroll
    for (int t = 0; t < 2; ++t)
#pragma unroll
        for (int i = 0; i < 16; ++i) R[t][i] = 0.f;
    if (u.samp) {
        const float* c0p = a.in[I_SC] + (size_t)u.sid * 16384;
#pragma unroll
        for (int t = 0; t < 2; ++t)
#pragma unroll
            for (int g = 0; g < 4; ++g) { const f32x4 v = *(const f32x4*)(c0p + (size_t)(dkb * 32 + r) * HD + (2 * dvh + t) * 32 + 8 * g + 4 * hh); R[t][4 * g] = v[0]; R[t][4 * g + 1] = v[1]; R[t][4 * g + 2] = v[2]; R[t][4 * g + 3] = v[3]; }
        nst = a.in[I_SN][(size_t)u.sid * 128 + dkb * 32 + r]; m_run = a.in[I_SM][u.sid];
    } else {
        const float* SSG = (const float*)(a.ws + WS_SSEG);
        const float* RSb = (const float*)(a.ws + WS_RSEG) + (size_t)(u.sid - u.sg) * 16384 + wave * 2048 + lane;
        const float* NSb = (const float*)(a.ws + WS_NSEG) + (size_t)(u.sid - u.sg) * 128 + dkb * 32 + r;
        const float* SGb = SSG + 2 * (u.sid - u.sg);
        f32x16 Rs[2]; float ns = 0.f, Bs = 0.f, ml = 0.f;
        if (u.sg > 0) {
#pragma unroll
            for (int t = 0; t < 2; ++t)
#pragma unroll
                for (int i = 0; i < 16; ++i) Rs[t][i] = RSb[(t * 16 + i) * 64];
            ns = NSb[0]; Bs = SGb[0]; ml = SGb[1];
        }
        for (int sp = 0; sp < u.sg; ++sp) {
            f32x16 Rn[2]; float nsn = 0.f, Bsn = 0.f, mln = 0.f;
            if (sp + 1 < u.sg) {
                const float* RS = RSb + (size_t)(sp + 1) * 16384;
#pragma unroll
                for (int t = 0; t < 2; ++t)
#pragma unroll
                    for (int i = 0; i < 16; ++i) Rn[t][i] = RS[(t * 16 + i) * 64];
                nsn = NSb[(sp + 1) * 128]; Bsn = SGb[2 * (sp + 1)]; mln = SGb[2 * (sp + 1) + 1];
            } else {
#pragma unroll
                for (int t = 0; t < 2; ++t)
#pragma unroll
                    for (int i = 0; i < 16; ++i) Rn[t][i] = 0.f;
            }
            const float mx = fmaxf(Bs + m_run, ml), al = __expf(Bs + m_run - mx), be = __expf(ml - mx);
#pragma unroll
            for (int t = 0; t < 2; ++t)
#pragma unroll
                for (int i = 0; i < 16; ++i) R[t][i] = al * R[t][i] + be * Rs[t][i];
            nst = al * nst + be * ns; m_run = mx;
#pragma unroll
            for (int t = 0; t < 2; ++t)
#pragma unroll
                for (int i = 0; i < 16; ++i) Rs[t][i] = Rn[t][i];
            ns = nsn; Bs = Bsn; ml = mln;
        }
    }
    gate_tables(G, lds, u, m_run, tid, wave, lane);
#pragma unroll
    for (int t = 0; t < 2; ++t)
#pragma unroll
        for (int i = 0; i < 16; ++i) *(LAS unsigned short*)(C0 + ((2 * dvh + t) * 32 + crow(i, hh)) * C0_PITCH + (dkb * 32 + r) * 2) = f2bf(R[t][i]);
    if (dvh == 0 && hh == 0) ((LAS float*)(lds + ML_NST))[dkb * 32 + r] = nst;
    const int tt = wave & 1, dvb = wave >> 1;
    const int t = 32 * tt + r; const bool tvalid = t < u.nvalid;
    const LAS float* mlg = (const LAS float*)(lds + ML_MLG);
    for (int cl = 0; cl < u.nch; ++cl) {
        int c = cl; asm volatile("" : "+s"(c));
        int tidc = tid, lanec = lane; asm volatile("" : "+v"(tidc), "+v"(lanec));
        const int tid = tidc, lane = lanec, r = lane & 31, hh = lane >> 5, t = 32 * tt + r; const bool tvalid = t < u.nvalid;
        const size_t rowc = u.row0 + 64 * c;
        const LAS float* GS = (const LAS float*)(lds + TAB_GS) + 64 * c;
        stage_chunk<true>(a, lds, u, c, ML_KT, tid);
        float touch = 0.f;
        if (cl + 1 < u.nch) { const size_t rn = rowc + 64 + (tid & 63); const int part = tid >> 6;
            const bf16* tb = part < 4 ? (const bf16*)(a.ws + WS_QKB) + rn * 2048 + (part >> 1) * 1024 + u.h * HD : (part < 6 ? (const bf16*)(a.ws + WS_VB) : OB) + rn * GW + u.h * HD;
            touch = *(const float*)(tb + (part & 1) * 64); }
        v2u ow[4];
#pragma unroll
        for (int g = 0; g < 4; ++g) { ow[g] = (v2u){0u, 0u}; if (tvalid) ow[g] = *(const v2u*)(OB + (rowc + t) * GW + u.h * HD + 32 * dvb + 8 * g + 4 * hh); }
        __syncthreads();
        const float m0c = ((const LAS float*)(lds + TAB_M))[c]; const float Mt = fmaxf(m0c, ((const LAS float*)(lds + TAB_CM))[64 * c + t]), it = __expf(m0c - Mt), et = __expf(-(((const LAS float*)(lds + TAB_BS))[64 * c + t] + Mt));
        f32x16 S0, S1, Nn; float dq = 0.f;
#pragma unroll
        for (int i = 0; i < 16; ++i) { S0[i] = 0.f; S1[i] = 0.f; Nn[i] = 0.f; }
        {
#pragma unroll
            for (int ks = 0; ks < 8; ++ks) {
                const bf16x8 qf = *(const LAS bf16x8*)(lds + ML_QS + t * KS_PITCH + (ks * 16 + hh * 8) * 2);
                const bf16x8 k0 = *(const LAS bf16x8*)(lds + ML_KS + r * KS_PITCH + (ks * 16 + hh * 8) * 2);
                S0 = MFMA32(k0, qf, S0);
                if (tt == 1) { const bf16x8 k1 = *(const LAS bf16x8*)(lds + ML_KS + (32 + r) * KS_PITCH + (ks * 16 + hh * 8) * 2); S1 = MFMA32(k1, qf, S1); }
            }
#pragma unroll
            for (int ks = 0; ks < 8; ++ks) { float f[8]; unpack8(*(const LAS v4u*)(lds + ML_QS + t * KS_PITCH + (ks * 16 + hh * 8) * 2), f);
                const f32x4 n0 = *(const LAS f32x4*)(lds + ML_NST + (ks * 16 + hh * 8) * 4), n1 = *(const LAS f32x4*)(lds + ML_NST + (ks * 16 + hh * 8) * 4 + 16);
#pragma unroll
                for (int e = 0; e < 8; ++e) f[e] *= it;
                dq += ((f[0] * n0[0] + f[1] * n0[1]) + (f[2] * n0[2] + f[3] * n0[3])) + ((f[4] * n1[0] + f[5] * n1[1]) + (f[6] * n1[2] + f[7] * n1[3]));
                const bf16x8 qs = __builtin_bit_cast(bf16x8, pack8f(f));
                const bf16x8 c0 = *(const LAS bf16x8*)(C0 + (32 * dvb + r) * C0_PITCH + (ks * 16 + hh * 8) * 2); Nn = MFMA32(c0, qs, Nn);
                if (ks & 1) __builtin_amdgcn_sched_barrier(0); }
        }
#pragma unroll
        for (int i = 0; i < 16; ++i) { const int s = crow(i, hh);
            S0[i] = (s <= t) ? S0[i] * __expf(GS[s] - Mt) : 0.f;
            S1[i] = (s + 32 <= t) ? S1[i] * __expf(GS[s + 32] - Mt) : 0.f;
            dq += S0[i] + S1[i]; }
        {
            bf16x8 sf[4]; sf[0] = pack_frag(S0, 0); sf[1] = pack_frag(S0, 1); sf[2] = pack_frag(S1, 0); sf[3] = pack_frag(S1, 1);
            const int nks = tt == 1 ? 4 : 2;
#pragma unroll
            for (int s = 0; s < 4; ++s) if (s < nks) {
                Nn = MFMA32(tr_frag(VT, 16 * s + 4 * hh, 16 * s + 8 + 4 * hh, 32 * dvb, lane), sf[s], Nn);
            }
        }
        const float den = sum_halves32(dq);
        const float inv = 1.0f / fmaxf(fabsf(den), et);
        float y[16]; float ss = 0.f;
#pragma unroll
        for (int g = 0; g < 4; ++g) { const int dv = 32 * dvb + 8 * g + 4 * hh;
            y[4 * g] = Nn[4 * g] * inv * __uint_as_float(ow[g].x << 16); y[4 * g + 1] = Nn[4 * g + 1] * inv * __uint_as_float(ow[g].x & 0xffff0000u);
            y[4 * g + 2] = Nn[4 * g + 2] * inv * __uint_as_float(ow[g].y << 16); y[4 * g + 3] = Nn[4 * g + 3] * inv * __uint_as_float(ow[g].y & 0xffff0000u);
            ss += (y[4 * g] * y[4 * g] + y[4 * g + 1] * y[4 * g + 1]) + (y[4 * g + 2] * y[4 * g + 2] + y[4 * g + 3] * y[4 * g + 3]); }
        ss = sum_halves32(ss);
        if (hh == 0) PS[dvb * 64 + t] = ss;
        { const LAS float* SC = (const LAS float*)(lds + TAB_SC) + 4 * c; state_update(lds, ML_KT, R, nst, SC[2], SC[3], wave, lane); }
        asm volatile("" :: "v"(touch));
        __syncthreads();
        const float tot = (PS[t] + PS[64 + t]) + (PS[128 + t] + PS[192 + t]);
        const float rstd = 1.0f / sqrtf(tot * (1.0f / 128.0f) + EPS);
        if (tvalid) {
#pragma unroll
            for (int g = 0; g < 4; ++g) { const int dv = 32 * dvb + 8 * g + 4 * hh; const f32x4 gv = *(const LAS f32x4*)(mlg + dv);
                v2u w; w.x = pk2(y[4 * g] * rstd * gv[0], y[4 * g + 1] * rstd * gv[1]); w.y = pk2(y[4 * g + 2] * rstd * gv[2], y[4 * g + 3] * rstd * gv[3]);
                *(v2u*)(MRG + pg8::tiled_elem((int)(rowc + t), GW + u.h * HD + dv, DM / 64)) = w; }
        }
        if (c + 1 < u.nch) {
#pragma unroll
            for (int tI = 0; tI < 2; ++tI)
#pragma unroll
                for (int i = 0; i < 16; ++i) *(LAS unsigned short*)(C0 + ((2 * dvh + tI) * 32 + crow(i, hh)) * C0_PITCH + (dkb * 32 + r) * 2) = f2bf(R[tI][i]);
            if (dvh == 0 && hh == 0) ((LAS float*)(lds + ML_NST))[dkb * 32 + r] = nst;
        }
    }
    if (u.samp || u.sg == NSEGB - 1) {
        int lanef = lane; asm volatile("" : "+v"(lanef));
        const int r = lanef & 31, hh = lanef >> 5;
        float* oc = a.out + (u.samp ? O_CS + (size_t)u.sid * 16384 : O_CP + (size_t)(u.b * NH + u.h) * 16384);
#pragma unroll
        for (int tI = 0; tI < 2; ++tI)
#pragma unroll
            for (int g = 0; g < 4; ++g) *(f32x4*)(oc + (size_t)(dkb * 32 + r) * HD + (2 * dvh + tI) * 32 + 8 * g + 4 * hh) = (f32x4){R[tI][4 * g], R[tI][4 * g + 1], R[tI][4 * g + 2], R[tI][4 * g + 3]};
        if (dvh == 0 && hh == 0) a.out[(u.samp ? O_NS + (size_t)u.sid * 128 : O_NP + (size_t)(u.b * NH + u.h) * 128) + dkb * 32 + r] = nst;
        if (tid == 0) a.out[u.samp ? O_MS + u.sid : O_MP + u.b * NH + u.h] = ((const LAS float*)(lds + TAB_M))[u.nch];
    }
}

__device__ __forceinline__ void final_norm_rows(const Args& a, int row_lo, int row_hi, int gw, int NGW, int lane) {
    const float* gf = a.in[I_GF];
    const bf16* XB = (const bf16*)(a.ws + WS_XB); const float* SS3 = (const float*)(a.ws + WS_SS + 15 * MiB);
    for (int m = row_hi - 1 - gw; m >= row_lo; m -= NGW) {
        float s = lane < 32 ? SS3[(size_t)m * 32 + lane] : 0.f;
        const float rstd = 1.0f / sqrtf(wave_sum(s) * (1.0f / DM) + EPS);

        float* yr = a.out + O_Y + (size_t)m * DM + 8 * lane;
#pragma unroll
        for (int j = 0; j < 4; ++j) { const v4u w = __builtin_nontemporal_load((const v4u*)(XB + pg8::tiled_elem(m, 8 * lane + 512 * j, DM / 64))); const f32x4 g0 = *(const f32x4*)(gf + 8 * lane + 512 * j), g1 = *(const f32x4*)(gf + 8 * lane + 512 * j + 4);
            f32x4 o0, o1; o0[0] = __uint_as_float(w.x << 16); o0[1] = __uint_as_float(w.x & 0xffff0000u); o0[2] = __uint_as_float(w.y << 16); o0[3] = __uint_as_float(w.y & 0xffff0000u);
            o1[0] = __uint_as_float(w.z << 16); o1[1] = __uint_as_float(w.z & 0xffff0000u); o1[2] = __uint_as_float(w.w << 16); o1[3] = __uint_as_float(w.w & 0xffff0000u);
            __builtin_nontemporal_store(o0 * rstd * g0, (f32x4*)(yr + 512 * j)); __builtin_nontemporal_store(o1 * rstd * g1, (f32x4*)(yr + 512 * j + 4)); }
    }
}


#ifndef ORD_SHARED
#define ORD_SHARED true
#endif
#define ORD_C (ORD_SHARED ? ((G % 8 == 0) ? (bx % 8) * (G / 8) + bx / 8 : bx) : bx)
#ifndef ORD_REV
#define ORD_REV true
#endif
#ifndef SPLIT_P6
#define SPLIT_P6 true
#endif
#ifndef SPLIT_P2
#define SPLIT_P2 true
#endif
#ifndef WGM_UP
#define WGM_UP 4
#endif
#ifndef WGM_DN
#define WGM_DN 4
#endif
#ifndef WGM_IN
#define WGM_IN 4
#endif
template <bool DIRECT> __device__ __forceinline__ void ph_ffn_up(LAS unsigned char* lds, const bf16* A, const bf16* W13, bf16* H, const float* SS, int G, int bx, bool rev = ORD_REV) {
    pg8::Gemm g{A, W13, MROWS, FF2, DM}; pg8::StaticOrder S; S.init(MROWS, FF2, G, ORD_C, WGM_UP); S.shared_a = ORD_SHARED; S.rev = rev;
    pg8::EpiSwiGLU<DIRECT> E{H, FF, SS};
    pg8::gemm_phase<pg8::EpiSwiGLU<DIRECT>, pg8::StaticOrder, true, true>(lds + RING_OFF, g, S, E);
}
__device__ __forceinline__ void ph_resid(LAS unsigned char* lds, const bf16* A, const bf16* Wt, int K, bf16* X, float* SSout, float scale, int G, int bx) {
    pg8::Gemm g{A, Wt, MROWS, DM, K}; pg8::StaticOrder S; S.init(MROWS, DM, G, ORD_C, WGM_DN); S.shared_a = ORD_SHARED;
    pg8::EpiResid E{X, X, SSout, scale, DM};
    pg8::gemm_phase<pg8::EpiResid, pg8::StaticOrder, true, true>(lds + RING_OFF, g, S, E);
}
__device__ __forceinline__ void ph_resid_prompt(LAS unsigned char* lds, const bf16* A, const bf16* Wt, int K, bf16* X, float* SSout, float scale, int G, int bx) {
    pg8::Gemm g{A, Wt, MP, DM, K}; pg8::StaticOrder S; S.init(MP, DM, G, ORD_C, WGM_DN); S.shared_a = ORD_SHARED;
    pg8::EpiResid E{X, X, SSout, scale, DM};
    pg8::gemm_phase<pg8::EpiResid, pg8::StaticOrder, true, true>(lds + RING_OFF, g, S, E);
}
template <int NS> __device__ __forceinline__ void ph_tail_splitk(LAS unsigned char* lds, const bf16* A, const bf16* Wt, int K, float* PART, int q) {
    const int unit = q / NS, sp = q % NS, nkt = K / 64, per = (((nkt + NS - 1) / NS) + 1) & ~1, kt0 = sp * per;
    pg8::Gemm g{A, Wt, MROWS, DM, K, kt0, (nkt - kt0) < per ? (nkt - kt0) : per}; pg8::SingleOrder S{MP / 256 + (unit >> 3), unit & 7};
    pg8::EpiPartial E{PART + (size_t)sp * MS * DM, MP};
    pg8::gemm_phase<pg8::EpiPartial, pg8::SingleOrder, true, true>(lds + RING_OFF, g, S, E);
}
__device__ __forceinline__ void ph_inproj(const Args& args, LAS unsigned char* lds, const bf16* A, const float* SS, int G, int bx) {
    unsigned char* ws = args.ws;
    pg8::Gemm g{A, (const bf16*)(ws + WS_WIN), MROWS, NINP, DM}; pg8::StaticOrder S; S.init(MROWS, NINP, G, ORD_C, WGM_IN); S.shared_a = ORD_SHARED; S.rev = ORD_REV;
    pg8::EpiInProj E{SS, (bf16*)(ws + WS_QA), (bf16*)(ws + WS_KA), (bf16*)(ws + WS_VA), (bf16*)(ws + WS_QKB), (bf16*)(ws + WS_VB), (bf16*)(ws + WS_OB),
                     args.out + O_KP, args.out + O_VP, args.out + O_KS, args.out + O_VS, (float*)(ws + WS_G), args.in[I_BIG], args.in[I_BFG], MP, QSCALE};
    pg8::gemm_phase<pg8::EpiInProj, pg8::StaticOrder, true, true>(lds + RING_OFF, g, S, E);
}

__device__ __forceinline__ void ph_probe(LAS unsigned char* lds, const bf16* A, const bf16* Wt, int N, int K, float* sink, int flag, int G, int bx) {
    pg8::Gemm g{A, Wt, MROWS, N, K}; pg8::StaticOrder S; S.init(MROWS, N, G, bx);
    pg8::EpiProbe E{sink, flag};
    pg8::gemm_phase<pg8::EpiProbe, pg8::StaticOrder, true, true>(lds + RING_OFF, g, S, E);
}

constexpr int NPHASE = 10;
#ifndef PROBE_REP
#define PROBE_REP 0
#endif
#define NREP(k) (1 + ((PROBE_REP >> (k)) & 1))
#define BARX() do { if (MK_N_LAUNCHES == 1) xcd_barrier(bar); } while (0)
__global__ void __launch_bounds__(512, 2) hymba_fwd(Args args) {
    extern __shared__ __attribute__((aligned(16))) unsigned char lds_raw[];
    LAS unsigned char* lds = (LAS unsigned char*)lds_raw;
    volatile LAS unsigned* MISC = (volatile LAS unsigned*)(lds + MISC_OFF);
    const int tid = threadIdx.x, lane = tid & 63, wave = __builtin_amdgcn_readfirstlane(tid >> 6);
    const int G = gridDim.x; const int bx = blockIdx.x; const int vcu = (G % 8 == 0) ? (bx % 8) * (G / 8) + bx / 8 : bx;
    unsigned char* ws = args.ws;
    gu32* ctl = (gu32*)(ws + WS_CTL);
    for (int u = tid; u < (LDS_BYTES - LDSCTL_OFF) / 4; u += 512) ((LAS unsigned*)(lds + LDSCTL_OFF))[u] = 0u;
    __syncthreads();
    XcdBarrier bar; bar.bar = (unsigned*)(ctl + CW_BAR); bar.x = 0; bar.st = nullptr;
    if (MK_N_LAUNCHES == 1) bar = xcd_barrier_post((unsigned*)(ctl + CW_BAR), MISC + 8);
    const int lo = args.ph_lo, hi = args.ph_hi;
#define IN(k) (lo <= (k) && (k) < hi)
#define SEAM(k) do { if (MK_N_LAUNCHES == 1 && IN(k) && IN((k) + 1)) xcd_barrier(bar); } while (0)
    bf16* XB = (bf16*)(ws + WS_XB); bf16* HB = (bf16*)(ws + WS_HU); bf16* MRG = (bf16*)(args.out + O_Y);
    float* SS0 = (float*)(ws + WS_SS); float* SS1 = (float*)(ws + WS_SS + 5 * MiB); float* SS2 = (float*)(ws + WS_SS + 10 * MiB); float* SS3 = (float*)(ws + WS_SS + 15 * MiB);
    float* RS1 = SS1 + (size_t)MROWS * 32; float* RS2 = SS2 + (size_t)MROWS * 32;
    const bool SPLITK = (MK_N_LAUNCHES == 1 && G == 256);
    constexpr int NSPL2 = 4, NSPL6 = 4;
    const int tq_x = vcu >> 5, tq_j = vcu & 31;
#define TAIL_CU(NS) (tq_j < 2 * (NS))
#define TAIL_Q(NS) (tq_x * 2 * (NS) + tq_j)
#define SIDE_I(NS) (tq_x * (32 - 2 * (NS)) + tq_j - 2 * (NS))
#define NSIDE(NS) (256 - 16 * (NS))
    float* PART = (float*)(ws + WS_RSEG);

    if (IN(0)) { p0_prologue(args, lds, vcu, G, wave, lane); if (NREP(0) == 2) p0_prologue(args, lds, vcu, G, wave, lane); } SEAM(0);
    constexpr int CV1_UP = 1536, CV3_UP = 5504;
    if (IN(1)) { ph_ffn_up<true>(lds, XB, (const bf16*)(ws + WS_W13A), HB, SS0, G, bx);
                 if (SPLITK) { const int nun = (MROWS / 256) * (FF2 / 256), nlast = nun - (nun / G) * G;
                     if (nlast > 0 && vcu >= nlast) { convert_weights(args, lds, 1, (vcu - nlast) * 8 + wave, (G - nlast) * 8, wave, lane, 18432, 20480); convert_weights(args, lds, 1, (vcu - nlast) * 8 + wave, (G - nlast) * 8, wave, lane, 0, CV1_UP); } } if (NREP(12) == 2) ph_ffn_up<true>(lds, XB, (const bf16*)(ws + WS_W13A), HB, SS0, G, bx); if (NREP(1) == 2) ph_probe(lds, XB, (const bf16*)(ws + WS_W13A), FF2, DM, (float*)(ws + WS_RSEG), args.ph_lo < 0, G, bx); } SEAM(1);
    if (IN(2) && SPLITK && SPLIT_P2) { ph_resid_prompt(lds, HB, (const bf16*)(ws + WS_W2A), FF, XB, SS1, 0.5f, G, bx);
                 if (TAIL_CU(NSPL2)) ph_tail_splitk<NSPL2>(lds, HB, (const bf16*)(ws + WS_W2A), FF, PART, TAIL_Q(NSPL2));
                 else convert_weights(args, lds, 1, SIDE_I(NSPL2) * 8 + wave, NSIDE(NSPL2) * 8, wave, lane, CV1_UP + CV3_UP, 18432); }
    else if (IN(2)) { ph_resid(lds, HB, (const bf16*)(ws + WS_W2A), FF, XB, SS1, 0.5f, G, bx);
                 { const int nun = (MROWS / 256) * (DM / 256), nfull = nun / G, nlast = nun - nfull * G;
                   const int oc = ORD_C;
                   if (nlast > 0 && oc >= nlast) convert_weights(args, lds, 1, (oc - nlast) * 8 + wave, (G - nlast) * 8, wave, lane);
                   else if (nlast == 0) convert_weights(args, lds, 1, oc * 8 + wave, G * 8, wave, lane); }
                 if (NREP(2) == 2) { __syncthreads(); ph_probe(lds, HB, (const bf16*)(ws + WS_W2A), DM, FF, (float*)(ws + WS_RSEG), args.ph_lo < 0, G, bx); } } SEAM(2);
    if (IN(3)) { if (SPLITK && SPLIT_P2) { finalize_rstd(SS1, RS1, vcu * 8 + wave, G * 8, lane, MP); reduce_sample_rows<NSPL2>(args, PART, 0.5f, RS1, wave * G + vcu, G * 8, lane); } else finalize_rstd(SS1, RS1, vcu * 8 + wave, G * 8, lane);
                 if (MK_N_LAUNCHES == 1) xcd_barrier(bar); else if (lo == 3) {   finalize_rstd(SS1, RS1, wave, 8, lane); __syncthreads(); }
                 ph_inproj(args, lds, XB, RS1, G, bx);
                 if (SPLITK) { const int nun = (MROWS / 256) * (NINP / 256), nlast = nun - (nun / G) * G;
                     if (nlast > 0 && vcu >= nlast) convert_weights(args, lds, 1, (vcu - nlast) * 8 + wave, (G - nlast) * 8, wave, lane, CV1_UP, CV1_UP + CV3_UP); } if (NREP(13) == 2) ph_inproj(args, lds, XB, RS1, G, bx); if (NREP(3) == 2) ph_probe(lds, XB, (const bf16*)(ws + WS_WIN), NINP, DM, (float*)(ws + WS_RSEG), args.ph_lo < 0, G, bx); } SEAM(3);
    if (IN(4)) {
        for (int j = vcu; j < NBP * NH * (NSEGB - 1); j += G) mlstm_summary_unit(args, lds, (j / (NSEGB - 1)) * NSEGB + j % (NSEGB - 1), tid, wave, lane);
        attn_prompt_phase(args, lds, vcu, G, tid, wave, lane);
        for (int u = vcu; u < NBS * NH; u += G) attn_sample_unit(args, lds, u >> 3, u & 7, tid, wave, lane);
        if (NREP(4) == 2) { for (int j = vcu; j < NBP * NH * (NSEGB - 1); j += G) mlstm_summary_unit(args, lds, (j / (NSEGB - 1)) * NSEGB + j % (NSEGB - 1), tid, wave, lane); }
        if (NREP(10) == 2) attn_prompt_phase(args, lds, vcu, G, tid, wave, lane);
        if (NREP(11) == 2) { for (int u = vcu; u < NBS * NH; u += G) attn_sample_unit(args, lds, u >> 3, u & 7, tid, wave, lane); }
    } SEAM(4);
    if (IN(5)) {
        for (int rep = 0; rep < NREP(5); ++rep)
        for (int s = vcu; s < NSEGP + NBS * NH; s += G) mlstm_out_unit(args, lds, s < NSEGP ? munit_prompt(s) : munit_sample(s - NSEGP), tid, wave, lane);
    } SEAM(5);
    if (IN(6) && SPLITK && SPLIT_P6) { __syncthreads(); ph_resid_prompt(lds, MRG, (const bf16*)(ws + WS_WOUT), DM, XB, SS2, 1.0f, G, bx);
                 if (TAIL_CU(NSPL6)) ph_tail_splitk<NSPL6>(lds, MRG, (const bf16*)(ws + WS_WOUT), DM, PART, TAIL_Q(NSPL6));
                 else convert_weights(args, lds, 2, SIDE_I(NSPL6) * 8 + wave, NSIDE(NSPL6) * 8, wave, lane); }
    else if (IN(6)) { __syncthreads(); ph_resid(lds, MRG, (const bf16*)(ws + WS_WOUT), DM, XB, SS2, 1.0f, G, bx);
                 { const int nun = (MROWS / 256) * (DM / 256), nfull = nun / G, nlast = nun - nfull * G;
                   const int oc = ORD_C;
                   if (nlast > 0 && oc >= nlast) convert_weights(args, lds, 2, (oc - nlast) * 8 + wave, (G - nlast) * 8, wave, lane);
                   else if (nlast == 0) convert_weights(args, lds, 2, oc * 8 + wave, G * 8, wave, lane); }
                 if (NREP(6) == 2) ph_probe(lds, MRG, (const bf16*)(ws + WS_WOUT), DM, DM, (float*)(ws + WS_RSEG), args.ph_lo < 0, G, bx); } SEAM(6);
    if (IN(7)) { if (SPLITK && SPLIT_P6) { finalize_rstd(SS2, RS2, vcu * 8 + wave, G * 8, lane, MP); reduce_sample_rows<NSPL6>(args, PART, 1.0f, RS2, wave * G + vcu, G * 8, lane); } else finalize_rstd(SS2, RS2, vcu * 8 + wave, G * 8, lane);
                 if (MK_N_LAUNCHES == 1) xcd_barrier(bar); else if (lo == 7) { finalize_rstd(SS2, RS2, wave, 8, lane); __syncthreads(); }
                 ph_ffn_up<true>(lds, XB, (const bf16*)(ws + WS_W13B), HB, RS2, G, bx); if (NREP(7) == 2) ph_probe(lds, XB, (const bf16*)(ws + WS_W13B), FF2, DM, (float*)(ws + WS_RSEG), args.ph_lo < 0, G, bx); } SEAM(7);
    if (IN(8) && IN(9) && MK_N_LAUNCHES == 1 && G == 256) {
        { pg8::Gemm g{HB, (const bf16*)(ws + WS_W2B), MP, DM, FF}; pg8::StaticOrder S; S.init(MP, DM, G, ORD_C, WGM_DN); S.shared_a = ORD_SHARED;
          pg8::EpiResid E{XB, XB, SS3, 0.5f, DM};
          pg8::gemm_phase<pg8::EpiResid, pg8::StaticOrder, true, true>(lds + RING_OFF, g, S, E); }
        xcd_barrier(bar);
        { const int tq_x = vcu >> 5, tq_j = vcu & 31; float* PART = (float*)(ws + WS_RSEG);
          constexpr int NORM_SPLIT = 14336;
          if (tq_j < 4) { const int q = tq_x * 4 + tq_j, unit = q >> 1, sp = q & 1;
              pg8::Gemm g{HB, (const bf16*)(ws + WS_W2B), MROWS, DM, FF, sp * 44, sp ? 42 : 44}; pg8::SingleOrder S{MP / 256 + (unit >> 3), unit & 7};
              pg8::EpiPartial E{PART + (size_t)sp * MS * DM, MP};
              pg8::gemm_phase<pg8::EpiPartial, pg8::SingleOrder, true, true>(lds + RING_OFF, g, S, E); }
          else final_norm_rows(args, NORM_SPLIT, MP, (tq_x * 28 + tq_j - 4) * 8 + wave, 224 * 8, lane);
          final_norm_rows(args, 0, NORM_SPLIT, vcu * 8 + wave, G * 8, lane);
          xcd_barrier(bar);
          final_norm_sample_rows(args, PART, wave * G + vcu, G * 8, lane); }
    } else {
    if (IN(8)) { ph_resid(lds, HB, (const bf16*)(ws + WS_W2B), FF, XB, SS3, 0.5f, G, bx);
                 if (NREP(8) == 2) ph_probe(lds, HB, (const bf16*)(ws + WS_W2B), DM, FF, (float*)(ws + WS_RSEG), args.ph_lo < 0, G, bx); } SEAM(8);
    if (IN(9)) { final_norm_rows(args, 0, MROWS, vcu * 8 + wave, G * 8, lane); }
    }
#undef IN
#undef SEAM
}

extern "C" void kernel_launch(void* const* d_in, const int* in_sizes, int n_in, void* d_out, int out_size, void* d_ws, size_t ws_size, hipStream_t stream) {
    static int grid = 0;
    if (grid == 0) {
        if (n_in != 26 || (size_t)out_size != O_END || ws_size < WS_END) { fprintf(stderr, "kernel_launch: unexpected shapes: n_in %d out %d ws %zu (need %zu)\n", n_in, out_size, ws_size, (size_t)WS_END); grid = -1; return; }
        int dev = 0, cus = 0, per_cu = 0;
        if (hipGetDevice(&dev) != hipSuccess || hipDeviceGetAttribute(&cus, hipDeviceAttributeMultiprocessorCount, dev) != hipSuccess) { grid = -1; return; }
        if (hipFuncSetAttribute((const void*)hymba_fwd, hipFuncAttributeMaxDynamicSharedMemorySize, LDS_BYTES) != hipSuccess) { fprintf(stderr, "kernel_launch: hipFuncSetAttribute failed\n"); grid = -1; return; }
        if (hipOccupancyMaxActiveBlocksPerMultiprocessor(&per_cu, (const void*)hymba_fwd, 512, LDS_BYTES) != hipSuccess || per_cu < 1) { fprintf(stderr, "kernel_launch: occupancy query says %d\n", per_cu); (void)hipGetLastError(); grid = -1; return; }
        grid = cus;
    }
    if (grid < 0) return;
    if (hipMemsetAsync((char*)d_ws + WS_CTL, 0, CTL_ZERO_BYTES, stream) != hipSuccess) return;
    Args a{};
    for (int i = 0; i < 26; ++i) a.in[i] = (const float*)d_in[i];
    a.out = (float*)d_out; a.ws = (unsigned char*)d_ws;
    if (MK_N_LAUNCHES == 1) { a.ph_lo = 0; a.ph_hi = NPHASE; hipLaunchKernelGGL(hymba_fwd, dim3(grid), dim3(512), LDS_BYTES, stream, a); }
    else for (int p = 0; p < NPHASE; ++p) { a.ph_lo = p; a.ph_hi = p + 1; hipLaunchKernelGGL(hymba_fwd, dim3(grid), dim3(512), LDS_BYTES, stream, a); }
}
```

```cpp
#include <hip/hip_runtime.h>
#include <cstdio>
#include <cstdint>

#ifndef MK_N_LAUNCHES
#define MK_N_LAUNCHES 1
#endif

constexpr int DM = 2048, MP = 32768, MS = 512, MROWS = MP + MS, TP = 8192, TS = 16, NBP = 4, NBS = 32, PAST = 2048;
constexpr int FF = 5504, FF2 = 2 * FF, NIN = 7184, NINP = 7424, HD = 128, NH = 8, GW = 1024;
constexpr int NCHP = NBP * NH * (TP / 64), NCHS = NBS * NH, NCH = NCHP + NCHS;
constexpr int LDX = DM, LDW = DM;
constexpr float EPS = 1e-6f;
constexpr float QSCALE = 0.08838834764831845f * 1.4426950408889634f;
constexpr float KSCALE = 0.08838834764831845f;

constexpr size_t O_Y = 0, O_KP = 68157440, O_VP = 101711872, O_CP = 135266304, O_NP = 135790592, O_MP = 135794688, O_CVP = 135794720,
                 O_KS = 135819296, O_VS = 136343584, O_CS = 136867872, O_NS = 141062176, O_MS = 141094944, O_CVS = 141095200, O_END = 141291808;

namespace pg8 {
#define PG8_LAS __attribute__((address_space(3)))
typedef unsigned short bf16_t;
typedef short bf16x8 __attribute__((ext_vector_type(8)));
typedef float f32x4 __attribute__((ext_vector_type(4)));
typedef unsigned u32x4 __attribute__((ext_vector_type(4)));
constexpr int BM = 256, BK = 64, HALF = 128, HTB = HALF * BK * 2  , STAGE_BYTES = 8 * HTB, NXCD = 8, WGM = 4;

__host__ __device__ __forceinline__ int lds_byte(int r, int c) { const int st = (r >> 4) * 2 + (c >> 5), rr = r & 15, cc = c & 31, ob = rr * 64 + cc * 2; return st * 1024 + (ob ^ (((ob >> 9) & 1) << 5)); }
__host__ __device__ __forceinline__ void stage_rc(int b, int& R, int& C) { const int st = b / 1024, sb = b % 1024, swz = sb ^ (((sb >> 9) & 1) << 5); R = (st >> 1) * 16 + swz / 64; C = (st & 1) * 32 + (swz % 64) / 2; }
__host__ __device__ __forceinline__ int perm32(int rho) { const int n = rho >> 4, i = rho & 15; return 8 * (i >> 2) + 4 * n + (i & 3); }

struct Unit { int pm, pn; };
struct Gemm { const bf16_t* A; const bf16_t* Bt; int M, N, K; int kt0 = 0, ktn = 0;   };
__host__ __device__ __forceinline__ size_t tiled_elem(int row, int col, int nKT) {
    const size_t blk = ((size_t)(row >> 8) * nKT + (col >> 6)) * 2 + ((row >> 7) & 1);
    return blk * 8192 + (size_t)(lds_byte(row & 127, col & 63) >> 1);
}
__host__ __device__ __forceinline__ int perm32inv(int c) { return 16 * ((c >> 2) & 1) + 4 * (c >> 3) + (c & 3); }
__host__ __device__ __forceinline__ size_t tiled_elem_b(int n, int k, int nKT) { return tiled_elem((n & ~31) + perm32inv(n & 31), k, nKT); }

struct StaticOrder {
    bool rev = false;
    bool shared_a = false;
    int nM, nN, nwg, G, c, wgm;
    __host__ __device__ void init(int M, int N, int G_, int c_, int wgm_ = WGM) { nM = M / BM; nN = N / BM; nwg = nM * nN; G = G_; c = c_; wgm = wgm_; }
    __host__ __device__ bool next(int i, Unit& u) const {
        const long L = (long)i * G + c; if (L >= nwg) return false;
        int wgid = (int)L; if (!shared_a) { const int q = nwg / NXCD, r = nwg % NXCD, xcd = wgid % NXCD, off = wgid / NXCD; wgid = (xcd < r ? xcd * (q + 1) : r * (q + 1) + (xcd - r) * q) + off; }
        const int nig = wgm * nN, gid = wgid / nig, fm = gid * wgm, gsz = (nM - fm) < wgm ? (nM - fm) : wgm;
        u.pm = fm + ((wgid % nig) % gsz); u.pn = (wgid % nig) / gsz; if (rev) u.pm = nM - 1 - u.pm; return true;
    }
    __device__ __forceinline__ void a_ready(const Unit&) const {}
    __device__ __forceinline__ void done(const Unit&) const {}
};
struct SingleOrder {
    int pm, pn;
    __host__ __device__ bool next(int i, Unit& u) const { if (i != 0) return false; u.pm = pm; u.pn = pn; return true; }
    __device__ __forceinline__ void a_ready(const Unit&) const {}
    __device__ __forceinline__ void done(const Unit&) const {}
};


typedef float f32x2 __attribute__((ext_vector_type(2)));
typedef __bf16 bf16x2_t __attribute__((ext_vector_type(2)));
__device__ __forceinline__ unsigned cvt_pk_bf16(float lo, float hi) { f32x2 v = {lo, hi}; bf16x2_t b = __builtin_convertvector(v, bf16x2_t); return __builtin_bit_cast(unsigned, b); }
__device__ __forceinline__ u32x4 pack8(f32x4 a, f32x4 b) { u32x4 w; w.x = cvt_pk_bf16(a[0], a[1]); w.y = cvt_pk_bf16(a[2], a[3]); w.z = cvt_pk_bf16(b[0], b[1]); w.w = cvt_pk_bf16(b[2], b[3]); return w; }

__device__ __forceinline__ void row_rstd(const float* SS, const Unit& u, int wr, int fr, int fq, float (&r)[2][4]) {
#pragma unroll
    for (int ai = 0; ai < 2; ++ai)
#pragma unroll
        for (int m = 0; m < 4; ++m) {
            const int row = u.pm * BM + ai * HALF + wr * 64 + m * 16 + fr;
            const f32x4* p = (const f32x4*)(SS + (size_t)row * 32 + fq * 8);
            const f32x4 a = p[0], b = p[1];
            float s = ((a[0] + a[1]) + (a[2] + a[3])) + ((b[0] + b[1]) + (b[2] + b[3]));
            s += __shfl_xor(s, 16); s += __shfl_xor(s, 32);
            r[ai][m] = 1.0f / sqrtf(s * (1.0f / 2048.0f) + 1e-6f);
        }
}
__device__ __forceinline__ float logsig_f(float x) { return fminf(x, 0.f) - 0.6931471805599453f * __builtin_amdgcn_logf(1.0f + __builtin_amdgcn_exp2f(-1.4426950408889634f * fabsf(x))); }
__device__ __forceinline__ void row_rstd_direct(const float* RS, const Unit& u, int wr, int fr, float (&r)[2][4]) {
#pragma unroll
    for (int ai = 0; ai < 2; ++ai)
#pragma unroll
        for (int m = 0; m < 4; ++m) r[ai][m] = RS[u.pm * BM + ai * HALF + wr * 64 + m * 16 + fr];
}
__device__ __forceinline__ float sigmoid_f(float a) { return __builtin_amdgcn_rcpf(1.0f + __builtin_amdgcn_exp2f(-1.4426950408889634f * a)); }

template <bool DIRECT  > struct EpiSwiGLU {
    static constexpr bool PERM = true, AFTER_DRAIN = false;
    bf16_t* H; int ldh; const float* SS;
    __device__ __forceinline__ void operator()(const f32x4 (&acc)[2][2][4][2], const Unit& u, int wr, int wc, int fr, int fq) const {
        float r[2][4]; if (DIRECT) row_rstd_direct(SS, u, wr, fr, r); else row_rstd(SS, u, wr, fr, fq, r);
        const int col0 = u.pn * HALF + wc * 32 + 8 * fq;
#pragma unroll
        for (int ai = 0; ai < 2; ++ai)
#pragma unroll
            for (int m = 0; m < 4; ++m) {
                const float rs = r[ai][m], rsn = rs * -1.4426950408889634f;
                bf16_t* rowp = H + tiled_elem(u.pm * BM + ai * HALF + wr * 64 + m * 16 + fr, col0, ldh / BK);
                f32x4 o[2];
#pragma unroll
                for (int n = 0; n < 2; ++n)
#pragma unroll
                    for (int hv = 0; hv < 2; ++hv) {
                        const f32x2 av = (f32x2){acc[ai][0][m][n][2 * hv], acc[ai][0][m][n][2 * hv + 1]}, bv = (f32x2){acc[ai][1][m][n][2 * hv], acc[ai][1][m][n][2 * hv + 1]};
                        const f32x2 t = av * rsn; f32x2 e; e.x = __builtin_amdgcn_exp2f(t.x); e.y = __builtin_amdgcn_exp2f(t.y);
                        const f32x2 d = e + 1.0f; f32x2 q; q.x = __builtin_amdgcn_rcpf(d.x); q.y = __builtin_amdgcn_rcpf(d.y);
                        const f32x2 h = (av * (rs * rs)) * (bv * q);
                        o[n][2 * hv] = h.x; o[n][2 * hv + 1] = h.y; }
                *(u32x4*)rowp = pack8(o[0], o[1]);
            }
    }
};

__device__ __forceinline__ f32x4 bf_lo4(unsigned a, unsigned b) { return (f32x4){__uint_as_float(a << 16), __uint_as_float(a & 0xffff0000u), __uint_as_float(b << 16), __uint_as_float(b & 0xffff0000u)}; }
struct EpiResid {
    static constexpr bool PERM = true, AFTER_DRAIN = false;
    const bf16_t* base; bf16_t* out; float* SSout; float scale; int ldx;
    __device__ __forceinline__ void operator()(const f32x4 (&acc)[2][2][4][2], const Unit& u, int wr, int wc, int fr, int fq) const {
        const int colb = u.pn * BM + wc * 32 + 8 * fq;
        const size_t row0 = (size_t)(u.pm * BM + wr * 64 + fr);
        u32x4 bv[2][4][2];
#pragma unroll
        for (int ai = 0; ai < 2; ++ai)
#pragma unroll
            for (int m = 0; m < 4; ++m)
#pragma unroll
                for (int bj = 0; bj < 2; ++bj) bv[ai][m][bj] = *(const u32x4*)(base + tiled_elem((int)row0 + ai * HALF + m * 16, colb + bj * HALF, 2048 / BK));
#pragma unroll
        for (int ai = 0; ai < 2; ++ai)
#pragma unroll
            for (int m = 0; m < 4; ++m) {
                const size_t row = row0 + ai * HALF + m * 16;
                float ss = 0.f;
#pragma unroll
                for (int bj = 0; bj < 2; ++bj) {
                    const u32x4 b = bv[ai][m][bj];
                    const f32x4 v0 = bf_lo4(b.x, b.y) + acc[ai][bj][m][0] * scale, v1 = bf_lo4(b.z, b.w) + acc[ai][bj][m][1] * scale;
                    *(u32x4*)(out + tiled_elem((int)row, colb + bj * HALF, 2048 / BK)) = pack8(v0, v1);
                    ss += ((v0[0] * v0[0] + v0[1] * v0[1]) + (v0[2] * v0[2] + v0[3] * v0[3])) + ((v1[0] * v1[0] + v1[1] * v1[1]) + (v1[2] * v1[2] + v1[3] * v1[3]));
                }
                { const auto r16 = __builtin_amdgcn_permlane16_swap(__float_as_uint(ss), __float_as_uint(ss), false, false); ss = __uint_as_float(r16[0]) + __uint_as_float(r16[1]);
                  const auto r32 = __builtin_amdgcn_permlane32_swap(__float_as_uint(ss), __float_as_uint(ss), false, false); ss = __uint_as_float(r32[0]) + __uint_as_float(r32[1]); }
                if (fq == 0) SSout[row * 32 + u.pn * 4 + wc] = ss;
            }
    }
};

struct EpiInProj {
    static constexpr bool PERM = true, AFTER_DRAIN = false;
    const float* SS;        bf16_t *QA, *KA, *VA, *QKB, *VB, *OB; float *outKP, *outVP, *outKS, *outVS; float* G; const float *b_ig, *b_fg; int splitRow; float qscale;
    __device__ __forceinline__ void operator()(const f32x4 (&acc)[2][2][4][2], const Unit& u, int wr, int wc, int fr, int fq) const {
        float r[2][4]; row_rstd_direct(SS, u, wr, fr, r);
        const int pn = u.pn;
        if (pn == 28) {
            if (wc == 0 && fq < 2) {
                const float* bias = fq == 0 ? b_ig : b_fg;
                const f32x4 bv0 = *(const f32x4*)bias, bv1 = *(const f32x4*)(bias + 4);
#pragma unroll
                for (int ai = 0; ai < 2; ++ai)
#pragma unroll
                    for (int m = 0; m < 4; ++m) {
                        const int row = u.pm * BM + ai * HALF + wr * 64 + m * 16 + fr;
                        f32x4 v0 = acc[ai][0][m][0] * r[ai][m] + bv0, v1 = acc[ai][0][m][1] * r[ai][m] + bv1;
                        if (fq == 1) {
#pragma unroll
                            for (int j = 0; j < 4; ++j) { v0[j] = logsig_f(v0[j]); v1[j] = logsig_f(v1[j]); }
                        }
                        *(f32x4*)(G + (size_t)row * 16 + 8 * fq) = v0; *(f32x4*)(G + (size_t)row * 16 + 8 * fq + 4) = v1;
                    }
            }
            return;
        }
        bf16_t* dst; int ld = 1024, ct = pn & 3; float sc = 1.f; float *fP = nullptr, *fS = nullptr; bool sig = false;
        if (pn < 4) { dst = QA; sc = qscale; }
        else if (pn < 8) { dst = KA; fP = outKP; fS = outKS; }
        else if (pn < 12) { dst = VA; fP = outVP; fS = outVS; }
        else if (pn < 20) { dst = QKB; ld = 2048; ct = pn - 12; }
        else if (pn < 24) { dst = VB; }
        else { dst = OB; sig = true; }
        const int colb = ct * BM + wc * 32 + 8 * fq;
#pragma unroll
        for (int ai = 0; ai < 2; ++ai)
#pragma unroll
            for (int m = 0; m < 4; ++m) {
                const int row = u.pm * BM + ai * HALF + wr * 64 + m * 16 + fr;
                const float rs = r[ai][m] * sc;
                float* fp = nullptr;
                if (fP) fp = (row >= splitRow) ? fS + (size_t)(row - splitRow) * 1024 : fP + (size_t)row * 1024;
#pragma unroll
                for (int bj = 0; bj < 2; ++bj) {
                    const int col = colb + bj * HALF;
                    f32x4 v0 = acc[ai][bj][m][0] * rs, v1 = acc[ai][bj][m][1] * rs;
                    if (sig) {
#pragma unroll
                        for (int j = 0; j < 4; ++j) { v0[j] = sigmoid_f(v0[j]); v1[j] = sigmoid_f(v1[j]); }
                    }
                    if (fp) { *(f32x4*)(fp + col) = v0; *(f32x4*)(fp + col + 4) = v1; }
                    *(u32x4*)(dst + (size_t)row * ld + col) = pack8(v0, v1);
                }
            }
    }
};


struct EpiPartial {
    static constexpr bool PERM = true, AFTER_DRAIN = false;
    float* P; int row_base;
    __device__ __forceinline__ void operator()(const f32x4 (&acc)[2][2][4][2], const Unit& u, int wr, int wc, int fr, int fq) const {
        const int colb = u.pn * BM + wc * 32 + 8 * fq;
        const int row0 = u.pm * BM - row_base + wr * 64 + fr;
#pragma unroll
        for (int ai = 0; ai < 2; ++ai)
#pragma unroll
            for (int m = 0; m < 4; ++m)
#pragma unroll
                for (int bj = 0; bj < 2; ++bj) {
                    float* p = P + (size_t)(row0 + ai * HALF + m * 16) * 2048 + colb + bj * HALF;
                    *(f32x4*)p = acc[ai][bj][m][0]; *(f32x4*)(p + 4) = acc[ai][bj][m][1];
                }
    }
};

struct EpiProbe {
    static constexpr bool PERM = true, AFTER_DRAIN = false;
    float* sink; int flag;
    __device__ __forceinline__ void operator()(const f32x4 (&acc)[2][2][4][2], const Unit& u, int wr, int wc, int fr, int fq) const {
        if (flag) {
            f32x4 s = (f32x4){0.f, 0.f, 0.f, 0.f};
#pragma unroll
            for (int ai = 0; ai < 2; ++ai)
#pragma unroll
                for (int bj = 0; bj < 2; ++bj)
#pragma unroll
                    for (int m = 0; m < 4; ++m)
#pragma unroll
                        for (int n = 0; n < 2; ++n) s += acc[ai][bj][m][n];
            *(f32x4*)(sink + (size_t)(u.pm * 8 + u.pn) * 2048 + threadIdx.x * 4) = s;
        }
    }
};
template <class Epi, class Sched, bool ALIGN_EPI = false, bool SP2 = false>
__device__ __forceinline__ void gemm_phase(PG8_LAS unsigned char* lds, const Gemm g, const Sched& S, const Epi& E) {
    const int tid = threadIdx.x, wid = __builtin_amdgcn_readfirstlane(tid >> 6), lane = tid & 63, wr = wid >> 2, wc = wid & 3, fr = lane & 15, fq = lane >> 4;
    const int K = g.K, nt = g.ktn > 0 ? g.ktn : K / BK;
    unsigned voffA[2], voffB[2];
#pragma unroll
    for (int i = 0; i < 2; ++i) { voffA[i] = (unsigned)(wid * 2048 + lane * 16); voffB[i] = voffA[i]; }
    static_assert(Epi::PERM, "the tiled weight copies carry the PERM row order");
    const size_t kstep = 32768;
    const size_t hstepA = 16384, hstepB = 16384;
    const size_t tstepA = (size_t)(K / BK) * 32768, tstepB = tstepA;
    const unsigned ldsw = (unsigned)wid * 2048u;
    const int aoff = lds_byte(wr * 64 + fr, fq * 8), boff = lds_byte(wc * 32 + fr, fq * 8);
#ifndef PG8_DMA_AUX
#define PG8_DMA_AUX 16
#endif
#define PG8_SA(b, h) (((b) * 2 + (h)) * HTB)
#define PG8_SB(b, h) ((4 + (b) * 2 + (h)) * HTB)
#define PG8_STAGE(bufoff, gbase, voff) do { const unsigned* _g = (const unsigned*)((const char*)(gbase) + (voff)[0]); PG8_LAS unsigned* _l = (PG8_LAS unsigned*)(lds + (bufoff) + ldsw); \
        __builtin_amdgcn_global_load_lds(_g, _l, 16, 0, PG8_DMA_AUX); __builtin_amdgcn_global_load_lds(_g, _l, 16, 1024, PG8_DMA_AUX); } while (0)
#define PG8_LDA(dst, b, h) do { _Pragma("unroll") for (int m = 0; m < 4; ++m) _Pragma("unroll") for (int k = 0; k < 2; ++k) dst[m][k] = *(const PG8_LAS bf16x8*)(lds + PG8_SA(b, h) + aoff + m * 2048 + k * 1024); } while (0)
#define PG8_LDB(dst, b, h) do { _Pragma("unroll") for (int n = 0; n < 2; ++n) _Pragma("unroll") for (int k = 0; k < 2; ++k) dst[n][k] = *(const PG8_LAS bf16x8*)(lds + PG8_SB(b, h) + boff + n * 2048 + k * 1024); } while (0)
#define PG8_MMA(ai, bj, At, Bt) do { __builtin_amdgcn_s_setprio(1); _Pragma("unroll") for (int m = 0; m < 4; ++m) _Pragma("unroll") for (int n = 0; n < 2; ++n) _Pragma("unroll") for (int k = 0; k < 2; ++k) \
        acc[ai][bj][m][n] = __builtin_amdgcn_mfma_f32_16x16x32_bf16(Bt[n][k], At[m][k], acc[ai][bj][m][n], 0, 0, 0); __builtin_amdgcn_s_setprio(0); } while (0)
#define PG8_WAIT_V(n) asm volatile("s_waitcnt vmcnt(" #n ")" ::: "memory")
#define PG8_WAIT_L(n) asm volatile("s_waitcnt lgkmcnt(" #n ")" ::: "memory")
#define PG8_BAR __builtin_amdgcn_s_barrier()
#define PG8_SCHED __builtin_amdgcn_sched_barrier(0)
    Unit cur, nxt; int ui = 0;
    if (!S.next(0, cur)) return;
    f32x4 acc[2][2][4][2];
#pragma unroll
    for (int a = 0; a < 2; ++a)
#pragma unroll
        for (int b = 0; b < 2; ++b)
#pragma unroll
            for (int m = 0; m < 4; ++m)
#pragma unroll
                for (int n = 0; n < 2; ++n) acc[a][b][m][n] = (f32x4){0.f, 0.f, 0.f, 0.f};
    bf16x8 At[4][2], B0[2][2], B1[2][2];
    const size_t koff = (size_t)g.kt0 * kstep;
    const char* cA = (const char*)g.A + (size_t)cur.pm * tstepA + koff; const char* cB = (const char*)g.Bt + (size_t)cur.pn * tstepB + koff;
    S.a_ready(cur);
    if constexpr (SP2) {
        PG8_STAGE(PG8_SB(0, 0), cB, voffB); PG8_STAGE(PG8_SB(0, 1), cB + hstepB, voffB); PG8_STAGE(PG8_SA(0, 0), cA, voffA); PG8_STAGE(PG8_SA(0, 1), cA + hstepA, voffA);
        if (wr == 1) PG8_BAR;
        PG8_WAIT_V(2); PG8_BAR;
        PG8_STAGE(PG8_SB(1, 0), cB + kstep, voffB); PG8_STAGE(PG8_SA(1, 0), cA + kstep, voffA); PG8_STAGE(PG8_SB(1, 1), cB + hstepB + kstep, voffB);
        PG8_WAIT_V(6); PG8_BAR;
    } else {
        PG8_STAGE(PG8_SB(0, 0), cB, voffB); PG8_STAGE(PG8_SA(0, 0), cA, voffA); PG8_STAGE(PG8_SB(0, 1), cB + hstepB, voffB); PG8_STAGE(PG8_SA(0, 1), cA + hstepA, voffA);
        if (wr == 1) PG8_BAR;
        PG8_WAIT_V(4); PG8_BAR;
        PG8_STAGE(PG8_SB(1, 0), cB + kstep, voffB); PG8_STAGE(PG8_SA(1, 0), cA + kstep, voffA); PG8_STAGE(PG8_SB(1, 1), cB + hstepB + kstep, voffB);
        PG8_WAIT_V(6); PG8_BAR;
    }
    for (;;) {
        const bool has_next = S.next(ui + 1, nxt);
        const char* nA = has_next ? (const char*)g.A + (size_t)nxt.pm * tstepA + koff : cA; const char* nB = has_next ? (const char*)g.Bt + (size_t)nxt.pn * tstepB + koff : cB;
        for (int t = 0; t < nt; t += 2) {
            const bool last = (t == nt - 2);
            const char* a1 = cA + (size_t)(t + 1) * kstep;
            const char* a2 = last ? nA : cA + (size_t)(t + 2) * kstep; const char* b2 = last ? nB : cB + (size_t)(t + 2) * kstep;
            const char* a3 = a2 + kstep; const char* b3 = b2 + kstep;
            if (last && has_next) S.a_ready(nxt);
            if constexpr (SP2) {
            PG8_LDB(B0, 0, 0); PG8_LDB(B1, 0, 1); PG8_SCHED; PG8_LDA(At, 0, 0); PG8_STAGE(PG8_SA(1, 1), a1 + hstepA, voffA);
            PG8_WAIT_V(8); PG8_WAIT_L(0); PG8_BAR; PG8_MMA(0, 0, At, B0); PG8_MMA(0, 1, At, B1); PG8_BAR; PG8_SCHED;
            PG8_LDA(At, 0, 1); PG8_STAGE(PG8_SB(0, 0), b2, voffB); PG8_STAGE(PG8_SB(0, 1), b2 + hstepB, voffB); PG8_STAGE(PG8_SA(0, 0), a2, voffA);
            PG8_WAIT_V(8); PG8_WAIT_L(0); PG8_BAR; PG8_MMA(1, 0, At, B0); PG8_MMA(1, 1, At, B1); PG8_BAR; PG8_SCHED;
            PG8_LDB(B0, 1, 0); PG8_LDB(B1, 1, 1); PG8_SCHED; PG8_LDA(At, 1, 0); PG8_STAGE(PG8_SA(0, 1), a2 + hstepA, voffA);
            PG8_WAIT_V(8); PG8_WAIT_L(0); PG8_BAR; PG8_MMA(0, 0, At, B0); PG8_MMA(0, 1, At, B1); PG8_BAR; PG8_SCHED;
            PG8_LDA(At, 1, 1); PG8_STAGE(PG8_SB(1, 0), b3, voffB); PG8_STAGE(PG8_SB(1, 1), b3 + hstepB, voffB); PG8_STAGE(PG8_SA(1, 0), a3, voffA);
            PG8_WAIT_V(8); PG8_WAIT_L(0); PG8_BAR; PG8_MMA(1, 0, At, B0); PG8_MMA(1, 1, At, B1); PG8_BAR; PG8_SCHED;
            } else {
            PG8_LDB(B0, 0, 0); PG8_SCHED; PG8_LDA(At, 0, 0); PG8_STAGE(PG8_SA(1, 1), a1 + hstepA, voffA);
            PG8_WAIT_L(8); PG8_BAR; PG8_WAIT_L(0); PG8_MMA(0, 0, At, B0); PG8_BAR; PG8_SCHED;
            PG8_LDB(B1, 0, 1); PG8_STAGE(PG8_SB(0, 0), b2, voffB);
            PG8_BAR; PG8_WAIT_L(0); PG8_MMA(0, 1, At, B1); PG8_BAR;
            PG8_LDA(At, 0, 1); PG8_STAGE(PG8_SA(0, 0), a2, voffA);
            PG8_BAR; PG8_WAIT_L(0); PG8_MMA(1, 0, At, B0); PG8_BAR; PG8_SCHED;
            PG8_STAGE(PG8_SB(0, 1), b2 + hstepB, voffB);
            PG8_WAIT_V(6); PG8_BAR; PG8_MMA(1, 1, At, B1); PG8_BAR;
            PG8_LDB(B0, 1, 0); PG8_SCHED; PG8_LDA(At, 1, 0); PG8_STAGE(PG8_SA(0, 1), a2 + hstepA, voffA);
            PG8_WAIT_L(8); PG8_BAR; PG8_WAIT_L(0); PG8_MMA(0, 0, At, B0); PG8_BAR; PG8_SCHED;
            PG8_LDB(B1, 1, 1); PG8_STAGE(PG8_SB(1, 0), b3, voffB);
            PG8_BAR; PG8_WAIT_L(0); PG8_MMA(0, 1, At, B1); PG8_BAR;
            PG8_LDA(At, 1, 1); PG8_STAGE(PG8_SA(1, 0), a3, voffA);
            PG8_BAR; PG8_WAIT_L(0); PG8_MMA(1, 0, At, B0); PG8_BAR; PG8_SCHED;
            PG8_STAGE(PG8_SB(1, 1), b3 + hstepB, voffB);
            PG8_WAIT_V(6); PG8_BAR; PG8_MMA(1, 1, At, B1); PG8_BAR;
            }
        }
        if constexpr (ALIGN_EPI) { if (wr == 0) PG8_BAR; }
        if constexpr (!Epi::AFTER_DRAIN) { E(acc, cur, wr, wc, fr, fq); S.done(cur); }
        if (!has_next) break;
#pragma unroll
        for (int a = 0; a < 2; ++a)
#pragma unroll
            for (int b = 0; b < 2; ++b)
#pragma unroll
                for (int m = 0; m < 4; ++m)
#pragma unroll
                    for (int n = 0; n < 2; ++n) acc[a][b][m][n] = (f32x4){0.f, 0.f, 0.f, 0.f};
        cur = nxt; cA = nA; cB = nB; ++ui;
        if constexpr (ALIGN_EPI) { if (wr == 1) PG8_BAR; }
    }
    PG8_WAIT_V(0);
    if constexpr (!ALIGN_EPI) { if (wr == 0) PG8_BAR; }
    PG8_BAR;
    if constexpr (Epi::AFTER_DRAIN) { E.fused(acc, cur, wr, wc, fr, fq, lds, wid, lane); S.done(cur); }
#undef PG8_SA
#undef PG8_SB
#undef PG8_STAGE
#undef PG8_LDA
#undef PG8_LDB
#undef PG8_MMA
#undef PG8_WAIT_V
#undef PG8_WAIT_L
#undef PG8_BAR
#undef PG8_SCHED
}
}

constexpr size_t MiB = 1u << 20;
constexpr size_t WS_CTL = 0, CTL_ZERO_BYTES = 1 * MiB;
constexpr size_t WS_W13A = 1 * MiB;
constexpr size_t WS_W2A = WS_W13A + 46 * MiB;
constexpr size_t WS_WIN = WS_W2A + 22 * MiB;
constexpr size_t WS_WOUT = WS_WIN + 31 * MiB;
constexpr size_t WS_W13B = WS_WOUT + 9 * MiB;
constexpr size_t WS_W2B = WS_W13B + 46 * MiB;
constexpr size_t WS_XB = WS_W2B + 22 * MiB;
constexpr size_t WS_SS = WS_XB + 139 * MiB;
constexpr size_t WS_G = WS_SS + 20 * MiB;
constexpr size_t WS_SSEG = WS_G + 3 * MiB;
constexpr size_t WS_NSEG = WS_SSEG + 1 * MiB;
constexpr size_t WS_RSEG = WS_NSEG + 1 * MiB;
constexpr size_t WS_HU = WS_RSEG + 16 * MiB;
constexpr size_t WS_QA = WS_HU, WS_KA = WS_QA + 65 * MiB, WS_VA = WS_KA + 65 * MiB, WS_QKB = WS_VA + 65 * MiB, WS_VB = WS_QKB + 130 * MiB, WS_OB = WS_VB + 65 * MiB;
constexpr size_t WS_END = WS_OB + 65 * MiB;
static_assert((size_t)MROWS * FF * 2 <= 350 * MiB && (size_t)MROWS * LDX * 2 <= 139 * MiB && (size_t)FF2 * LDW * 2 <= 46 * MiB && (size_t)NINP * LDW * 2 <= 31 * MiB && (size_t)DM * LDW * 2 <= 9 * MiB, "d_ws map");
constexpr int CW_BAR = 4096;

constexpr int RING_OFF = 0, RING_BYTES = 131072;
constexpr int LDS_BYTES = 155648;
constexpr int LDSCTL_OFF = LDS_BYTES - 512, MISC_OFF = LDSCTL_OFF + 320;

#define GAS __attribute__((address_space(1)))
#define LAS __attribute__((address_space(3)))
typedef unsigned short bf16;
typedef unsigned v4u __attribute__((ext_vector_type(4)));
typedef unsigned v2u __attribute__((ext_vector_type(2)));
typedef float f32x4 __attribute__((ext_vector_type(4)));
typedef float f32x16 __attribute__((ext_vector_type(16)));
typedef short bf16x8 __attribute__((ext_vector_type(8)));
typedef short s16x4 __attribute__((ext_vector_type(4)));
typedef GAS unsigned gu32;
#define RLX_AGENT __ATOMIC_RELAXED, __HIP_MEMORY_SCOPE_AGENT
#define LDS_WAIT() asm volatile("s_waitcnt lgkmcnt(0)" ::: "memory")
#define VM_WAIT() asm volatile("s_waitcnt vmcnt(0)" ::: "memory")
__device__ __forceinline__ float bf2f(unsigned short b) { return __uint_as_float((unsigned)b << 16); }
__device__ __forceinline__ unsigned pk2(float lo, float hi) { return pg8::cvt_pk_bf16(lo, hi); }
__device__ __forceinline__ unsigned short f2bf(float f) { return (unsigned short)(pg8::cvt_pk_bf16(f, 0.f) & 0xffffu); }
__device__ __forceinline__ int crow(int r, int hi) { return (r & 3) + 8 * (r >> 2) + 4 * hi; }
__device__ __forceinline__ float wave_sum(float v) {
#pragma unroll
    for (int o = 1; o < 64; o <<= 1) v += __shfl_xor(v, o);
    return v;
}
__device__ __forceinline__ float wave_max(float v) {
#pragma unroll
    for (int o = 1; o < 64; o <<= 1) v = fmaxf(v, __shfl_xor(v, o));
    return v;
}
#define MFMA32(a, b, c) __builtin_amdgcn_mfma_f32_32x32x16_bf16(a, b, c, 0, 0, 0)
__device__ __forceinline__ void halves32(float x, float& lo, float& hi) {
    const auto rr = __builtin_amdgcn_permlane32_swap(__float_as_uint(x), __float_as_uint(x), false, false);
    lo = __uint_as_float(rr[0]); hi = __uint_as_float(rr[1]);
}
__device__ __forceinline__ float sum_halves32(float x) { float lo, hi; halves32(x, lo, hi); return lo + hi; }

#define XB_TMO      128
#define XB_XCNT(j)  (256  + 64 * (j))
#define XB_XSUB(j)  (1280 + 64 * (j))
#define XB_XGEN(j)  (2304 + 64 * (j))
#define XB_TOP      3328
#define XB_TOPGEN   3392
#define XCD_BAR_WORDS 3456
#define XB_SPIN_CAP (1u << 18)

__device__ __forceinline__ unsigned xb_ld(unsigned* p)              { return __hip_atomic_load(p, __ATOMIC_RELAXED, __HIP_MEMORY_SCOPE_AGENT); }
__device__ __forceinline__ unsigned xb_add(unsigned* p, unsigned v) { return __hip_atomic_fetch_add(p, v, __ATOMIC_RELAXED, __HIP_MEMORY_SCOPE_AGENT); }
__device__ __forceinline__ unsigned xb_xcc_id() { return (unsigned)__builtin_amdgcn_s_getreg((3 << 11) | 20) & 0xFu; }
#define XB_SPIN(cond, bar) do { unsigned _sp = 0; while (cond) { __builtin_amdgcn_s_sleep(1); \
    if ((++_sp & 255u) == 0u) { if (xb_ld(&(bar)[XB_TMO])) break; if (_sp > XB_SPIN_CAP) { atomicAdd(&(bar)[XB_TMO], 1u); break; } } } } while (0)

struct XcdBarrier {
    unsigned* bar; unsigned x;
    volatile LAS unsigned* st;
};

__device__ __forceinline__ XcdBarrier xcd_barrier_post(unsigned* bar, volatile LAS unsigned* st) {
    XcdBarrier b; b.bar = bar; b.x = xb_xcc_id(); b.st = st;
    if (threadIdx.x == 0) (void)xb_add(&bar[XB_XCNT(b.x)], 1u);
    return b;
}
__device__ __forceinline__ void xcd_barrier_complete(unsigned* bar, unsigned x, unsigned& nloc, unsigned& nx) {
    const unsigned G = gridDim.x * gridDim.y * gridDim.z;
    unsigned sum, cnt, mine, sp = 0u;
    for (;;) {
        sum = 0u; cnt = 0u; mine = 0u;
#pragma unroll
        for (unsigned j = 0; j < 16; ++j) { const unsigned c = xb_ld(&bar[XB_XCNT(j)]); sum += c; cnt += (c > 0u) ? 1u : 0u; mine = (j == x) ? c : mine; }
        if (sum == G) break;
        __builtin_amdgcn_s_sleep(1);
        if ((++sp & 255u) == 0u) { if (xb_ld(&bar[XB_TMO])) break; if (sp > XB_SPIN_CAP) { atomicAdd(&bar[XB_TMO], 1u); break; } }
    }
    nloc = mine > 0u ? mine : 1u; nx = cnt > 0u ? cnt : 1u;
}

__device__ __forceinline__ void xcd_barrier(const XcdBarrier& b) {
    asm volatile("s_waitcnt vmcnt(0)" ::: "memory");
    __syncthreads();
    if (threadIdx.x == 0) {
        unsigned* bar = b.bar;
        __builtin_amdgcn_s_waitcnt(0);
        unsigned nloc = b.st[0], nx = b.st[1];
        if (nloc == 0u) { xcd_barrier_complete(bar, b.x, nloc, nx); b.st[0] = nloc; b.st[1] = nx; }
        const unsigned old = xb_add(&bar[XB_XSUB(b.x)], 1u);
        const unsigned gen = old / nloc;
        if (old + 1u == (gen + 1u) * nloc) {
            __builtin_amdgcn_fence(__ATOMIC_RELEASE, "agent");
            asm volatile("s_waitcnt vmcnt(0)" ::: "memory");
            const unsigned og = xb_add(&bar[XB_TOP], 1u);
            const unsigned tg = og / nx;
            if (og + 1u == (tg + 1u) * nx) xb_add(&bar[XB_TOPGEN], 1u);
            else XB_SPIN(xb_ld(&bar[XB_TOPGEN]) == tg, bar);
            __builtin_amdgcn_fence(__ATOMIC_ACQUIRE, "agent");
            xb_add(&bar[XB_XGEN(b.x)], 1u);
            asm volatile("s_waitcnt vmcnt(0)" ::: "memory");
        } else {
            XB_SPIN(xb_ld(&bar[XB_XGEN(b.x)]) == gen, bar);
            __builtin_amdgcn_fence(__ATOMIC_ACQUIRE, "agent");
            asm volatile("s_waitcnt vmcnt(0)" ::: "memory");
        }
    }
    __syncthreads();
}

struct Args {
    const float* in[26]; float* out; unsigned char* ws; int ph_lo, ph_hi;
};
enum { I_XP = 0, I_XS, I_CK, I_CV, I_SC, I_SN, I_SM, I_SCONV, I_G1, I_F1W1, I_F1W3, I_F1W2, I_GM, I_WIN, I_BIG, I_BFG, I_CONVW, I_CONVB, I_SBG, I_MLG, I_WOUT, I_G2, I_F2W1, I_F2W3, I_F2W2, I_GF };

struct CvtItem { const float* W; const float* gain; bf16* WT; int N, nKT, dst_row0, k0, n0; };
__device__ __forceinline__ void cvt_load(const CvtItem& d, int lane, f32x4 (&v)[8]) {
    const int r8 = lane >> 3, n = d.n0 + 4 * (lane & 7);
#pragma unroll
    for (int i = 0; i < 8; ++i) { const int kk = 8 * i + r8; f32x4 t = (f32x4){0.f, 0.f, 0.f, 0.f};
        if (n < d.N) t = __builtin_nontemporal_load((const f32x4*)(d.W + (size_t)(d.k0 + kk) * d.N + n));
        if (d.gain) t *= d.gain[d.k0 + kk];
        v[i] = t; }
}
__device__ __forceinline__ void cvt_store(const CvtItem& d, LAS float* scr, int lane, const f32x4 (&v)[8]) {
    const int r8 = lane >> 3, c4 = 4 * (lane & 7);
#pragma unroll
    for (int i = 0; i < 8; ++i) { LAS float* s = scr + (8 * i + r8) * 33 + c4; s[0] = v[i][0]; s[1] = v[i][1]; s[2] = v[i][2]; s[3] = v[i][3]; }
    LDS_WAIT(); asm volatile("" ::: "memory");
    const int c = lane & 7;
#pragma unroll
    for (int j = 0; j < 4; ++j) { const int nn = (lane >> 3) + 8 * j; const LAS float* s = scr + (8 * c) * 33 + nn;
        v4u o; o.x = pk2(s[0 * 33], s[1 * 33]); o.y = pk2(s[2 * 33], s[3 * 33]); o.z = pk2(s[4 * 33], s[5 * 33]); o.w = pk2(s[6 * 33], s[7 * 33]);
        *(GAS v4u*)(d.WT + pg8::tiled_elem_b(d.dst_row0 + nn, d.k0 + 8 * c, d.nKT)) = o; }
    LDS_WAIT(); asm volatile("" ::: "memory");
}
__device__ __forceinline__ CvtItem cvt_item(const Args& a, int part, int it) {
    unsigned char* ws = a.ws;
    constexpr int I_UP = (DM / 64) * (FF / 32);
    constexpr int I_DN = (FF / 64) * (DM / 32);
    constexpr int I_IN = (DM / 64) * (NINP / 32);
    const int n_up = part == 2 ? 0 : 2 * I_UP, n_dn = part == 1 ? 0 : I_DN;
    CvtItem d; int r = it;
    if (r < n_up) {
        const int which = r / I_UP; r -= which * I_UP; const int nblk = FF / 32, kb = r / nblk, nb = r % nblk, n0 = 32 * nb;
        d.W = a.in[part == 0 ? (which == 0 ? I_F1W1 : I_F1W3) : (which == 0 ? I_F2W1 : I_F2W3)]; d.gain = a.in[part == 0 ? I_G1 : I_G2];
        d.WT = (bf16*)(ws + (part == 0 ? WS_W13A : WS_W13B)); d.N = FF; d.nKT = DM / 64; d.dst_row0 = 256 * (n0 / 128) + (n0 % 128) + 128 * which; d.k0 = 64 * kb; d.n0 = n0; return d; }
    r -= n_up;
    if (r < n_dn) { const int nblk = DM / 32, kb = r / nblk, nb = r % nblk;
        d.W = a.in[part ? I_F2W2 : I_F1W2]; d.gain = nullptr; d.WT = (bf16*)(ws + (part ? WS_W2B : WS_W2A)); d.N = DM; d.nKT = FF / 64; d.dst_row0 = 32 * nb; d.k0 = 64 * kb; d.n0 = 32 * nb; return d; }
    r -= n_dn;
    if (r < I_IN) { const int nblk = NINP / 32, kb = r / nblk, nb = r % nblk;
        d.W = a.in[I_WIN]; d.gain = a.in[I_GM]; d.WT = (bf16*)(ws + WS_WIN); d.N = NIN; d.nKT = DM / 64; d.dst_row0 = 32 * nb; d.k0 = 64 * kb; d.n0 = 32 * nb; return d; }
    r -= I_IN; { const int nblk = DM / 32, kb = r / nblk, nb = r % nblk;
        d.W = a.in[I_WOUT]; d.gain = nullptr; d.WT = (bf16*)(ws + WS_WOUT); d.N = DM; d.nKT = DM / 64; d.dst_row0 = 32 * nb; d.k0 = 64 * kb; d.n0 = 32 * nb; return d; }
}
__device__ __forceinline__ void convert_weights(const Args& a, LAS unsigned char* lds, int part, int gw, int NGW, int wave, int lane, int it_lo = 0, int it_hi = 1 << 30) {
    LAS float* scr = (LAS float*)(lds + RING_OFF + wave * 16384);
    constexpr int I_UP = (DM / 64) * (FF / 32), I_DN = (FF / 64) * (DM / 32), I_IN = (DM / 64) * (NINP / 32), I_OUT = (DM / 64) * (DM / 32);
    const int full = (part == 2 ? 0 : 2 * I_UP) + (part == 1 ? 0 : I_DN) + (part == 1 ? I_IN + I_OUT : 0), total = it_hi < full ? it_hi : full;
    int it = it_lo + gw; if (it >= total) return;
    CvtItem d = cvt_item(a, part, it); f32x4 v[8]; cvt_load(d, lane, v);
    for (;;) {
        const int itn = it + NGW; const bool more = itn < total;
        CvtItem dn = d; f32x4 vn[8];
#pragma unroll
        for (int i = 0; i < 8; ++i) vn[i] = v[i];
        if (more) { dn = cvt_item(a, part, itn); cvt_load(dn, lane, vn); }
        cvt_store(d, scr, lane, v);
        if (!more) break;
        d = dn; it = itn;
#pragma unroll
        for (int i = 0; i < 8; ++i) v[i] = vn[i];
    }
}
__device__ __forceinline__ void p0_prologue(const Args& a, LAS unsigned char* lds, int vcu, int G, int wave, int lane) {
    const int gw = vcu * 8 + wave, NGW = G * 8;
    unsigned char* ws = a.ws;
    convert_weights(a, lds, 0, gw, NGW, wave, lane);
    bf16* XB = (bf16*)(ws + WS_XB); float* SS0 = (float*)(ws + WS_SS);
    for (int m = gw; m < MROWS; m += NGW) {
        const float* xrow = (m < MP) ? a.in[I_XP] + (size_t)m * DM : a.in[I_XS] + (size_t)(m - MP) * DM;
        const GAS f32x4* xr = (const GAS f32x4*)xrow + lane;
        f32x4 v[8]; float s = 0.f;
#pragma unroll
        for (int j = 0; j < 8; ++j) { v[j] = __builtin_nontemporal_load(xr + 64 * j); s += (v[j].x * v[j].x + v[j].y * v[j].y) + (v[j].z * v[j].z + v[j].w * v[j].w); }
        s = wave_sum(s);
#pragma unroll
        for (int j = 0; j < 8; ++j) { v2u w; w.x = pk2(v[j].x, v[j].y); w.y = pk2(v[j].z, v[j].w); *(GAS v2u*)(XB + pg8::tiled_elem(m, 4 * lane + 256 * j, DM / 64)) = w; }
        if (lane == 0) SS0[m] = 1.0f / sqrtf(s * (1.0f / DM) + EPS);
    }
}

__device__ __forceinline__ void finalize_rstd(const float* SS, float* RS, int gw, int NGW, int lane, int nrows = MROWS) {
    const int hl = lane & 31, hf = lane >> 5;
    constexpr int NB = 9;
    for (int mb = 2 * gw; mb < nrows; mb += NB * 2 * NGW) {
        float s[NB];
#pragma unroll
        for (int k = 0; k < NB; ++k) { const int m = mb + k * 2 * NGW + hf; s[k] = m < nrows ? SS[(size_t)m * 32 + hl] : 0.f; }
#pragma unroll
        for (int k = 0; k < NB; ++k) {
            const int m = mb + k * 2 * NGW + hf;
            float v = s[k];
#pragma unroll
            for (int o = 1; o < 32; o <<= 1) v += __shfl_xor(v, o);
            if (hl == 0 && m < nrows) RS[m] = 1.0f / sqrtf(v * (1.0f / DM) + EPS);
        }
    }
}

__device__ __forceinline__ void final_norm_sample_rows(const Args& a, const float* PART, int gw, int NGW, int lane) {
    const bf16* XB = (const bf16*)(a.ws + WS_XB); const float* gf = a.in[I_GF];
    for (int r = gw; r < MS; r += NGW) {
        const int m = MP + r;
        pg8::f32x4 v[4][2]; float ss = 0.f;
#pragma unroll
        for (int j = 0; j < 4; ++j) {
            const int col = 8 * lane + 512 * j;
            const v4u w = *(const v4u*)(XB + pg8::tiled_elem(m, col, DM / 64));
            const float* p = PART + (size_t)r * DM + col;
            const pg8::f32x4 s0 = *(const pg8::f32x4*)p + *(const pg8::f32x4*)(p + (size_t)MS * DM), s1 = *(const pg8::f32x4*)(p + 4) + *(const pg8::f32x4*)(p + 4 + (size_t)MS * DM);
            v[j][0] = pg8::bf_lo4(w.x, w.y) + s0 * 0.5f; v[j][1] = pg8::bf_lo4(w.z, w.w) + s1 * 0.5f;
#pragma unroll
            for (int e = 0; e < 4; ++e) ss += v[j][0][e] * v[j][0][e] + v[j][1][e] * v[j][1][e];
        }
        const float rstd = 1.0f / sqrtf(wave_sum(ss) * (1.0f / DM) + EPS);
        float* yr = a.out + O_Y + (size_t)m * DM + 8 * lane;
#pragma unroll
        for (int j = 0; j < 4; ++j) { const pg8::f32x4 g0 = *(const pg8::f32x4*)(gf + 8 * lane + 512 * j), g1 = *(const pg8::f32x4*)(gf + 8 * lane + 512 * j + 4);
            *(pg8::f32x4*)(yr + 512 * j) = v[j][0] * rstd * g0; *(pg8::f32x4*)(yr + 512 * j + 4) = v[j][1] * rstd * g1; }
    }
}

template <int NS> __device__ __forceinline__ void reduce_sample_rows(const Args& a, const float* PART, float scale, float* RS, int gw, int NGW, int lane) {
    bf16* XB = (bf16*)(a.ws + WS_XB);
    for (int r = gw; r < MS; r += NGW) {
        const int m = MP + r;
        pg8::f32x4 v[4][2]; float ss = 0.f;
#pragma unroll
        for (int j = 0; j < 4; ++j) {
            const int col = 8 * lane + 512 * j;
            const v4u w = *(const v4u*)(XB + pg8::tiled_elem(m, col, DM / 64));
            const float* p = PART + (size_t)r * DM + col;
            pg8::f32x4 s0 = *(const pg8::f32x4*)p, s1 = *(const pg8::f32x4*)(p + 4);
#pragma unroll
            for (int q = 1; q < NS; ++q) { s0 += *(const pg8::f32x4*)(p + (size_t)q * MS * DM); s1 += *(const pg8::f32x4*)(p + 4 + (size_t)q * MS * DM); }
            v[j][0] = pg8::bf_lo4(w.x, w.y) + s0 * scale; v[j][1] = pg8::bf_lo4(w.z, w.w) + s1 * scale;
#pragma unroll
            for (int e = 0; e < 4; ++e) ss += v[j][0][e] * v[j][0][e] + v[j][1][e] * v[j][1][e];
        }
        const float rstd = 1.0f / sqrtf(wave_sum(ss) * (1.0f / DM) + EPS);
#pragma unroll
        for (int j = 0; j < 4; ++j) *(pg8::u32x4*)(XB + pg8::tiled_elem(m, 8 * lane + 512 * j, DM / 64)) = pg8::pack8(v[j][0], v[j][1]);
        if (lane == 0) RS[m] = rstd;
    }
}

constexpr float CP_EXIT = 8.8817841970012523e-16f;
constexpr int KS_PITCH = 272;
__device__ __forceinline__ float ex2(float x) { return __builtin_amdgcn_exp2f(x); }
__device__ __forceinline__ void sb_tile(f32x16& p0, f32x16& p1, float& cp, bool diag, int kv0, int qpos, int hh) {
    float om0[16], om1[16];
#pragma unroll
    for (int i = 0; i < 16; ++i) {
        { const float E = ex2(fminf(p0[i], 60.f)), rr = __builtin_amdgcn_rcpf(1.f + E); om0[i] = rr; p0[i] = E * rr; }
        { const float E = ex2(fminf(p1[i], 60.f)), rr = __builtin_amdgcn_rcpf(1.f + E); om1[i] = rr; p1[i] = E * rr; }
    }
    if (diag) {
        int rel = qpos - kv0 - 4 * hh; asm volatile("" : "+v"(rel));
#pragma unroll
        for (int i = 0; i < 16; ++i) { const int kvr = (i & 3) + 8 * (i >> 2);
            if (kvr >= rel) { om0[i] = 1.f; p0[i] = 0.f; }
            if (kvr + 32 >= rel) { om1[i] = 1.f; p1[i] = 0.f; } }
    }
    float gp[8], pp[8], T[8], E[8];
#pragma unroll
    for (int g = 0; g < 4; ++g) { gp[g] = (om0[4 * g] * om0[4 * g + 1]) * (om0[4 * g + 2] * om0[4 * g + 3]); gp[4 + g] = (om1[4 * g] * om1[4 * g + 1]) * (om1[4 * g + 2] * om1[4 * g + 3]); }
#pragma unroll
    for (int o = 0; o < 8; ++o) { float lo, hi; halves32(gp[o], lo, hi); pp[o] = hh == 0 ? hi : lo; T[o] = lo * hi; }
    E[7] = cp;
#pragma unroll
    for (int o = 6; o >= 0; --o) E[o] = E[o + 1] * T[o + 1];
    cp = E[0] * T[0];
#pragma unroll
    for (int g = 0; g < 4; ++g) {
        { const float off = E[g] * (hh == 0 ? pp[g] : 1.f); const float s3 = off, s2 = s3 * om0[4 * g + 3], s1 = s2 * om0[4 * g + 2], s0 = s1 * om0[4 * g + 1];
          p0[4 * g + 3] *= s3; p0[4 * g + 2] *= s2; p0[4 * g + 1] *= s1; p0[4 * g] *= s0; }
        { const float off = E[4 + g] * (hh == 0 ? pp[4 + g] : 1.f); const float s3 = off, s2 = s3 * om1[4 * g + 3], s1 = s2 * om1[4 * g + 2], s0 = s1 * om1[4 * g + 1];
          p1[4 * g + 3] *= s3; p1[4 * g + 2] *= s2; p1[4 * g + 1] *= s1; p1[4 * g] *= s0; }
    }
}
__device__ __forceinline__ bf16x8 pack_frag(const f32x16& p, int half) {
    v4u w; w.x = pk2(p[8 * half + 0], p[8 * half + 1]); w.y = pk2(p[8 * half + 2], p[8 * half + 3]); w.z = pk2(p[8 * half + 4], p[8 * half + 5]); w.w = pk2(p[8 * half + 6], p[8 * half + 7]);
    return __builtin_bit_cast(bf16x8, w);
}
constexpr int RP = 320;
__device__ __forceinline__ s16x4 trd(const LAS unsigned char* blk, int pitch, int lane) {
    typedef short v4i16_t __attribute__((ext_vector_type(4)));
    const int i = lane & 15;
    return __builtin_bit_cast(s16x4, __builtin_amdgcn_ds_read_tr16_b64_v4i16((LAS v4i16_t*)(blk + (i >> 2) * pitch + 8 * (i & 3))));
}
__device__ __forceinline__ bf16x8 tr_frag(const LAS unsigned char* tile, int ra, int rb, int cbase, int lane) {
    const int g = (lane >> 4) & 1;
    const s16x4 lo = trd(tile + ra * RP + (cbase + 16 * g) * 2, RP, lane), hi = trd(tile + rb * RP + (cbase + 16 * g) * 2, RP, lane);
    return (bf16x8){lo[0], lo[1], lo[2], lo[3], hi[0], hi[1], hi[2], hi[3]};
}
__device__ __forceinline__ void attn_prompt_pair(const Args& a, LAS unsigned char* lds, int b, int h, int j, int tid, int wave, int lane) {
    const bf16* QA = (const bf16*)(a.ws + WS_QA); const bf16* KA = (const bf16*)(a.ws + WS_KA); const bf16* VA = (const bf16*)(a.ws + WS_VA);
    bf16* MRG = (bf16*)(a.out + O_Y);
    const int r = lane & 31, hh = lane >> 5, half = wave >> 2, hw = wave & 3;
    const int t0w = (2 * j + half) * 128 + hw * 32;
    const size_t mrow = (size_t)b * TP + t0w + r;
    f32x16 o[4];
#pragma unroll
    for (int k = 0; k < 4; ++k)
#pragma unroll
        for (int i = 0; i < 16; ++i) o[k][i] = 0.f;
    float cp = 1.f;
    constexpr int ABUF = 64 * KS_PITCH + 64 * RP + 128 * KS_PITCH;
    LAS unsigned char* Ks = lds + half * ABUF; LAS unsigned char* VS = Ks + 64 * KS_PITCH; LAS unsigned char* QS = VS + 64 * RP;
    static_assert(2 * ABUF + 64 <= LDSCTL_OFF, "attention LDS");
    LAS unsigned* DONE = (LAS unsigned*)(lds + 2 * ABUF);
    bool wdone = false;
    const int htid = tid & 255, srow = htid >> 4, sc8 = htid & 15;
    {
        const bf16* qg = QA + ((size_t)b * TP + (2 * j + half) * 128 + srow) * GW + h * HD + 8 * sc8;
#pragma unroll
        for (int i = 0; i < 8; ++i) *(LAS v4u*)(QS + (srow + 16 * i) * KS_PITCH + 16 * sc8) = *(const v4u*)(qg + (size_t)(16 * i) * GW);
    }
    const LAS unsigned char* qrow = QS + (hw * 32 + r) * KS_PITCH + hh * 16;
    const bf16* kg = KA + ((size_t)b * TP + srow) * GW + h * HD + 8 * sc8; const bf16* vg = VA + ((size_t)b * TP + srow) * GW + h * HD + 8 * sc8;
    v4u pk[4], pv[4];
    { const int jt0 = 2 * (2 * j + half) + 1;
#pragma unroll
      for (int i = 0; i < 4; ++i) { pk[i] = *(const v4u*)(kg + (size_t)(64 * jt0 + 16 * i) * GW); pv[i] = *(const v4u*)(vg + (size_t)(64 * jt0 + 16 * i) * GW); } }
    for (int jt = 2 * (2 * j + half) + 1;; --jt) {
        if (jt < 0) wdone = true;
        if (lane == 0) DONE[wave] = wdone ? 1u : 0u;
        __syncthreads();
        { const v4u d0 = *(const LAS v4u*)DONE, d1 = *(const LAS v4u*)(DONE + 4); if ((d0.x & d0.y & d0.z & d0.w & d1.x & d1.y & d1.z & d1.w) != 0u) break; }
        if (jt >= 0) {
            LAS unsigned char* kd = Ks + srow * KS_PITCH + 16 * sc8; LAS unsigned char* vd = VS + srow * RP + 16 * sc8;
#pragma unroll
            for (int i = 0; i < 4; ++i) { *(LAS v4u*)(kd + 16 * i * KS_PITCH) = pk[i]; *(LAS v4u*)(vd + 16 * i * RP) = pv[i]; }
        }
        if (jt >= 1) {
#pragma unroll
            for (int i = 0; i < 4; ++i) { pk[i] = *(const v4u*)(kg + (size_t)(64 * (jt - 1) + 16 * i) * GW); pv[i] = *(const v4u*)(vg + (size_t)(64 * (jt - 1) + 16 * i) * GW); }
        }
        __syncthreads();
        if (!wdone && 64 * jt <= t0w + 30) {
            f32x16 p0, p1;
#pragma unroll
            for (int i = 0; i < 16; ++i) { p0[i] = 0.f; p1[i] = 0.f; }
#pragma unroll
            for (int ks = 0; ks < 8; ++ks) {
                const bf16x8 k0 = *(const LAS bf16x8*)(Ks + r * KS_PITCH + (ks * 16 + hh * 8) * 2);
                const bf16x8 k1 = *(const LAS bf16x8*)(Ks + (32 + r) * KS_PITCH + (ks * 16 + hh * 8) * 2);
                const bf16x8 qf = *(const LAS bf16x8*)(qrow + ks * 32);
                p0 = MFMA32(k0, qf, p0); p1 = MFMA32(k1, qf, p1);
            }
            sb_tile(p0, p1, cp, 64 * jt + 63 >= t0w, 64 * jt, t0w + r, hh);
            bf16x8 af[4]; af[0] = pack_frag(p0, 0); af[1] = pack_frag(p0, 1); af[2] = pack_frag(p1, 0); af[3] = pack_frag(p1, 1);
#pragma unroll
            for (int blk = 0; blk < 4; ++blk)
#pragma unroll
                for (int s = 0; s < 4; ++s) {
                    o[blk] = MFMA32(tr_frag(VS, 16 * s + 4 * hh, 16 * s + 8 + 4 * hh, 32 * blk, lane), af[s], o[blk]);
                }
            wdone = __ballot(cp >= CP_EXIT) == 0ull;
        }
    }
    __syncthreads();
    float ss = 0.f;
#pragma unroll
    for (int k = 0; k < 4; ++k)
#pragma unroll
        for (int i = 0; i < 16; ++i) ss += o[k][i] * o[k][i];
    ss = sum_halves32(ss);
    const float rstd = 1.0f / sqrtf(ss * (1.0f / 128.0f) + EPS);
    const float* sbg = a.in[I_SBG] + h * HD;
#pragma unroll
    for (int k = 0; k < 4; ++k)
#pragma unroll
        for (int g = 0; g < 4; ++g) { const int d = 32 * k + 8 * g + 4 * hh; const f32x4 gv = *(const f32x4*)(sbg + d);
            v2u w; w.x = pk2(o[k][4 * g] * rstd * gv[0], o[k][4 * g + 1] * rstd * gv[1]); w.y = pk2(o[k][4 * g + 2] * rstd * gv[2], o[k][4 * g + 3] * rstd * gv[3]);
            *(v2u*)(MRG + pg8::tiled_elem((int)mrow, h * HD + d, DM / 64)) = w; }
}
__device__ __forceinline__ void attn_prompt_phase(const Args& a, LAS unsigned char* lds, int vcu, int G, int tid, int wave, int lane) {
    for (int p = vcu; p < NBP * NH * (TP / 256); p += G) {
        const int bh = p >> 5, j = p & 31;
        attn_prompt_pair(a, lds, bh >> 3, bh & 7, j, tid, wave, lane);
    }
}

constexpr int SEGK = 128;
__device__ __forceinline__ void attn_sample_unit(const Args& a, LAS unsigned char* lds, int b, int h, int tid, int wave, int lane) {
    LAS float* Qs = (LAS float*)lds;
    LAS float* OM = (LAS float*)(lds + 8192);
    LAS float* BT = (LAS float*)(lds + 16384);
    LAS float* RED = (LAS float*)(lds + 24576);
    LAS float* CAR = (LAS float*)(lds + 24576 + 256);
    const bf16* QA = (const bf16*)(a.ws + WS_QA); bf16* MRG = (bf16*)(a.out + O_Y);
    __syncthreads();
    for (int i = tid; i < 16 * 128; i += 512) { const int q = i >> 7, d = i & 127; Qs[i] = bf2f(QA[(size_t)(MP + b * TS + q) * GW + h * HD + d]); }
    __syncthreads();
    const int dch = tid & 127, qg = tid >> 7;
    float oacc[4] = {0.f, 0.f, 0.f, 0.f};
    float carry0 = 1.f, carry1 = 1.f;
    for (int seg = 0; seg <= PAST / SEGK; ++seg) {
        const bool isnew = seg == 0; const int seglen = isnew ? TS : SEGK, kstart = isnew ? 0 : PAST - seg * SEGK;
        {
            float om[4] = {1.f, 1.f, 1.f, 1.f}, bt[4] = {0.f, 0.f, 0.f, 0.f};
            if (dch < seglen) {
                const float* krow = isnew ? a.out + O_KS + ((size_t)(b * TS + dch) * NH + h) * HD : a.in[I_CK] + (((size_t)b * PAST + kstart + dch) * NH + h) * HD;
                float z[4] = {0.f, 0.f, 0.f, 0.f};
#pragma unroll 8
                for (int d4 = 0; d4 < 32; ++d4) { const f32x4 kv = *(const f32x4*)(krow + 4 * d4);
#pragma unroll
                    for (int q = 0; q < 4; ++q) { const f32x4 qv = *(const LAS f32x4*)(Qs + (4 * qg + q) * 128 + 4 * d4); z[q] += (kv[0] * qv[0] + kv[1] * qv[1]) + (kv[2] * qv[2] + kv[3] * qv[3]); } }
#pragma unroll
                for (int q = 0; q < 4; ++q) { const float E = ex2(fminf(z[q], 60.f)), rr = __builtin_amdgcn_rcpf(1.f + E); om[q] = rr; bt[q] = E * rr;
                    if (isnew && dch >= 4 * qg + q) { om[q] = 1.f; bt[q] = 0.f; } }
            }
#pragma unroll
            for (int q = 0; q < 4; ++q) { OM[(4 * qg + q) * SEGK + dch] = om[q]; BT[(4 * qg + q) * SEGK + dch] = bt[q]; }
        }
        __syncthreads();
#pragma unroll
        for (int rr2 = 0; rr2 < 2; ++rr2) { const int q = 2 * wave + rr2; float& carry = rr2 ? carry1 : carry0;
            const float om0 = OM[q * SEGK + 2 * lane], om1 = OM[q * SEGK + 2 * lane + 1], bt0 = BT[q * SEGK + 2 * lane], bt1 = BT[q * SEGK + 2 * lane + 1];
            float inc = om0 * om1;
#pragma unroll
            for (int off = 1; off < 64; off <<= 1) { const float v = __shfl_down(inc, off); if (lane + off < 64) inc *= v; }
            float exc = __shfl_down(inc, 1); if (lane == 63) exc = 1.f;
            const float suf = carry * exc;
            BT[q * SEGK + 2 * lane + 1] = bt1 * suf; BT[q * SEGK + 2 * lane] = bt0 * suf * om1;
            carry = carry * __shfl(inc, 0);
            if (lane == 0) CAR[q] = carry;
        }
        __syncthreads();
        {
            const float* vbase = isnew ? a.out + O_VS + ((size_t)(b * TS) * NH + h) * HD + dch : a.in[I_CV] + (((size_t)b * PAST + kstart) * NH + h) * HD + dch;
            for (int k4 = 0; k4 < seglen; k4 += 4) {
                float v[4];
#pragma unroll
                for (int e = 0; e < 4; ++e) v[e] = vbase[(size_t)(k4 + e) * (NH * HD)];
#pragma unroll
                for (int i = 0; i < 4; ++i) { const f32x4 aw = *(const LAS f32x4*)(BT + (4 * qg + i) * SEGK + k4); oacc[i] += (aw[0] * v[0] + aw[1] * v[1]) + (aw[2] * v[2] + aw[3] * v[3]); }
            }
        }
        float cmax = 0.f;
#pragma unroll
        for (int q4 = 0; q4 < 4; ++q4) { const f32x4 cv = *(const LAS f32x4*)(CAR + 4 * q4); cmax = fmaxf(fmaxf(cmax, fmaxf(cv[0], cv[1])), fmaxf(cv[2], cv[3])); }
        __syncthreads();
        if (cmax < CP_EXIT) break;
    }
#pragma unroll
    for (int i = 0; i < 4; ++i) { const float s = wave_sum(oacc[i] * oacc[i]); if (lane == 0) RED[(4 * qg + i) * 4 + (wave & 1)] = s; }
    __syncthreads();
    const float gsb = a.in[I_SBG][h * HD + dch];
#pragma unroll
    for (int i = 0; i < 4; ++i) { const int q = 4 * qg + i; const float ss = RED[q * 4] + RED[q * 4 + 1]; const float rstd = 1.0f / sqrtf(ss * (1.0f / 128.0f) + EPS);
        MRG[pg8::tiled_elem(MP + b * TS + q, h * HD + dch, DM / 64)] = f2bf(oacc[i] * rstd * gsb); }
}

constexpr int SEGC = 16, NSEGB = (TP / 64) / SEGC, NSEGP = NBP * NH * NSEGB;
constexpr int C0_PITCH = 272;
typedef float f32x2v __attribute__((ext_vector_type(2)));
constexpr int ML_QS = 0, ML_KS = 17408, ML_KT = 34816  , ML_VT = ML_KT + 64 * RP  , ML_C0 = 76288, ML_CWL = 119808, ML_PS = 127520, ML_MLG = 128544, ML_NST = 129056  ;
constexpr int ML_TAB = 132096, TAB_GS = ML_TAB, TAB_CM = ML_TAB + 4096, TAB_BS = ML_TAB + 8192, TAB_WA = ML_TAB + 12288, TAB_SC = ML_TAB + 16384, TAB_M = TAB_SC + 256, ML_TAB_END = TAB_M + 128;
static_assert(ML_TAB >= RING_BYTES && ML_TAB_END <= LDSCTL_OFF, "mLSTM gate tables");
static_assert(ML_VT + 64 * RP <= ML_C0 && ML_C0 + 2 * 64 * RP <= ML_CWL && ML_NST + 512 <= RING_BYTES, "mLSTM LDS map");

struct MUnit { int b, h, nvalid, nch, samp, sid, sg, t0; size_t row0; };
__device__ __forceinline__ MUnit munit_prompt(int seg) { MUnit u; const int bh = seg / NSEGB; u.sg = seg % NSEGB; u.b = bh >> 3; u.h = bh & 7; u.nvalid = 64; u.nch = SEGC; u.samp = 0; u.sid = seg;
    u.t0 = u.sg * SEGC * 64; u.row0 = (size_t)u.b * TP + u.t0; return u; }
__device__ __forceinline__ MUnit munit_sample(int sid) { MUnit u; u.b = sid >> 3; u.h = sid & 7; u.sg = 0; u.nvalid = TS; u.nch = 1; u.samp = 1; u.sid = sid; u.t0 = 0; u.row0 = (size_t)MP + u.b * TS; return u; }

__device__ __forceinline__ void unpack8(const v4u w, float (&x)[8]) {
    x[0] = __uint_as_float(w.x << 16); x[1] = __uint_as_float(w.x & 0xffff0000u); x[2] = __uint_as_float(w.y << 16); x[3] = __uint_as_float(w.y & 0xffff0000u);
    x[4] = __uint_as_float(w.z << 16); x[5] = __uint_as_float(w.z & 0xffff0000u); x[6] = __uint_as_float(w.w << 16); x[7] = __uint_as_float(w.w & 0xffff0000u);
}
__device__ __forceinline__ void load_taps(const bf16* src, int tpos, v4u (&raw)[5]) {
#pragma unroll
    for (int j = 0; j < 5; ++j) { raw[j] = (v4u){0u, 0u, 0u, 0u}; if (tpos + j - 3 >= 0) raw[j] = *(const v4u*)(src + (long)(j - 3) * 2048); }
}
__device__ __forceinline__ void conv8x2(const v4u (&raw)[5], int tpos  , bool samp, const float* hist  , const LAS float* cwl  ,
                                        float sc, float (&o0)[8], float (&o1)[8], float (&x3)[8], float (&x4)[8]) {
    float x[5][8];
#pragma unroll
    for (int j = 0; j < 5; ++j) {
        const int tt = tpos + j - 3;
        unpack8(raw[j], x[j]);
        if (tt < 0 && samp) { const float* sp = hist + (size_t)(3 + tt) * 2048; const f32x4 s0 = *(const f32x4*)sp, s1 = *(const f32x4*)(sp + 4); x[j][0] = s0[0]; x[j][1] = s0[1]; x[j][2] = s0[2]; x[j][3] = s0[3]; x[j][4] = s1[0]; x[j][5] = s1[1]; x[j][6] = s1[2]; x[j][7] = s1[3]; }
    }
    { const f32x4 b0 = *(const LAS f32x4*)(cwl + 4 * 128), b1 = *(const LAS f32x4*)(cwl + 4 * 128 + 4);
#pragma unroll
      for (int e = 0; e < 4; ++e) { o0[e] = b0[e]; o0[4 + e] = b1[e]; o1[e] = b0[e]; o1[4 + e] = b1[e]; } }
#pragma unroll
    for (int j = 0; j < 4; ++j) { const f32x4 w0 = *(const LAS f32x4*)(cwl + j * 128), w1 = *(const LAS f32x4*)(cwl + j * 128 + 4);
#pragma unroll
        for (int e = 0; e < 4; ++e) { o0[e] += w0[e] * x[j][e]; o0[4 + e] += w1[e] * x[j][4 + e]; o1[e] += w0[e] * x[j + 1][e]; o1[4 + e] += w1[e] * x[j + 1][4 + e]; } }
#pragma unroll
    for (int e = 0; e < 8; ++e) { o0[e] = o0[e] * pg8::sigmoid_f(o0[e]) * sc; o1[e] = o1[e] * pg8::sigmoid_f(o1[e]) * sc; x3[e] = x[3][e]; x4[e] = x[4][e]; }
}
__device__ __forceinline__ v4u pack8f(const float (&v)[8]) { v4u w; w.x = pk2(v[0], v[1]); w.y = pk2(v[2], v[3]); w.z = pk2(v[4], v[5]); w.w = pk2(v[6], v[7]); return w; }
__device__ __forceinline__ v4u pack8fs(const float (&v)[8], float s) { v4u w; w.x = pk2(v[0] * s, v[1] * s); w.y = pk2(v[2] * s, v[3] * s); w.z = pk2(v[4] * s, v[5] * s); w.w = pk2(v[6] * s, v[7] * s); return w; }
template <bool OUT> __device__ __forceinline__ void stage_chunk(const Args& a, LAS unsigned char* lds, const MUnit& u, int c, int wkoff, int tid) {
    const LAS float* WA = (const LAS float*)(lds + TAB_WA) + 64 * c;
    const bf16* QKB = (const bf16*)(a.ws + WS_QKB); const bf16* VB = (const bf16*)(a.ws + WS_VB);
    const size_t rowc = u.row0 + 64 * c; const int tc = u.t0 + 64 * c;
    const int c8 = tid & 15, s0 = 2 * (tid >> 4);
    const LAS float* cwq = (const LAS float*)(lds + ML_CWL) + 8 * c8; const LAS float* cwk = cwq + 5 * 128;
    const float* histq = a.in[I_SCONV] + (size_t)u.b * 3 * 2048 + u.h * HD + 8 * c8; const float* histk = histq + 1024;
    const bool lastchunk = OUT && (u.samp || (u.sg == NSEGB - 1 && c == SEGC - 1));
    const v4u z4 = (v4u){0u, 0u, 0u, 0u};
    const bool valid = s0 < u.nvalid;
    LAS unsigned char* qsb = lds + ML_QS + s0 * KS_PITCH + 16 * c8;
    LAS unsigned char* wkb = lds + wkoff + s0 * RP + 16 * c8;
    float* ob = a.out + (u.samp ? O_CVS : O_CVP) + (size_t)u.b * 3 * 2048 + u.h * HD + 8 * c8;
    const bool w0 = lastchunk && s0 >= u.nvalid - 3, w1 = lastchunk && s0 + 1 >= u.nvalid - 3;
    v4u rk[5], rq[5], v0 = z4, v1 = z4;
#pragma unroll
    for (int j = 0; j < 5; ++j) { rk[j] = z4; rq[j] = z4; }
    if (valid) {
        load_taps(QKB + (rowc + s0) * 2048 + 1024 + u.h * HD + 8 * c8, tc + s0, rk);
        if (OUT) load_taps(QKB + (rowc + s0) * 2048 + u.h * HD + 8 * c8, tc + s0, rq);
        v0 = *(const v4u*)(VB + (rowc + s0) * GW + u.h * HD + 8 * c8); v1 = *(const v4u*)(VB + (rowc + s0 + 1) * GW + u.h * HD + 8 * c8);
    }
    {
        v4u k0 = z4, k1 = z4, wk0 = z4, wk1 = z4;
        if (valid) { float o0[8], o1[8], x3[8], x4[8];
            conv8x2(rk, tc + s0, u.samp != 0, histk, cwk, KSCALE, o0, o1, x3, x4);
            wk0 = pack8fs(o0, WA[s0]); wk1 = pack8fs(o1, WA[s0 + 1]);
            if (OUT) { k0 = pack8f(o0); k1 = pack8f(o1);
                if (w0) { float* o = ob + (size_t)(s0 - (u.nvalid - 3)) * 2048 + 1024; *(f32x4*)o = (f32x4){x3[0], x3[1], x3[2], x3[3]}; *(f32x4*)(o + 4) = (f32x4){x3[4], x3[5], x3[6], x3[7]}; }
                if (w1) { float* o = ob + (size_t)(s0 + 1 - (u.nvalid - 3)) * 2048 + 1024; *(f32x4*)o = (f32x4){x4[0], x4[1], x4[2], x4[3]}; *(f32x4*)(o + 4) = (f32x4){x4[4], x4[5], x4[6], x4[7]}; } } }
        if (OUT) { *(LAS v4u*)(qsb + (ML_KS - ML_QS)) = k0; *(LAS v4u*)(qsb + (ML_KS - ML_QS) + KS_PITCH) = k1; }
        *(LAS v4u*)wkb = wk0; *(LAS v4u*)(wkb + RP) = wk1;
        *(LAS v4u*)(wkb + 64 * RP) = v0; *(LAS v4u*)(wkb + 64 * RP + RP) = v1;
    }
    if (OUT) {
        __builtin_amdgcn_sched_barrier(0);
        v4u q0 = z4, q1 = z4;
        if (valid) { float o0[8], o1[8], x3[8], x4[8];
            conv8x2(rq, tc + s0, u.samp != 0, histq, cwq, 1.0f, o0, o1, x3, x4);
            q0 = pack8f(o0); q1 = pack8f(o1);
            if (w0) { float* o = ob + (size_t)(s0 - (u.nvalid - 3)) * 2048; *(f32x4*)o = (f32x4){x3[0], x3[1], x3[2], x3[3]}; *(f32x4*)(o + 4) = (f32x4){x3[4], x3[5], x3[6], x3[7]}; }
            if (w1) { float* o = ob + (size_t)(s0 + 1 - (u.nvalid - 3)) * 2048; *(f32x4*)o = (f32x4){x4[0], x4[1], x4[2], x4[3]}; *(f32x4*)(o + 4) = (f32x4){x4[4], x4[5], x4[6], x4[7]}; } }
        *(LAS v4u*)qsb = q0; *(LAS v4u*)(qsb + KS_PITCH) = q1;
    }
}
__device__ __forceinline__ void load_kv(const Args& a, const MUnit& u, int c, int tid, v4u (&t)[7]) {
    const bf16* QKB = (const bf16*)(a.ws + WS_QKB); const bf16* VB = (const bf16*)(a.ws + WS_VB);
    const size_t rowc = u.row0 + 64 * c; const int tc = u.t0 + 64 * c;
    const int c8 = tid & 15, s0 = 2 * (tid >> 4);
    v4u rk[5]; load_taps(QKB + (rowc + s0) * 2048 + 1024 + u.h * HD + 8 * c8, tc + s0, rk);
#pragma unroll
    for (int j = 0; j < 5; ++j) t[j] = rk[j];
    t[5] = *(const v4u*)(VB + (rowc + s0) * GW + u.h * HD + 8 * c8); t[6] = *(const v4u*)(VB + (rowc + s0 + 1) * GW + u.h * HD + 8 * c8);
}
__device__ __forceinline__ void process_kv(const Args& a, LAS unsigned char* lds, const MUnit& u, int c, int wkoff, int tid, const v4u (&t)[7]) {
    const LAS float* WA = (const LAS float*)(lds + TAB_WA) + 64 * c;
    const int tc = u.t0 + 64 * c, c8 = tid & 15, s0 = 2 * (tid >> 4);
    const LAS float* cwk = (const LAS float*)(lds + ML_CWL) + 8 * c8 + 5 * 128;
    const float* histk = a.in[I_SCONV] + (size_t)u.b * 3 * 2048 + u.h * HD + 8 * c8 + 1024;
    v4u rk[5];
#pragma unroll
    for (int j = 0; j < 5; ++j) rk[j] = t[j];
    float o0[8], o1[8], x3[8], x4[8];
    conv8x2(rk, tc + s0, u.samp != 0, histk, cwk, KSCALE, o0, o1, x3, x4);
    LAS unsigned char* wkb = lds + wkoff + s0 * RP + 16 * c8;
    *(LAS v4u*)wkb = pack8fs(o0, WA[s0]); *(LAS v4u*)(wkb + RP) = pack8fs(o1, WA[s0 + 1]);
    *(LAS v4u*)(wkb + 64 * RP) = t[5]; *(LAS v4u*)(wkb + 64 * RP + RP) = t[6];
}
__device__ __forceinline__ void munit_setup(const Args& a, LAS unsigned char* lds, const MUnit& u, int tid, bool both  ) {
    LAS float* cwl = (LAS float*)(lds + ML_CWL);
    for (int i = tid; i < 2 * 5 * 128; i += 512) { const int qk = i / 640, j = (i % 640) >> 7, d = i & 127;
        cwl[i] = j < 4 ? a.in[I_CONVW][(size_t)j * 2048 + qk * 1024 + u.h * HD + d] : a.in[I_CONVB][qk * 1024 + u.h * HD + d]; }
    for (int i = tid; i < 64 * 4; i += 512) { const int row = i >> 2, q = i & 3; const v4u w = (v4u){q == 0 ? 0x3f80u : 0u, 0u, 0u, 0u};
        *(LAS v4u*)(lds + ML_VT + row * RP + 256 + 16 * q) = w; if (both) *(LAS v4u*)(lds + ML_C0 + 64 * RP + row * RP + 256 + 16 * q) = w; }
    if (tid < 128) ((LAS float*)(lds + ML_MLG))[tid] = a.in[I_MLG][u.h * HD + tid];
}
__device__ __forceinline__ float lane_read(float v, int src) { return __int_as_float(__builtin_amdgcn_ds_bpermute(src << 2, __float_as_int(v))); }
__device__ __forceinline__ void chunk_gates(const float* G, size_t rowc, int nvalid, int h, int lane, float& bs, float& gs, float& Btot, float& Gmax) {
    float ig = -INFINITY, lf = 0.f;
    if (lane < nvalid) { ig = G[(rowc + lane) * 16 + h]; lf = G[(rowc + lane) * 16 + 8 + h]; }
    float x = lf;
#pragma unroll
    for (int off = 1; off < 64; off <<= 1) { const float v = lane_read(x, lane >= off ? lane - off : lane); if (lane >= off) x += v; }
    bs = x; gs = ig - x; Btot = lane_read(x, 63 | (lane & 0));
    float mxv = gs;
#pragma unroll
    for (int off = 1; off < 64; off <<= 1) mxv = fmaxf(mxv, lane_read(mxv, lane ^ off));
    Gmax = mxv;
}
__device__ __forceinline__ void gate_tables(const float* G, LAS unsigned char* lds, const MUnit& u, float m0, int tid, int wave, int lane) {
    for (int c = wave; c < u.nch; c += 8) {
        float bs, gs, Bt, Gm; chunk_gates(G, u.row0 + 64 * c, u.nvalid, u.h, lane, bs, gs, Bt, Gm);
        float cm = gs;
#pragma unroll
        for (int off = 1; off < 64; off <<= 1) { const float v = lane_read(cm, lane >= off ? lane - off : lane); if (lane >= off) cm = fmaxf(cm, v); }
        ((LAS float*)(lds + TAB_GS))[64 * c + lane] = gs; ((LAS float*)(lds + TAB_CM))[64 * c + lane] = cm; ((LAS float*)(lds + TAB_BS))[64 * c + lane] = bs; ((LAS float*)(lds + TAB_WA))[64 * c + lane] = __expf(gs - Gm);
        if (lane == 0) { ((LAS float*)(lds + TAB_SC))[4 * c] = Bt; ((LAS float*)(lds + TAB_SC))[4 * c + 1] = Gm; }
    }
    __syncthreads();
    if (tid == 0) { float m = m0; LAS float* SC = (LAS float*)(lds + TAB_SC); LAS float* M = (LAS float*)(lds + TAB_M); float bsum = 0.f;
        for (int c = 0; c < u.nch; ++c) { M[c] = m; const float Bt = SC[4 * c], Gm = SC[4 * c + 1], mx = fmaxf(m, Gm); SC[4 * c + 2] = __expf(m - mx); SC[4 * c + 3] = __expf(Gm - mx); m = Bt + mx; bsum += Bt; }
        M[u.nch] = m; M[u.nch + 1] = bsum; }
    __syncthreads();
}
__device__ __forceinline__ void state_update(LAS unsigned char* lds, int wkoff, f32x16 (&R)[2], float& nst, float al, float be, int wave, int lane) {
    const int hh = lane >> 5, dkb = wave & 3, dvh = wave >> 2;
    const LAS unsigned char* WK = lds + wkoff; const LAS unsigned char* VS = WK + 64 * RP;
    bf16x8 kf[4];
#pragma unroll
    for (int ks = 0; ks < 4; ++ks) kf[ks] = tr_frag(WK, 16 * ks + 8 * hh, 16 * ks + 8 * hh + 4, dkb * 32, lane);
#pragma unroll
    for (int t = 0; t < 2; ++t) {
        const int dvb = 2 * dvh + t; f32x16 U;
#pragma unroll
        for (int i = 0; i < 16; ++i) U[i] = 0.f;
#pragma unroll
        for (int ks = 0; ks < 4; ++ks) U = MFMA32(tr_frag(VS, 16 * ks + 8 * hh, 16 * ks + 8 * hh + 4, dvb * 32, lane), kf[ks], U);
#pragma unroll
        for (int i = 0; i < 16; ++i) R[t][i] = al * R[t][i] + be * U[i];
    }
    if (dvh == 0) { f32x16 U;
#pragma unroll
        for (int i = 0; i < 16; ++i) U[i] = 0.f;
#pragma unroll
        for (int ks = 0; ks < 4; ++ks) U = MFMA32(tr_frag(VS, 16 * ks + 8 * hh, 16 * ks + 8 * hh + 4, 128, lane), kf[ks], U);
        nst = al * nst + be * U[0]; }
}
__device__ __forceinline__ void mlstm_summary_unit(const Args& a, LAS unsigned char* lds, int seg, int tid, int wave, int lane) {
    asm volatile("" : "+v"(tid), "+v"(lane));
    const MUnit u = munit_prompt(seg);
    const float* G = (const float*)(a.ws + WS_G);
    __syncthreads();
    munit_setup(a, lds, u, tid, true);
    gate_tables(G, lds, u, -INFINITY, tid, wave, lane);
    f32x16 R[2]; float nst = 0.f;
#pragma unroll
    for (int t = 0; t < 2; ++t)
#pragma unroll
        for (int i = 0; i < 16; ++i) R[t][i] = 0.f;
    v4u cur[7]; load_kv(a, u, 0, tid, cur);
    for (int cl = 0; cl < SEGC; ++cl) {
        int c = cl; asm volatile("" : "+s"(c));
        int tidc = tid, lanec = lane; asm volatile("" : "+v"(tidc), "+v"(lanec));
        const int tid = tidc, lane = lanec;
        const int ktoff = (c & 1) ? ML_C0 : ML_KT;
        v4u nxt[7];
#pragma unroll
        for (int j = 0; j < 7; ++j) nxt[j] = cur[j];
        if (c + 1 < SEGC) load_kv(a, u, c + 1, tid, nxt);
        process_kv(a, lds, u, c, ktoff, tid, cur);
#pragma unroll
        for (int j = 0; j < 7; ++j) cur[j] = nxt[j];
        __syncthreads();
        const LAS float* SC = (const LAS float*)(lds + TAB_SC) + 4 * c;
        state_update(lds, ktoff, R, nst, SC[2], SC[3], wave, lane);
    }
    const float Bseg = ((const LAS float*)(lds + TAB_M))[SEGC + 1], m_run = ((const LAS float*)(lds + TAB_M))[SEGC];
    int r = lane & 31; asm volatile("" : "+v"(r));
    const int hh = lane >> 5, dkb = wave & 3, dvh = wave >> 2;
    float* RS = (float*)(a.ws + WS_RSEG) + (size_t)seg * 16384 + wave * 2048 + hh * 32 + r;
#pragma unroll
    for (int t = 0; t < 2; ++t)
#pragma unroll
        for (int i = 0; i < 16; ++i) RS[(t * 16 + i) * 64] = R[t][i];
    if (dvh == 0 && hh == 0) ((float*)(a.ws + WS_NSEG))[(size_t)seg * 128 + dkb * 32 + r] = nst;
    if (tid == 0) { float* SS = (float*)(a.ws + WS_SSEG); SS[2 * seg] = Bseg; SS[2 * seg + 1] = m_run; }
}
__device__ __forceinline__ void mlstm_out_unit(const Args& a, LAS unsigned char* lds, const MUnit u, int tid, int wave, int lane) {
    asm volatile("" : "+v"(tid), "+v"(lane));
    const float* G = (const float*)(a.ws + WS_G);
    LAS float* PS = (LAS float*)(lds + ML_PS);
    LAS unsigned char* C0 = lds + ML_C0; LAS unsigned char* VT = lds + ML_VT;
    const bf16* OB = (const bf16*)(a.ws + WS_OB); bf16* MRG = (bf16*)(a.out + O_Y);
    const int r = lane & 31, hh = lane >> 5, dkb = wave & 3, dvh = wave >> 2;
    __syncthreads();
    munit_setup(a, lds, u, tid, false);
    f32x16 R[2]; float nst = 0.f, m_run = 0.f;
#pragma unroll
    for (int t = 0; t < 2; ++t)
#pragma unroll
        for (int i = 0; i < 16; ++i) R[t][i] = 0.f;
    if (u.samp) {
        const float* c0p = a.in[I_SC] + (size_t)u.sid * 16384;
#pragma unroll
        for (int t = 0; t < 2; ++t)
#pragma unroll
            for (int g = 0; g < 4; ++g) { const f32x4 v = *(const f32x4*)(c0p + (size_t)(dkb * 32 + r) * HD + (2 * dvh + t) * 32 + 8 * g + 4 * hh); R[t][4 * g] = v[0]; R[t][4 * g + 1] = v[1]; R[t][4 * g + 2] = v[2]; R[t][4 * g + 3] = v[3]; }
        nst = a.in[I_SN][(size_t)u.sid * 128 + dkb * 32 + r]; m_run = a.in[I_SM][u.sid];
    } else {
        const float* SSG = (const float*)(a.ws + WS_SSEG);
        const float* RSb = (const float*)(a.ws + WS_RSEG) + (size_t)(u.sid - u.sg) * 16384 + wave * 2048 + lane;
        const float* NSb = (const float*)(a.ws + WS_NSEG) + (size_t)(u.sid - u.sg) * 128 + dkb * 32 + r;
        const float* SGb = SSG + 2 * (u.sid - u.sg);
        f32x16 Rs[2]; float ns = 0.f, Bs = 0.f, ml = 0.f;
        if (u.sg > 0) {
#pragma unroll
            for (int t = 0; t < 2; ++t)
#pragma unroll
                for (int i = 0; i < 16; ++i) Rs[t][i] = RSb[(t * 16 + i) * 64];
            ns = NSb[0]; Bs = SGb[0]; ml = SGb[1];
        }
        for (int sp = 0; sp < u.sg; ++sp) {
            f32x16 Rn[2]; float nsn = 0.f, Bsn = 0.f, mln = 0.f;
            if (sp + 1 < u.sg) {
                const float* RS = RSb + (size_t)(sp + 1) * 16384;
#pragma unroll
                for (int t = 0; t < 2; ++t)
#pragma unroll
                    for (int i = 0; i < 16; ++i) Rn[t][i] = RS[(t * 16 + i) * 64];
                nsn = NSb[(sp + 1) * 128]; Bsn = SGb[2 * (sp + 1)]; mln = SGb[2 * (sp + 1) + 1];
            } else {
#pragma unroll
                for (int t = 0; t < 2; ++t)
#pragma unroll
                    for (int i = 0; i < 16; ++i) Rn[t][i] = 0.f;
            }
            const float mx = fmaxf(Bs + m_run, ml), al = __expf(Bs + m_run - mx), be = __expf(ml - mx);
#pragma unroll
            for (int t = 0; t < 2; ++t)
#pragma unroll
                for (int i = 0; i < 16; ++i) R[t][i] = al * R[t][i] + be * Rs[t][i];
            nst = al * nst + be * ns; m_run = mx;
#pragma unroll
            for (int t = 0; t < 2; ++t)
#pragma unroll
                for (int i = 0; i < 16; ++i) Rs[t][i] = Rn[t][i];
            ns = nsn; Bs = Bsn; ml = mln;
        }
    }
    gate_tables(G, lds, u, m_run, tid, wave, lane);
#pragma unroll
    for (int t = 0; t < 2; ++t)
#pragma unroll
        for (int i = 0; i < 16; ++i) *(LAS unsigned short*)(C0 + ((2 * dvh + t) * 32 + crow(i, hh)) * C0_PITCH + (dkb * 32 + r) * 2) = f2bf(R[t][i]);
    if (dvh == 0 && hh == 0) ((LAS float*)(lds + ML_NST))[dkb * 32 + r] = nst;
    const int tt = wave & 1, dvb = wave >> 1;
    const int t = 32 * tt + r; const bool tvalid = t < u.nvalid;
    const LAS float* mlg = (const LAS float*)(lds + ML_MLG);
    for (int cl = 0; cl < u.nch; ++cl) {
        int c = cl; asm volatile("" : "+s"(c));
        int tidc = tid, lanec = lane; asm volatile("" : "+v"(tidc), "+v"(lanec));
        const int tid = tidc, lane = lanec, r = lane & 31, hh = lane >> 5, t = 32 * tt + r; const bool tvalid = t < u.nvalid;
        const size_t rowc = u.row0 + 64 * c;
        const LAS float* GS = (const LAS float*)(lds + TAB_GS) + 64 * c;
        stage_chunk<true>(a, lds, u, c, ML_KT, tid);
        float touch = 0.f;
        if (cl + 1 < u.nch) { const size_t rn = rowc + 64 + (tid & 63); const int part = tid >> 6;
            const bf16* tb = part < 4 ? (const bf16*)(a.ws + WS_QKB) + rn * 2048 + (part >> 1) * 1024 + u.h * HD : (part < 6 ? (const bf16*)(a.ws + WS_VB) : OB) + rn * GW + u.h * HD;
            touch = *(const float*)(tb + (part & 1) * 64); }
        v2u ow[4];
#pragma unroll
        for (int g = 0; g < 4; ++g) { ow[g] = (v2u){0u, 0u}; if (tvalid) ow[g] = *(const v2u*)(OB + (rowc + t) * GW + u.h * HD + 32 * dvb + 8 * g + 4 * hh); }
        __syncthreads();
        const float m0c = ((const LAS float*)(lds + TAB_M))[c]; const float Mt = fmaxf(m0c, ((const LAS float*)(lds + TAB_CM))[64 * c + t]), it = __expf(m0c - Mt), et = __expf(-(((const LAS float*)(lds + TAB_BS))[64 * c + t] + Mt));
        f32x16 S0, S1, Nn; float dq = 0.f;
#pragma unroll
        for (int i = 0; i < 16; ++i) { S0[i] = 0.f; S1[i] = 0.f; Nn[i] = 0.f; }
        {
#pragma unroll
            for (int ks = 0; ks < 8; ++ks) {
                const bf16x8 qf = *(const LAS bf16x8*)(lds + ML_QS + t * KS_PITCH + (ks * 16 + hh * 8) * 2);
                const bf16x8 k0 = *(const LAS bf16x8*)(lds + ML_KS + r * KS_PITCH + (ks * 16 + hh * 8) * 2);
                S0 = MFMA32(k0, qf, S0);
                if (tt == 1) { const bf16x8 k1 = *(const LAS bf16x8*)(lds + ML_KS + (32 + r) * KS_PITCH + (ks * 16 + hh * 8) * 2); S1 = MFMA32(k1, qf, S1); }
            }
#pragma unroll
            for (int ks = 0; ks < 8; ++ks) { float f[8]; unpack8(*(const LAS v4u*)(lds + ML_QS + t * KS_PITCH + (ks * 16 + hh * 8) * 2), f);
                const f32x4 n0 = *(const LAS f32x4*)(lds + ML_NST + (ks * 16 + hh * 8) * 4), n1 = *(const LAS f32x4*)(lds + ML_NST + (ks * 16 + hh * 8) * 4 + 16);
#pragma unroll
                for (int e = 0; e < 8; ++e) f[e] *= it;
                dq += ((f[0] * n0[0] + f[1] * n0[1]) + (f[2] * n0[2] + f[3] * n0[3])) + ((f[4] * n1[0] + f[5] * n1[1]) + (f[6] * n1[2] + f[7] * n1[3]));
                const bf16x8 qs = __builtin_bit_cast(bf16x8, pack8f(f));
                const bf16x8 c0 = *(const LAS bf16x8*)(C0 + (32 * dvb + r) * C0_PITCH + (ks * 16 + hh * 8) * 2); Nn = MFMA32(c0, qs, Nn);
                if (ks & 1) __builtin_amdgcn_sched_barrier(0); }
        }
#pragma unroll
        for (int i = 0; i < 16; ++i) { const int s = crow(i, hh);
            S0[i] = (s <= t) ? S0[i] * __expf(GS[s] - Mt) : 0.f;
            S1[i] = (s + 32 <= t) ? S1[i] * __expf(GS[s + 32] - Mt) : 0.f;
            dq += S0[i] + S1[i]; }
        {
            bf16x8 sf[4]; sf[0] = pack_frag(S0, 0); sf[1] = pack_frag(S0, 1); sf[2] = pack_frag(S1, 0); sf[3] = pack_frag(S1, 1);
            const int nks = tt == 1 ? 4 : 2;
#pragma unroll
            for (int s = 0; s < 4; ++s) if (s < nks) {
                Nn = MFMA32(tr_frag(VT, 16 * s + 4 * hh, 16 * s + 8 + 4 * hh, 32 * dvb, lane), sf[s], Nn);
            }
        }
        const float den = sum_halves32(dq);
        const float inv = 1.0f / fmaxf(fabsf(den), et);
        float y[16]; float ss = 0.f;
#pragma unroll
        for (int g = 0; g < 4; ++g) { const int dv = 32 * dvb + 8 * g + 4 * hh;
            y[4 * g] = Nn[4 * g] * inv * __uint_as_float(ow[g].x << 16); y[4 * g + 1] = Nn[4 * g + 1] * inv * __uint_as_float(ow[g].x & 0xffff0000u);
            y[4 * g + 2] = Nn[4 * g + 2] * inv * __uint_as_float(ow[g].y << 16); y[4 * g + 3] = Nn[4 * g + 3] * inv * __uint_as_float(ow[g].y & 0xffff0000u);
            ss += (y[4 * g] * y[4 * g] + y[4 * g + 1] * y[4 * g + 1]) + (y[4 * g + 2] * y[4 * g + 2] + y[4 * g + 3] * y[4 * g + 3]); }
        ss = sum_halves32(ss);
        if (hh == 0) PS[dvb * 64 + t] = ss;
        { const LAS float* SC = (const LAS float*)(lds + TAB_SC) + 4 * c; state_update(lds, ML_KT, R, nst, SC[2], SC[3], wave, lane); }
        asm volatile("" :: "v"(touch));
        __syncthreads();
        const float tot = (PS[t] + PS[64 + t]) + (PS[128 + t] + PS[192 + t]);
        const float rstd = 1.0f / sqrtf(tot * (1.0f / 128.0f) + EPS);
        if (tvalid) {
#pragma unroll
            for (int g = 0; g < 4; ++g) { const int dv = 32 * dvb + 8 * g + 4 * hh; const f32x4 gv = *(const LAS f32x4*)(mlg + dv);
                v2u w; w.x = pk2(y[4 * g] * rstd * gv[0], y[4 * g + 1] * rstd * gv[1]); w.y = pk2(y[4 * g + 2] * rstd * gv[2], y[4 * g + 3] * rstd * gv[3]);
                *(v2u*)(MRG + pg8::tiled_elem((int)(rowc + t), GW + u.h * HD + dv, DM / 64)) = w; }
        }
        if (c + 1 < u.nch) {
#pragma unroll
            for (int tI = 0; tI < 2; ++tI)
#pragma unroll
                for (int i = 0; i < 16; ++i) *(LAS unsigned short*)(C0 + ((2 * dvh + tI) * 32 + crow(i, hh)) * C0_PITCH + (dkb * 32 + r) * 2) = f2bf(R[tI][i]);
            if (dvh == 0 && hh == 0) ((LAS float*)(lds + ML_NST))[dkb * 32 + r] = nst;
        }
    }
    if (u.samp || u.sg == NSEGB - 1) {
        int lanef = lane; asm volatile("" : "+v"(lanef));
        const int r = lanef & 31, hh = lanef >> 5;
        float* oc = a.out + (u.samp ? O_CS + (size_t)u.sid * 16384 : O_CP + (size_t)(u.b * NH + u.h) * 16384);
#pragma unroll
        for (int tI = 0; tI < 2; ++tI)
#pragma unroll
            for (int g = 0; g < 4; ++g) *(f32x4*)(oc + (size_t)(dkb * 32 + r) * HD + (2 * dvh + tI) * 32 + 8 * g + 4 * hh) = (f32x4){R[tI][4 * g], R[tI][4 * g + 1], R[tI][4 * g + 2], R[tI][4 * g + 3]};
        if (dvh == 0 && hh == 0) a.out[(u.samp ? O_NS + (size_t)u.sid * 128 : O_NP + (size_t)(u.b * NH + u.h) * 128) + dkb * 32 + r] = nst;
        if (tid == 0) a.out[u.samp ? O_MS + u.sid : O_MP + u.b * NH + u.h] = ((const LAS float*)(lds + TAB_M))[u.nch];
    }
}

__device__ __forceinline__ void final_norm_rows(const Args& a, int row_lo, int row_hi, int gw, int NGW, int lane) {
    const float* gf = a.in[I_GF];
    const bf16* XB = (const bf16*)(a.ws + WS_XB); const float* SS3 = (const float*)(a.ws + WS_SS + 15 * MiB);
    for (int m = row_hi - 1 - gw; m >= row_lo; m -= NGW) {
        float s = lane < 32 ? SS3[(size_t)m * 32 + lane] : 0.f;
        const float rstd = 1.0f / sqrtf(wave_sum(s) * (1.0f / DM) + EPS);

        float* yr = a.out + O_Y + (size_t)m * DM + 8 * lane;
#pragma unroll
        for (int j = 0; j < 4; ++j) { const v4u w = __builtin_nontemporal_load((const v4u*)(XB + pg8::tiled_elem(m, 8 * lane + 512 * j, DM / 64))); const f32x4 g0 = *(const f32x4*)(gf + 8 * lane + 512 * j), g1 = *(const f32x4*)(gf + 8 * lane + 512 * j + 4);
            f32x4 o0, o1; o0[0] = __uint_as_float(w.x << 16); o0[1] = __uint_as_float(w.x & 0xffff0000u); o0[2] = __uint_as_float(w.y << 16); o0[3] = __uint_as_float(w.y & 0xffff0000u);
            o1[0] = __uint_as_float(w.z << 16); o1[1] = __uint_as_float(w.z & 0xffff0000u); o1[2] = __uint_as_float(w.w << 16); o1[3] = __uint_as_float(w.w & 0xffff0000u);
            *(f32x4*)(yr + 512 * j) = o0 * rstd * g0; *(f32x4*)(yr + 512 * j + 4) = o1 * rstd * g1; }
    }
}


#ifndef ORD_SHARED
#define ORD_SHARED true
#endif
#define ORD_C (ORD_SHARED ? ((G % 8 == 0) ? (bx % 8) * (G / 8) + bx / 8 : bx) : bx)
#ifndef ORD_REV
#define ORD_REV true
#endif
#ifndef SPLIT_P6
#define SPLIT_P6 true
#endif
#ifndef SPLIT_P2
#define SPLIT_P2 true
#endif
#ifndef WGM_UP
#define WGM_UP 4
#endif
#ifndef WGM_DN
#define WGM_DN 4
#endif
#ifndef WGM_IN
#define WGM_IN 4
#endif
template <bool DIRECT> __device__ __forceinline__ void ph_ffn_up(LAS unsigned char* lds, const bf16* A, const bf16* W13, bf16* H, const float* SS, int G, int bx, bool rev = ORD_REV) {
    pg8::Gemm g{A, W13, MROWS, FF2, DM}; pg8::StaticOrder S; S.init(MROWS, FF2, G, ORD_C, WGM_UP); S.shared_a = ORD_SHARED; S.rev = rev;
    pg8::EpiSwiGLU<DIRECT> E{H, FF, SS};
    pg8::gemm_phase<pg8::EpiSwiGLU<DIRECT>, pg8::StaticOrder, true, true>(lds + RING_OFF, g, S, E);
}
__device__ __forceinline__ void ph_resid(LAS unsigned char* lds, const bf16* A, const bf16* Wt, int K, bf16* X, float* SSout, float scale, int G, int bx) {
    pg8::Gemm g{A, Wt, MROWS, DM, K}; pg8::StaticOrder S; S.init(MROWS, DM, G, ORD_C, WGM_DN); S.shared_a = ORD_SHARED;
    pg8::EpiResid E{X, X, SSout, scale, DM};
    pg8::gemm_phase<pg8::EpiResid, pg8::StaticOrder, true, true>(lds + RING_OFF, g, S, E);
}
__device__ __forceinline__ void ph_resid_prompt(LAS unsigned char* lds, const bf16* A, const bf16* Wt, int K, bf16* X, float* SSout, float scale, int G, int bx) {
    pg8::Gemm g{A, Wt, MP, DM, K}; pg8::StaticOrder S; S.init(MP, DM, G, ORD_C, WGM_DN); S.shared_a = ORD_SHARED;
    pg8::EpiResid E{X, X, SSout, scale, DM};
    pg8::gemm_phase<pg8::EpiResid, pg8::StaticOrder, true, true>(lds + RING_OFF, g, S, E);
}
template <int NS> __device__ __forceinline__ void ph_tail_splitk(LAS unsigned char* lds, const bf16* A, const bf16* Wt, int K, float* PART, int q) {
    const int unit = q / NS, sp = q % NS, nkt = K / 64, per = (((nkt + NS - 1) / NS) + 1) & ~1, kt0 = sp * per;
    pg8::Gemm g{A, Wt, MROWS, DM, K, kt0, (nkt - kt0) < per ? (nkt - kt0) : per}; pg8::SingleOrder S{MP / 256 + (unit >> 3), unit & 7};
    pg8::EpiPartial E{PART + (size_t)sp * MS * DM, MP};
    pg8::gemm_phase<pg8::EpiPartial, pg8::SingleOrder, true, true>(lds + RING_OFF, g, S, E);
}
__device__ __forceinline__ void ph_inproj(const Args& args, LAS unsigned char* lds, const bf16* A, const float* SS, int G, int bx) {
    unsigned char* ws = args.ws;
    pg8::Gemm g{A, (const bf16*)(ws + WS_WIN), MROWS, NINP, DM}; pg8::StaticOrder S; S.init(MROWS, NINP, G, ORD_C, WGM_IN); S.shared_a = ORD_SHARED; S.rev = ORD_REV;
    pg8::EpiInProj E{SS, (bf16*)(ws + WS_QA), (bf16*)(ws + WS_KA), (bf16*)(ws + WS_VA), (bf16*)(ws + WS_QKB), (bf16*)(ws + WS_VB), (bf16*)(ws + WS_OB),
                     args.out + O_KP, args.out + O_VP, args.out + O_KS, args.out + O_VS, (float*)(ws + WS_G), args.in[I_BIG], args.in[I_BFG], MP, QSCALE};
    pg8::gemm_phase<pg8::EpiInProj, pg8::StaticOrder, true, true>(lds + RING_OFF, g, S, E);
}

__device__ __forceinline__ void ph_probe(LAS unsigned char* lds, const bf16* A, const bf16* Wt, int N, int K, float* sink, int flag, int G, int bx) {
    pg8::Gemm g{A, Wt, MROWS, N, K}; pg8::StaticOrder S; S.init(MROWS, N, G, bx);
    pg8::EpiProbe E{sink, flag};
    pg8::gemm_phase<pg8::EpiProbe, pg8::StaticOrder, true, true>(lds + RING_OFF, g, S, E);
}

constexpr int NPHASE = 10;
#ifndef PROBE_REP
#define PROBE_REP 0
#endif
#define NREP(k) (1 + ((PROBE_REP >> (k)) & 1))
#define BARX() do { if (MK_N_LAUNCHES == 1) xcd_barrier(bar); } while (0)
__global__ void __launch_bounds__(512, 2) hymba_fwd(Args args) {
    extern __shared__ __attribute__((aligned(16))) unsigned char lds_raw[];
    LAS unsigned char* lds = (LAS unsigned char*)lds_raw;
    volatile LAS unsigned* MISC = (volatile LAS unsigned*)(lds + MISC_OFF);
    const int tid = threadIdx.x, lane = tid & 63, wave = __builtin_amdgcn_readfirstlane(tid >> 6);
    const int G = gridDim.x; const int bx = blockIdx.x; const int vcu = (G % 8 == 0) ? (bx % 8) * (G / 8) + bx / 8 : bx;
    unsigned char* ws = args.ws;
    gu32* ctl = (gu32*)(ws + WS_CTL);
    for (int u = tid; u < (LDS_BYTES - LDSCTL_OFF) / 4; u += 512) ((LAS unsigned*)(lds + LDSCTL_OFF))[u] = 0u;
    __syncthreads();
    XcdBarrier bar; bar.bar = (unsigned*)(ctl + CW_BAR); bar.x = 0; bar.st = nullptr;
    if (MK_N_LAUNCHES == 1) bar = xcd_barrier_post((unsigned*)(ctl + CW_BAR), MISC + 8);
    const int lo = args.ph_lo, hi = args.ph_hi;
#define IN(k) (lo <= (k) && (k) < hi)
#define SEAM(k) do { if (MK_N_LAUNCHES == 1 && IN(k) && IN((k) + 1)) xcd_barrier(bar); } while (0)
    bf16* XB = (bf16*)(ws + WS_XB); bf16* HB = (bf16*)(ws + WS_HU); bf16* MRG = (bf16*)(args.out + O_Y);
    float* SS0 = (float*)(ws + WS_SS); float* SS1 = (float*)(ws + WS_SS + 5 * MiB); float* SS2 = (float*)(ws + WS_SS + 10 * MiB); float* SS3 = (float*)(ws + WS_SS + 15 * MiB);
    float* RS1 = SS1 + (size_t)MROWS * 32; float* RS2 = SS2 + (size_t)MROWS * 32;
    const bool SPLITK = (MK_N_LAUNCHES == 1 && G == 256);
    constexpr int NSPL2 = 4, NSPL6 = 4;
    const int tq_x = vcu >> 5, tq_j = vcu & 31;
#define TAIL_CU(NS) (tq_j < 2 * (NS))
#define TAIL_Q(NS) (tq_x * 2 * (NS) + tq_j)
#define SIDE_I(NS) (tq_x * (32 - 2 * (NS)) + tq_j - 2 * (NS))
#define NSIDE(NS) (256 - 16 * (NS))
    float* PART = (float*)(ws + WS_RSEG);

    if (IN(0)) { p0_prologue(args, lds, vcu, G, wave, lane); if (NREP(0) == 2) p0_prologue(args, lds, vcu, G, wave, lane); } SEAM(0);
    constexpr int CV1_UP = 1536, CV3_UP = 5504;
    if (IN(1)) { ph_ffn_up<true>(lds, XB, (const bf16*)(ws + WS_W13A), HB, SS0, G, bx);
                 if (SPLITK) { const int nun = (MROWS / 256) * (FF2 / 256), nlast = nun - (nun / G) * G;
                     if (nlast > 0 && vcu >= nlast) { convert_weights(args, lds, 1, (vcu - nlast) * 8 + wave, (G - nlast) * 8, wave, lane, 18432, 20480); convert_weights(args, lds, 1, (vcu - nlast) * 8 + wave, (G - nlast) * 8, wave, lane, 0, CV1_UP); } } if (NREP(12) == 2) ph_ffn_up<true>(lds, XB, (const bf16*)(ws + WS_W13A), HB, SS0, G, bx); if (NREP(1) == 2) ph_probe(lds, XB, (const bf16*)(ws + WS_W13A), FF2, DM, (float*)(ws + WS_RSEG), args.ph_lo < 0, G, bx); } SEAM(1);
    if (IN(2) && SPLITK && SPLIT_P2) { ph_resid_prompt(lds, HB, (const bf16*)(ws + WS_W2A), FF, XB, SS1, 0.5f, G, bx);
                 if (TAIL_CU(NSPL2)) ph_tail_splitk<NSPL2>(lds, HB, (const bf16*)(ws + WS_W2A), FF, PART, TAIL_Q(NSPL2));
                 else convert_weights(args, lds, 1, SIDE_I(NSPL2) * 8 + wave, NSIDE(NSPL2) * 8, wave, lane, CV1_UP + CV3_UP, 18432); }
    else if (IN(2)) { ph_resid(lds, HB, (const bf16*)(ws + WS_W2A), FF, XB, SS1, 0.5f, G, bx);
                 { const int nun = (MROWS / 256) * (DM / 256), nfull = nun / G, nlast = nun - nfull * G;
                   const int oc = ORD_C;
                   if (nlast > 0 && oc >= nlast) convert_weights(args, lds, 1, (oc - nlast) * 8 + wave, (G - nlast) * 8, wave, lane);
                   else if (nlast == 0) convert_weights(args, lds, 1, oc * 8 + wave, G * 8, wave, lane); }
                 if (NREP(2) == 2) { __syncthreads(); ph_probe(lds, HB, (const bf16*)(ws + WS_W2A), DM, FF, (float*)(ws + WS_RSEG), args.ph_lo < 0, G, bx); } } SEAM(2);
    if (IN(3)) { if (SPLITK && SPLIT_P2) { finalize_rstd(SS1, RS1, vcu * 8 + wave, G * 8, lane, MP); reduce_sample_rows<NSPL2>(args, PART, 0.5f, RS1, wave * G + vcu, G * 8, lane); } else finalize_rstd(SS1, RS1, vcu * 8 + wave, G * 8, lane);
                 if (MK_N_LAUNCHES == 1) xcd_barrier(bar); else if (lo == 3) {   finalize_rstd(SS1, RS1, wave, 8, lane); __syncthreads(); }
                 ph_inproj(args, lds, XB, RS1, G, bx);
                 if (SPLITK) { const int nun = (MROWS / 256) * (NINP / 256), nlast = nun - (nun / G) * G;
                     if (nlast > 0 && vcu >= nlast) convert_weights(args, lds, 1, (vcu - nlast) * 8 + wave, (G - nlast) * 8, wave, lane, CV1_UP, CV1_UP + CV3_UP); } if (NREP(13) == 2) ph_inproj(args, lds, XB, RS1, G, bx); if (NREP(3) == 2) ph_probe(lds, XB, (const bf16*)(ws + WS_WIN), NINP, DM, (float*)(ws + WS_RSEG), args.ph_lo < 0, G, bx); } SEAM(3);
    if (IN(4)) {
        for (int j = vcu; j < NBP * NH * (NSEGB - 1); j += G) mlstm_summary_unit(args, lds, (j / (NSEGB - 1)) * NSEGB + j % (NSEGB - 1), tid, wave, lane);
        attn_prompt_phase(args, lds, vcu, G, tid, wave, lane);
        for (int u = vcu; u < NBS * NH; u += G) attn_sample_unit(args, lds, u >> 3, u & 7, tid, wave, lane);
        if (NREP(4) == 2) { for (int j = vcu; j < NBP * NH * (NSEGB - 1); j += G) mlstm_summary_unit(args, lds, (j / (NSEGB - 1)) * NSEGB + j % (NSEGB - 1), tid, wave, lane); }
        if (NREP(10) == 2) attn_prompt_phase(args, lds, vcu, G, tid, wave, lane);
        if (NREP(11) == 2) { for (int u = vcu; u < NBS * NH; u += G) attn_sample_unit(args, lds, u >> 3, u & 7, tid, wave, lane); }
    } SEAM(4);
    if (IN(5)) {
        for (int rep = 0; rep < NREP(5); ++rep)
        for (int s = vcu; s < NSEGP + NBS * NH; s += G) mlstm_out_unit(args, lds, s < NSEGP ? munit_prompt(s) : munit_sample(s - NSEGP), tid, wave, lane);
    } SEAM(5);
    if (IN(6) && SPLITK && SPLIT_P6) { __syncthreads(); ph_resid_prompt(lds, MRG, (const bf16*)(ws + WS_WOUT), DM, XB, SS2, 1.0f, G, bx);
                 if (TAIL_CU(NSPL6)) ph_tail_splitk<NSPL6>(lds, MRG, (const bf16*)(ws + WS_WOUT), DM, PART, TAIL_Q(NSPL6));
                 else convert_weights(args, lds, 2, SIDE_I(NSPL6) * 8 + wave, NSIDE(NSPL6) * 8, wave, lane); }
    else if (IN(6)) { __syncthreads(); ph_resid(lds, MRG, (const bf16*)(ws + WS_WOUT), DM, XB, SS2, 1.0f, G, bx);
                 { const int nun = (MROWS / 256) * (DM / 256), nfull = nun / G, nlast = nun - nfull * G;
                   const int oc = ORD_C;
                   if (nlast > 0 && oc >= nlast) convert_weights(args, lds, 2, (oc - nlast) * 8 + wave, (G - nlast) * 8, wave, lane);
                   else if (nlast == 0) convert_weights(args, lds, 2, oc * 8 + wave, G * 8, wave, lane); }
                 if (NREP(6) == 2) ph_probe(lds, MRG, (const bf16*)(ws + WS_WOUT), DM, DM, (float*)(ws + WS_RSEG), args.ph_lo < 0, G, bx); } SEAM(6);
    if (IN(7)) { if (SPLITK && SPLIT_P6) { finalize_rstd(SS2, RS2, vcu * 8 + wave, G * 8, lane, MP); reduce_sample_rows<NSPL6>(args, PART, 1.0f, RS2, wave * G + vcu, G * 8, lane); } else finalize_rstd(SS2, RS2, vcu * 8 + wave, G * 8, lane);
                 if (MK_N_LAUNCHES == 1) xcd_barrier(bar); else if (lo == 7) { finalize_rstd(SS2, RS2, wave, 8, lane); __syncthreads(); }
                 ph_ffn_up<true>(lds, XB, (const bf16*)(ws + WS_W13B), HB, RS2, G, bx); if (NREP(7) == 2) ph_probe(lds, XB, (const bf16*)(ws + WS_W13B), FF2, DM, (float*)(ws + WS_RSEG), args.ph_lo < 0, G, bx); } SEAM(7);
    if (IN(8) && IN(9) && MK_N_LAUNCHES == 1 && G == 256) {
        { pg8::Gemm g{HB, (const bf16*)(ws + WS_W2B), MP, DM, FF}; pg8::StaticOrder S; S.init(MP, DM, G, ORD_C, WGM_DN); S.shared_a = ORD_SHARED;
          pg8::EpiResid E{XB, XB, SS3, 0.5f, DM};
          pg8::gemm_phase<pg8::EpiResid, pg8::StaticOrder, true, true>(lds + RING_OFF, g, S, E); }
        xcd_barrier(bar);
        { const int tq_x = vcu >> 5, tq_j = vcu & 31; float* PART = (float*)(ws + WS_RSEG);
          constexpr int NORM_SPLIT = 14336;
          if (tq_j < 4) { const int q = tq_x * 4 + tq_j, unit = q >> 1, sp = q & 1;
              pg8::Gemm g{HB, (const bf16*)(ws + WS_W2B), MROWS, DM, FF, sp * 44, sp ? 42 : 44}; pg8::SingleOrder S{MP / 256 + (unit >> 3), unit & 7};
              pg8::EpiPartial E{PART + (size_t)sp * MS * DM, MP};
              pg8::gemm_phase<pg8::EpiPartial, pg8::SingleOrder, true, true>(lds + RING_OFF, g, S, E); }
          else final_norm_rows(args, NORM_SPLIT, MP, (tq_x * 28 + tq_j - 4) * 8 + wave, 224 * 8, lane);
          final_norm_rows(args, 0, NORM_SPLIT, vcu * 8 + wave, G * 8, lane);
          xcd_barrier(bar);
          final_norm_sample_rows(args, PART, wave * G + vcu, G * 8, lane); }
    } else {
    if (IN(8)) { ph_resid(lds, HB, (const bf16*)(ws + WS_W2B), FF, XB, SS3, 0.5f, G, bx);
                 if (NREP(8) == 2) ph_probe(lds, HB, (const bf16*)(ws + WS_W2B), DM, FF, (float*)(ws + WS_RSEG), args.ph_lo < 0, G, bx); } SEAM(8);
    if (IN(9)) { final_norm_rows(args, 0, MROWS, vcu * 8 + wave, G * 8, lane); }
    }
#undef IN
#undef SEAM
}

extern "C" void kernel_launch(void* const* d_in, const int* in_sizes, int n_in, void* d_out, int out_size, void* d_ws, size_t ws_size, hipStream_t stream) {
    static int grid = 0;
    if (grid == 0) {
        if (n_in != 26 || (size_t)out_size != O_END || ws_size < WS_END) { fprintf(stderr, "kernel_launch: unexpected shapes: n_in %d out %d ws %zu (need %zu)\n", n_in, out_size, ws_size, (size_t)WS_END); grid = -1; return; }
        int dev = 0, cus = 0, per_cu = 0;
        if (hipGetDevice(&dev) != hipSuccess || hipDeviceGetAttribute(&cus, hipDeviceAttributeMultiprocessorCount, dev) != hipSuccess) { grid = -1; return; }
        if (hipFuncSetAttribute((const void*)hymba_fwd, hipFuncAttributeMaxDynamicSharedMemorySize, LDS_BYTES) != hipSuccess) { fprintf(stderr, "kernel_launch: hipFuncSetAttribute failed\n"); grid = -1; return; }
        if (hipOccupancyMaxActiveBlocksPerMultiprocessor(&per_cu, (const void*)hymba_fwd, 512, LDS_BYTES) != hipSuccess || per_cu < 1) { fprintf(stderr, "kernel_launch: occupancy query says %d\n", per_cu); (void)hipGetLastError(); grid = -1; return; }
        grid = cus;
    }
    if (grid < 0) return;
    if (hipMemsetAsync((char*)d_ws + WS_CTL, 0, CTL_ZERO_BYTES, stream) != hipSuccess) return;
    Args a{};
    for (int i = 0; i < 26; ++i) a.in[i] = (const float*)d_in[i];
    a.out = (float*)d_out; a.ws = (unsigned char*)d_ws;
    if (MK_N_LAUNCHES == 1) { a.ph_lo = 0; a.ph_hi = NPHASE; hipLaunchKernelGGL(hymba_fwd, dim3(grid), dim3(512), LDS_BYTES, stream, a); }
    else for (int p = 0; p < NPHASE; ++p) { a.ph_lo = p; a.ph_hi = p + 1; hipLaunchKernelGGL(hymba_fwd, dim3(grid), dim3(512), LDS_BYTES, stream, a); }
}
```

```cpp
#include <hip/hip_runtime.h>
#include <cstdio>
#include <cstdint>

#ifndef MK_N_LAUNCHES
#define MK_N_LAUNCHES 1
#endif

constexpr int DM = 2048, MP = 32768, MS = 512, MROWS = MP + MS, TP = 8192, TS = 16, NBP = 4, NBS = 32, PAST = 2048;
constexpr int FF = 5504, FF2 = 2 * FF, NIN = 7184, NINP = 7424, HD = 128, NH = 8, GW = 1024;
constexpr int NCHP = NBP * NH * (TP / 64), NCHS = NBS * NH, NCH = NCHP + NCHS;
constexpr int LDX = DM, LDW = DM;
constexpr float EPS = 1e-6f;
constexpr float QSCALE = 0.08838834764831845f * 1.4426950408889634f;
constexpr float KSCALE = 0.08838834764831845f;

constexpr size_t O_Y = 0, O_KP = 68157440, O_VP = 101711872, O_CP = 135266304, O_NP = 135790592, O_MP = 135794688, O_CVP = 135794720,
                 O_KS = 135819296, O_VS = 136343584, O_CS = 136867872, O_NS = 141062176, O_MS = 141094944, O_CVS = 141095200, O_END = 141291808;

namespace pg8 {
#define PG8_LAS __attribute__((address_space(3)))
typedef unsigned short bf16_t;
typedef short bf16x8 __attribute__((ext_vector_type(8)));
typedef float f32x4 __attribute__((ext_vector_type(4)));
typedef unsigned u32x4 __attribute__((ext_vector_type(4)));
constexpr int BM = 256, BK = 64, HALF = 128, HTB = HALF * BK * 2  , STAGE_BYTES = 8 * HTB, NXCD = 8, WGM = 4;

__host__ __device__ __forceinline__ int lds_byte(int r, int c) { const int st = (r >> 4) * 2 + (c >> 5), rr = r & 15, cc = c & 31, ob = rr * 64 + cc * 2; return st * 1024 + (ob ^ (((ob >> 9) & 1) << 5)); }
__host__ __device__ __forceinline__ void stage_rc(int b, int& R, int& C) { const int st = b / 1024, sb = b % 1024, swz = sb ^ (((sb >> 9) & 1) << 5); R = (st >> 1) * 16 + swz / 64; C = (st & 1) * 32 + (swz % 64) / 2; }
__host__ __device__ __forceinline__ int perm32(int rho) { const int n = rho >> 4, i = rho & 15; return 8 * (i >> 2) + 4 * n + (i & 3); }

struct Unit { int pm, pn; };
struct Gemm { const bf16_t* A; const bf16_t* Bt; int M, N, K; int kt0 = 0, ktn = 0;   };
__host__ __device__ __forceinline__ size_t tiled_elem(int row, int col, int nKT) {
    const size_t blk = ((size_t)(row >> 8) * nKT + (col >> 6)) * 2 + ((row >> 7) & 1);
    return blk * 8192 + (size_t)(lds_byte(row & 127, col & 63) >> 1);
}
__host__ __device__ __forceinline__ int perm32inv(int c) { return 16 * ((c >> 2) & 1) + 4 * (c >> 3) + (c & 3); }
__host__ __device__ __forceinline__ size_t tiled_elem_b(int n, int k, int nKT) { return tiled_elem((n & ~31) + perm32inv(n & 31), k, nKT); }

struct StaticOrder {
    bool rev = false;
    bool shared_a = false;
    int nM, nN, nwg, G, c, wgm;
    __host__ __device__ void init(int M, int N, int G_, int c_, int wgm_ = WGM) { nM = M / BM; nN = N / BM; nwg = nM * nN; G = G_; c = c_; wgm = wgm_; }
    __host__ __device__ bool next(int i, Unit& u) const {
        const long L = (long)i * G + c; if (L >= nwg) return false;
        int wgid = (int)L; if (!shared_a) { const int q = nwg / NXCD, r = nwg % NXCD, xcd = wgid % NXCD, off = wgid / NXCD; wgid = (xcd < r ? xcd * (q + 1) : r * (q + 1) + (xcd - r) * q) + off; }
        const int nig = wgm * nN, gid = wgid / nig, fm = gid * wgm, gsz = (nM - fm) < wgm ? (nM - fm) : wgm;
        u.pm = fm + ((wgid % nig) % gsz); u.pn = (wgid % nig) / gsz; if (rev) u.pm = nM - 1 - u.pm; return true;
    }
    __device__ __forceinline__ void a_ready(const Unit&) const {}
    __device__ __forceinline__ void done(const Unit&) const {}
};
struct SingleOrder {
    int pm, pn;
    __host__ __device__ bool next(int i, Unit& u) const { if (i != 0) return false; u.pm = pm; u.pn = pn; return true; }
    __device__ __forceinline__ void a_ready(const Unit&) const {}
    __device__ __forceinline__ void done(const Unit&) const {}
};


typedef float f32x2 __attribute__((ext_vector_type(2)));
typedef __bf16 bf16x2_t __attribute__((ext_vector_type(2)));
__device__ __forceinline__ unsigned cvt_pk_bf16(float lo, float hi) { f32x2 v = {lo, hi}; bf16x2_t b = __builtin_convertvector(v, bf16x2_t); return __builtin_bit_cast(unsigned, b); }
__device__ __forceinline__ u32x4 pack8(f32x4 a, f32x4 b) { u32x4 w; w.x = cvt_pk_bf16(a[0], a[1]); w.y = cvt_pk_bf16(a[2], a[3]); w.z = cvt_pk_bf16(b[0], b[1]); w.w = cvt_pk_bf16(b[2], b[3]); return w; }

__device__ __forceinline__ void row_rstd(const float* SS, const Unit& u, int wr, int fr, int fq, float (&r)[2][4]) {
#pragma unroll
    for (int ai = 0; ai < 2; ++ai)
#pragma unroll
        for (int m = 0; m < 4; ++m) {
            const int row = u.pm * BM + ai * HALF + wr * 64 + m * 16 + fr;
            const f32x4* p = (const f32x4*)(SS + (size_t)row * 32 + fq * 8);
            const f32x4 a = p[0], b = p[1];
            float s = ((a[0] + a[1]) + (a[2] + a[3])) + ((b[0] + b[1]) + (b[2] + b[3]));
            s += __shfl_xor(s, 16); s += __shfl_xor(s, 32);
            r[ai][m] = 1.0f / sqrtf(s * (1.0f / 2048.0f) + 1e-6f);
        }
}
__device__ __forceinline__ float logsig_f(float x) { return fminf(x, 0.f) - 0.6931471805599453f * __builtin_amdgcn_logf(1.0f + __builtin_amdgcn_exp2f(-1.4426950408889634f * fabsf(x))); }
__device__ __forceinline__ void row_rstd_direct(const float* RS, const Unit& u, int wr, int fr, float (&r)[2][4]) {
#pragma unroll
    for (int ai = 0; ai < 2; ++ai)
#pragma unroll
        for (int m = 0; m < 4; ++m) r[ai][m] = RS[u.pm * BM + ai * HALF + wr * 64 + m * 16 + fr];
}
__device__ __forceinline__ float sigmoid_f(float a) { return __builtin_amdgcn_rcpf(1.0f + __builtin_amdgcn_exp2f(-1.4426950408889634f * a)); }

template <bool DIRECT  > struct EpiSwiGLU {
    static constexpr bool PERM = true, AFTER_DRAIN = false;
    bf16_t* H; int ldh; const float* SS;
    __device__ __forceinline__ void operator()(const f32x4 (&acc)[2][2][4][2], const Unit& u, int wr, int wc, int fr, int fq) const {
        float r[2][4]; if (DIRECT) row_rstd_direct(SS, u, wr, fr, r); else row_rstd(SS, u, wr, fr, fq, r);
        const int col0 = u.pn * HALF + wc * 32 + 8 * fq;
#pragma unroll
        for (int ai = 0; ai < 2; ++ai)
#pragma unroll
            for (int m = 0; m < 4; ++m) {
                const float rs = r[ai][m], rsn = rs * -1.4426950408889634f;
                bf16_t* rowp = H + tiled_elem(u.pm * BM + ai * HALF + wr * 64 + m * 16 + fr, col0, ldh / BK);
                f32x4 o[2];
#pragma unroll
                for (int n = 0; n < 2; ++n)
#pragma unroll
                    for (int hv = 0; hv < 2; ++hv) {
                        const f32x2 av = (f32x2){acc[ai][0][m][n][2 * hv], acc[ai][0][m][n][2 * hv + 1]}, bv = (f32x2){acc[ai][1][m][n][2 * hv], acc[ai][1][m][n][2 * hv + 1]};
                        const f32x2 t = av * rsn; f32x2 e; e.x = __builtin_amdgcn_exp2f(t.x); e.y = __builtin_amdgcn_exp2f(t.y);
                        const f32x2 d = e + 1.0f; f32x2 q; q.x = __builtin_amdgcn_rcpf(d.x); q.y = __builtin_amdgcn_rcpf(d.y);
                        const f32x2 h = (av * (rs * rs)) * (bv * q);
                        o[n][2 * hv] = h.x; o[n][2 * hv + 1] = h.y; }
                *(u32x4*)rowp = pack8(o[0], o[1]);
            }
    }
};

__device__ __forceinline__ f32x4 bf_lo4(unsigned a, unsigned b) { return (f32x4){__uint_as_float(a << 16), __uint_as_float(a & 0xffff0000u), __uint_as_float(b << 16), __uint_as_float(b & 0xffff0000u)}; }
struct EpiResid {
    static constexpr bool PERM = true, AFTER_DRAIN = false;
    const bf16_t* base; bf16_t* out; float* SSout; float scale; int ldx;
    __device__ __forceinline__ void operator()(const f32x4 (&acc)[2][2][4][2], const Unit& u, int wr, int wc, int fr, int fq) const {
        const int colb = u.pn * BM + wc * 32 + 8 * fq;
        const size_t row0 = (size_t)(u.pm * BM + wr * 64 + fr);
        u32x4 bv[2][4][2];
#pragma unroll
        for (int ai = 0; ai < 2; ++ai)
#pragma unroll
            for (int m = 0; m < 4; ++m)
#pragma unroll
                for (int bj = 0; bj < 2; ++bj) bv[ai][m][bj] = *(const u32x4*)(base + tiled_elem((int)row0 + ai * HALF + m * 16, colb + bj * HALF, 2048 / BK));
#pragma unroll
        for (int ai = 0; ai < 2; ++ai)
#pragma unroll
            for (int m = 0; m < 4; ++m) {
                const size_t row = row0 + ai * HALF + m * 16;
                float ss = 0.f;
#pragma unroll
                for (int bj = 0; bj < 2; ++bj) {
                    const u32x4 b = bv[ai][m][bj];
                    const f32x4 v0 = bf_lo4(b.x, b.y) + acc[ai][bj][m][0] * scale, v1 = bf_lo4(b.z, b.w) + acc[ai][bj][m][1] * scale;
                    *(u32x4*)(out + tiled_elem((int)row, colb + bj * HALF, 2048 / BK)) = pack8(v0, v1);
                    ss += ((v0[0] * v0[0] + v0[1] * v0[1]) + (v0[2] * v0[2] + v0[3] * v0[3])) + ((v1[0] * v1[0] + v1[1] * v1[1]) + (v1[2] * v1[2] + v1[3] * v1[3]));
                }
                { const auto r16 = __builtin_amdgcn_permlane16_swap(__float_as_uint(ss), __float_as_uint(ss), false, false); ss = __uint_as_float(r16[0]) + __uint_as_float(r16[1]);
                  const auto r32 = __builtin_amdgcn_permlane32_swap(__float_as_uint(ss), __float_as_uint(ss), false, false); ss = __uint_as_float(r32[0]) + __uint_as_float(r32[1]); }
                if (fq == 0) SSout[row * 32 + u.pn * 4 + wc] = ss;
            }
    }
};

struct EpiInProj {
    static constexpr bool PERM = true, AFTER_DRAIN = false;
    const float* SS;        bf16_t *QA, *KA, *VA, *QKB, *VB, *OB; float *outKP, *outVP, *outKS, *outVS; float* G; const float *b_ig, *b_fg; int splitRow; float qscale;
    __device__ __forceinline__ void operator()(const f32x4 (&acc)[2][2][4][2], const Unit& u, int wr, int wc, int fr, int fq) const {
        float r[2][4]; row_rstd_direct(SS, u, wr, fr, r);
        const int pn = u.pn;
        if (pn == 28) {
            if (wc == 0 && fq < 2) {
                const float* bias = fq == 0 ? b_ig : b_fg;
                const f32x4 bv0 = *(const f32x4*)bias, bv1 = *(const f32x4*)(bias + 4);
#pragma unroll
                for (int ai = 0; ai < 2; ++ai)
#pragma unroll
                    for (int m = 0; m < 4; ++m) {
                        const int row = u.pm * BM + ai * HALF + wr * 64 + m * 16 + fr;
                        f32x4 v0 = acc[ai][0][m][0] * r[ai][m] + bv0, v1 = acc[ai][0][m][1] * r[ai][m] + bv1;
                        if (fq == 1) {
#pragma unroll
                            for (int j = 0; j < 4; ++j) { v0[j] = logsig_f(v0[j]); v1[j] = logsig_f(v1[j]); }
                        }
                        *(f32x4*)(G + (size_t)row * 16 + 8 * fq) = v0; *(f32x4*)(G + (size_t)row * 16 + 8 * fq + 4) = v1;
                    }
            }
            return;
        }
        bf16_t* dst; int ld = 1024, ct = pn & 3; float sc = 1.f; float *fP = nullptr, *fS = nullptr; bool sig = false;
        if (pn < 4) { dst = QA; sc = qscale; }
        else if (pn < 8) { dst = KA; fP = outKP; fS = outKS; }
        else if (pn < 12) { dst = VA; fP = outVP; fS = outVS; }
        else if (pn < 20) { dst = QKB; ld = 2048; ct = pn - 12; }
        else if (pn < 24) { dst = VB; }
        else { dst = OB; sig = true; }
        const int colb = ct * BM + wc * 32 + 8 * fq;
#pragma unroll
        for (int ai = 0; ai < 2; ++ai)
#pragma unroll
            for (int m = 0; m < 4; ++m) {
                const int row = u.pm * BM + ai * HALF + wr * 64 + m * 16 + fr;
                const float rs = r[ai][m] * sc;
                float* fp = nullptr;
                if (fP) fp = (row >= splitRow) ? fS + (size_t)(row - splitRow) * 1024 : fP + (size_t)row * 1024;
#pragma unroll
                for (int bj = 0; bj < 2; ++bj) {
                    const int col = colb + bj * HALF;
                    f32x4 v0 = acc[ai][bj][m][0] * rs, v1 = acc[ai][bj][m][1] * rs;
                    if (sig) {
#pragma unroll
                        for (int j = 0; j < 4; ++j) { v0[j] = sigmoid_f(v0[j]); v1[j] = sigmoid_f(v1[j]); }
                    }
                    if (fp) { *(f32x4*)(fp + col) = v0; *(f32x4*)(fp + col + 4) = v1; }
                    *(u32x4*)(dst + (size_t)row * ld + col) = pack8(v0, v1);
                }
            }
    }
};


struct EpiPartial {
    static constexpr bool PERM = true, AFTER_DRAIN = false;
    float* P; int row_base;
    __device__ __forceinline__ void operator()(const f32x4 (&acc)[2][2][4][2], const Unit& u, int wr, int wc, int fr, int fq) const {
        const int colb = u.pn * BM + wc * 32 + 8 * fq;
        const int row0 = u.pm * BM - row_base + wr * 64 + fr;
#pragma unroll
        for (int ai = 0; ai < 2; ++ai)
#pragma unroll
            for (int m = 0; m < 4; ++m)
#pragma unroll
                for (int bj = 0; bj < 2; ++bj) {
                    float* p = P + (size_t)(row0 + ai * HALF + m * 16) * 2048 + colb + bj * HALF;
                    *(f32x4*)p = acc[ai][bj][m][0]; *(f32x4*)(p + 4) = acc[ai][bj][m][1];
                }
    }
};

struct EpiProbe {
    static constexpr bool PERM = true, AFTER_DRAIN = false;
    float* sink; int flag;
    __device__ __forceinline__ void operator()(const f32x4 (&acc)[2][2][4][2], const Unit& u, int wr, int wc, int fr, int fq) const {
        if (flag) {
            f32x4 s = (f32x4){0.f, 0.f, 0.f, 0.f};
#pragma unroll
            for (int ai = 0; ai < 2; ++ai)
#pragma unroll
                for (int bj = 0; bj < 2; ++bj)
#pragma unroll
                    for (int m = 0; m < 4; ++m)
#pragma unroll
                        for (int n = 0; n < 2; ++n) s += acc[ai][bj][m][n];
            *(f32x4*)(sink + (size_t)(u.pm * 8 + u.pn) * 2048 + threadIdx.x * 4) = s;
        }
    }
};
template <class Epi, class Sched, bool ALIGN_EPI = false, bool SP2 = false>
__device__ __forceinline__ void gemm_phase(PG8_LAS unsigned char* lds, const Gemm g, const Sched& S, const Epi& E) {
    const int tid = threadIdx.x, wid = __builtin_amdgcn_readfirstlane(tid >> 6), lane = tid & 63, wr = wid >> 2, wc = wid & 3, fr = lane & 15, fq = lane >> 4;
    const int K = g.K, nt = g.ktn > 0 ? g.ktn : K / BK;
    unsigned voffA[2], voffB[2];
#pragma unroll
    for (int i = 0; i < 2; ++i) { voffA[i] = (unsigned)(wid * 2048 + lane * 16); voffB[i] = voffA[i]; }
    static_assert(Epi::PERM, "the tiled weight copies carry the PERM row order");
    const size_t kstep = 32768;
    const size_t hstepA = 16384, hstepB = 16384;
    const size_t tstepA = (size_t)(K / BK) * 32768, tstepB = tstepA;
    const unsigned ldsw = (unsigned)wid * 2048u;
    const int aoff = lds_byte(wr * 64 + fr, fq * 8), boff = lds_byte(wc * 32 + fr, fq * 8);
#ifndef PG8_DMA_AUX
#define PG8_DMA_AUX 16
#endif
#define PG8_SA(b, h) (((b) * 2 + (h)) * HTB)
#define PG8_SB(b, h) ((4 + (b) * 2 + (h)) * HTB)
#define PG8_STAGE(bufoff, gbase, voff) do { const unsigned* _g = (const unsigned*)((const char*)(gbase) + (voff)[0]); PG8_LAS unsigned* _l = (PG8_LAS unsigned*)(lds + (bufoff) + ldsw); \
        __builtin_amdgcn_global_load_lds(_g, _l, 16, 0, PG8_DMA_AUX); __builtin_amdgcn_global_load_lds(_g, _l, 16, 1024, PG8_DMA_AUX); } while (0)
#define PG8_LDA(dst, b, h) do { _Pragma("unroll") for (int m = 0; m < 4; ++m) _Pragma("unroll") for (int k = 0; k < 2; ++k) dst[m][k] = *(const PG8_LAS bf16x8*)(lds + PG8_SA(b, h) + aoff + m * 2048 + k * 1024); } while (0)
#define PG8_LDB(dst, b, h) do { _Pragma("unroll") for (int n = 0; n < 2; ++n) _Pragma("unroll") for (int k = 0; k < 2; ++k) dst[n][k] = *(const PG8_LAS bf16x8*)(lds + PG8_SB(b, h) + boff + n * 2048 + k * 1024); } while (0)
#define PG8_MMA(ai, bj, At, Bt) do { __builtin_amdgcn_s_setprio(1); _Pragma("unroll") for (int m = 0; m < 4; ++m) _Pragma("unroll") for (int n = 0; n < 2; ++n) _Pragma("unroll") for (int k = 0; k < 2; ++k) \
        acc[ai][bj][m][n] = __builtin_amdgcn_mfma_f32_16x16x32_bf16(Bt[n][k], At[m][k], acc[ai][bj][m][n], 0, 0, 0); __builtin_amdgcn_s_setprio(0); } while (0)
#define PG8_WAIT_V(n) asm volatile("s_waitcnt vmcnt(" #n ")" ::: "memory")
#define PG8_WAIT_L(n) asm volatile("s_waitcnt lgkmcnt(" #n ")" ::: "memory")
#define PG8_BAR __builtin_amdgcn_s_barrier()
#define PG8_SCHED __builtin_amdgcn_sched_barrier(0)
    Unit cur, nxt; int ui = 0;
    if (!S.next(0, cur)) return;
    f32x4 acc[2][2][4][2];
#pragma unroll
    for (int a = 0; a < 2; ++a)
#pragma unroll
        for (int b = 0; b < 2; ++b)
#pragma unroll
            for (int m = 0; m < 4; ++m)
#pragma unroll
                for (int n = 0; n < 2; ++n) acc[a][b][m][n] = (f32x4){0.f, 0.f, 0.f, 0.f};
    bf16x8 At[4][2], B0[2][2], B1[2][2];
    const size_t koff = (size_t)g.kt0 * kstep;
    const char* cA = (const char*)g.A + (size_t)cur.pm * tstepA + koff; const char* cB = (const char*)g.Bt + (size_t)cur.pn * tstepB + koff;
    S.a_ready(cur);
    if constexpr (SP2) {
        PG8_STAGE(PG8_SB(0, 0), cB, voffB); PG8_STAGE(PG8_SB(0, 1), cB + hstepB, voffB); PG8_STAGE(PG8_SA(0, 0), cA, voffA); PG8_STAGE(PG8_SA(0, 1), cA + hstepA, voffA);
        if (wr == 1) PG8_BAR;
        PG8_WAIT_V(2); PG8_BAR;
        PG8_STAGE(PG8_SB(1, 0), cB + kstep, voffB); PG8_STAGE(PG8_SA(1, 0), cA + kstep, voffA); PG8_STAGE(PG8_SB(1, 1), cB + hstepB + kstep, voffB);
        PG8_WAIT_V(6); PG8_BAR;
    } else {
        PG8_STAGE(PG8_SB(0, 0), cB, voffB); PG8_STAGE(PG8_SA(0, 0), cA, voffA); PG8_STAGE(PG8_SB(0, 1), cB + hstepB, voffB); PG8_STAGE(PG8_SA(0, 1), cA + hstepA, voffA);
        if (wr == 1) PG8_BAR;
        PG8_WAIT_V(4); PG8_BAR;
        PG8_STAGE(PG8_SB(1, 0), cB + kstep, voffB); PG8_STAGE(PG8_SA(1, 0), cA + kstep, voffA); PG8_STAGE(PG8_SB(1, 1), cB + hstepB + kstep, voffB);
        PG8_WAIT_V(6); PG8_BAR;
    }
    for (;;) {
        const bool has_next = S.next(ui + 1, nxt);
        const char* nA = has_next ? (const char*)g.A + (size_t)nxt.pm * tstepA + koff : cA; const char* nB = has_next ? (const char*)g.Bt + (size_t)nxt.pn * tstepB + koff : cB;
        for (int t = 0; t < nt; t += 2) {
            const bool last = (t == nt - 2);
            const char* a1 = cA + (size_t)(t + 1) * kstep;
            const char* a2 = last ? nA : cA + (size_t)(t + 2) * kstep; const char* b2 = last ? nB : cB + (size_t)(t + 2) * kstep;
            const char* a3 = a2 + kstep; const char* b3 = b2 + kstep;
            if (last && has_next) S.a_ready(nxt);
            if constexpr (SP2) {
            PG8_LDB(B0, 0, 0); PG8_LDB(B1, 0, 1); PG8_SCHED; PG8_LDA(At, 0, 0); PG8_STAGE(PG8_SA(1, 1), a1 + hstepA, voffA);
            PG8_WAIT_V(8); PG8_WAIT_L(0); PG8_BAR; PG8_MMA(0, 0, At, B0); PG8_MMA(0, 1, At, B1); PG8_BAR; PG8_SCHED;
            PG8_LDA(At, 0, 1); PG8_STAGE(PG8_SB(0, 0), b2, voffB); PG8_STAGE(PG8_SB(0, 1), b2 + hstepB, voffB); PG8_STAGE(PG8_SA(0, 0), a2, voffA);
            PG8_WAIT_V(8); PG8_WAIT_L(0); PG8_BAR; PG8_MMA(1, 0, At, B0); PG8_MMA(1, 1, At, B1); PG8_BAR; PG8_SCHED;
            PG8_LDB(B0, 1, 0); PG8_LDB(B1, 1, 1); PG8_SCHED; PG8_LDA(At, 1, 0); PG8_STAGE(PG8_SA(0, 1), a2 + hstepA, voffA);
            PG8_WAIT_V(8); PG8_WAIT_L(0); PG8_BAR; PG8_MMA(0, 0, At, B0); PG8_MMA(0, 1, At, B1); PG8_BAR; PG8_SCHED;
            PG8_LDA(At, 1, 1); PG8_STAGE(PG8_SB(1, 0), b3, voffB); PG8_STAGE(PG8_SB(1, 1), b3 + hstepB, voffB); PG8_STAGE(PG8_SA(1, 0), a3, voffA);
            PG8_WAIT_V(8); PG8_WAIT_L(0); PG8_BAR; PG8_MMA(1, 0, At, B0); PG8_MMA(1, 1, At, B1); PG8_BAR; PG8_SCHED;
            } else {
            PG8_LDB(B0, 0, 0); PG8_SCHED; PG8_LDA(At, 0, 0); PG8_STAGE(PG8_SA(1, 1), a1 + hstepA, voffA);
            PG8_WAIT_L(8); PG8_BAR; PG8_WAIT_L(0); PG8_MMA(0, 0, At, B0); PG8_BAR; PG8_SCHED;
            PG8_LDB(B1, 0, 1); PG8_STAGE(PG8_SB(0, 0), b2, voffB);
            PG8_BAR; PG8_WAIT_L(0); PG8_MMA(0, 1, At, B1); PG8_BAR;
            PG8_LDA(At, 0, 1); PG8_STAGE(PG8_SA(0, 0), a2, voffA);
            PG8_BAR; PG8_WAIT_L(0); PG8_MMA(1, 0, At, B0); PG8_BAR; PG8_SCHED;
            PG8_STAGE(PG8_SB(0, 1), b2 + hstepB, voffB);
            PG8_WAIT_V(6); PG8_BAR; PG8_MMA(1, 1, At, B1); PG8_BAR;
            PG8_LDB(B0, 1, 0); PG8_SCHED; PG8_LDA(At, 1, 0); PG8_STAGE(PG8_SA(0, 1), a2 + hstepA, voffA);
            PG8_WAIT_L(8); PG8_BAR; PG8_WAIT_L(0); PG8_MMA(0, 0, At, B0); PG8_BAR; PG8_SCHED;
            PG8_LDB(B1, 1, 1); PG8_STAGE(PG8_SB(1, 0), b3, voffB);
            PG8_BAR; PG8_WAIT_L(0); PG8_MMA(0, 1, At, B1); PG8_BAR;
            PG8_LDA(At, 1, 1); PG8_STAGE(PG8_SA(1, 0), a3, voffA);
            PG8_BAR; PG8_WAIT_L(0); PG8_MMA(1, 0, At, B0); PG8_BAR; PG8_SCHED;
            PG8_STAGE(PG8_SB(1, 1), b3 + hstepB, voffB);
            PG8_WAIT_V(6); PG8_BAR; PG8_MMA(1, 1, At, B1); PG8_BAR;
            }
        }
        if constexpr (ALIGN_EPI) { if (wr == 0) PG8_BAR; }
        if constexpr (!Epi::AFTER_DRAIN) { E(acc, cur, wr, wc, fr, fq); S.done(cur); }
        if (!has_next) break;
#pragma unroll
        for (int a = 0; a < 2; ++a)
#pragma unroll
            for (int b = 0; b < 2; ++b)
#pragma unroll
                for (int m = 0; m < 4; ++m)
#pragma unroll
                    for (int n = 0; n < 2; ++n) acc[a][b][m][n] = (f32x4){0.f, 0.f, 0.f, 0.f};
        cur = nxt; cA = nA; cB = nB; ++ui;
        if constexpr (ALIGN_EPI) { if (wr == 1) PG8_BAR; }
    }
    PG8_WAIT_V(0);
    if constexpr (!ALIGN_EPI) { if (wr == 0) PG8_BAR; }
    PG8_BAR;
    if constexpr (Epi::AFTER_DRAIN) { E.fused(acc, cur, wr, wc, fr, fq, lds, wid, lane); S.done(cur); }
#undef PG8_SA
#undef PG8_SB
#undef PG8_STAGE
#undef PG8_LDA
#undef PG8_LDB
#undef PG8_MMA
#undef PG8_WAIT_V
#undef PG8_WAIT_L
#undef PG8_BAR
#undef PG8_SCHED
}
}

constexpr size_t MiB = 1u << 20;
constexpr size_t WS_CTL = 0, CTL_ZERO_BYTES = 1 * MiB;
constexpr size_t WS_W13A = 1 * MiB;
constexpr size_t WS_W2A = WS_W13A + 46 * MiB;
constexpr size_t WS_WIN = WS_W2A + 22 * MiB;
constexpr size_t WS_WOUT = WS_WIN + 31 * MiB;
constexpr size_t WS_W13B = WS_WOUT + 9 * MiB;
constexpr size_t WS_W2B = WS_W13B + 46 * MiB;
constexpr size_t WS_XB = WS_W2B + 22 * MiB;
constexpr size_t WS_SS = WS_XB + 139 * MiB;
constexpr size_t WS_G = WS_SS + 20 * MiB;
constexpr size_t WS_SSEG = WS_G + 3 * MiB;
constexpr size_t WS_NSEG = WS_SSEG + 1 * MiB;
constexpr size_t WS_RSEG = WS_NSEG + 1 * MiB;
constexpr size_t WS_HU = WS_RSEG + 16 * MiB;
constexpr size_t WS_QA = WS_HU, WS_KA = WS_QA + 65 * MiB, WS_VA = WS_KA + 65 * MiB, WS_QKB = WS_VA + 65 * MiB, WS_VB = WS_QKB + 130 * MiB, WS_OB = WS_VB + 65 * MiB;
constexpr size_t WS_END = WS_OB + 65 * MiB;
static_assert((size_t)MROWS * FF * 2 <= 350 * MiB && (size_t)MROWS * LDX * 2 <= 139 * MiB && (size_t)FF2 * LDW * 2 <= 46 * MiB && (size_t)NINP * LDW * 2 <= 31 * MiB && (size_t)DM * LDW * 2 <= 9 * MiB, "d_ws map");
constexpr int CW_BAR = 4096;

constexpr int RING_OFF = 0, RING_BYTES = 131072;
constexpr int LDS_BYTES = 155648;
constexpr int LDSCTL_OFF = LDS_BYTES - 512, MISC_OFF = LDSCTL_OFF + 320;

#define GAS __attribute__((address_space(1)))
#define LAS __attribute__((address_space(3)))
typedef unsigned short bf16;
typedef unsigned v4u __attribute__((ext_vector_type(4)));
typedef unsigned v2u __attribute__((ext_vector_type(2)));
typedef float f32x4 __attribute__((ext_vector_type(4)));
typedef float f32x16 __attribute__((ext_vector_type(16)));
typedef short bf16x8 __attribute__((ext_vector_type(8)));
typedef short s16x4 __attribute__((ext_vector_type(4)));
typedef GAS unsigned gu32;
#define RLX_AGENT __ATOMIC_RELAXED, __HIP_MEMORY_SCOPE_AGENT
#define LDS_WAIT() asm volatile("s_waitcnt lgkmcnt(0)" ::: "memory")
#define VM_WAIT() asm volatile("s_waitcnt vmcnt(0)" ::: "memory")
__device__ __forceinline__ float bf2f(unsigned short b) { return __uint_as_float((unsigned)b << 16); }
__device__ __forceinline__ unsigned pk2(float lo, float hi) { return pg8::cvt_pk_bf16(lo, hi); }
__device__ __forceinline__ unsigned short f2bf(float f) { return (unsigned short)(pg8::cvt_pk_bf16(f, 0.f) & 0xffffu); }
__device__ __forceinline__ int crow(int r, int hi) { return (r & 3) + 8 * (r >> 2) + 4 * hi; }
__device__ __forceinline__ float wave_sum(float v) {
#pragma unroll
    for (int o = 1; o < 64; o <<= 1) v += __shfl_xor(v, o);
    return v;
}
__device__ __forceinline__ float wave_max(float v) {
#pragma unroll
    for (int o = 1; o < 64; o <<= 1) v = fmaxf(v, __shfl_xor(v, o));
    return v;
}
#define MFMA32(a, b, c) __builtin_amdgcn_mfma_f32_32x32x16_bf16(a, b, c, 0, 0, 0)
__device__ __forceinline__ void halves32(float x, float& lo, float& hi) {
    const auto rr = __builtin_amdgcn_permlane32_swap(__float_as_uint(x), __float_as_uint(x), false, false);
    lo = __uint_as_float(rr[0]); hi = __uint_as_float(rr[1]);
}
__device__ __forceinline__ float sum_halves32(float x) { float lo, hi; halves32(x, lo, hi); return lo + hi; }

#define XB_TMO      128
#define XB_XCNT(j)  (256  + 64 * (j))
#define XB_XSUB(j)  (1280 + 64 * (j))
#define XB_XGEN(j)  (2304 + 64 * (j))
#define XB_TOP      3328
#define XB_TOPGEN   3392
#define XCD_BAR_WORDS 3456
#define XB_SPIN_CAP (1u << 18)

__device__ __forceinline__ unsigned xb_ld(unsigned* p)              { return __hip_atomic_load(p, __ATOMIC_RELAXED, __HIP_MEMORY_SCOPE_AGENT); }
__device__ __forceinline__ unsigned xb_add(unsigned* p, unsigned v) { return __hip_atomic_fetch_add(p, v, __ATOMIC_RELAXED, __HIP_MEMORY_SCOPE_AGENT); }
__device__ __forceinline__ unsigned xb_xcc_id() { return (unsigned)__builtin_amdgcn_s_getreg((3 << 11) | 20) & 0xFu; }
#define XB_SPIN(cond, bar) do { unsigned _sp = 0; while (cond) { __builtin_amdgcn_s_sleep(1); \
    if ((++_sp & 255u) == 0u) { if (xb_ld(&(bar)[XB_TMO])) break; if (_sp > XB_SPIN_CAP) { atomicAdd(&(bar)[XB_TMO], 1u); break; } } } } while (0)

struct XcdBarrier {
    unsigned* bar; unsigned x;
    volatile LAS unsigned* st;
};

__device__ __forceinline__ XcdBarrier xcd_barrier_post(unsigned* bar, volatile LAS unsigned* st) {
    XcdBarrier b; b.bar = bar; b.x = xb_xcc_id(); b.st = st;
    if (threadIdx.x == 0) (void)xb_add(&bar[XB_XCNT(b.x)], 1u);
    return b;
}
__device__ __forceinline__ void xcd_barrier_complete(unsigned* bar, unsigned x, unsigned& nloc, unsigned& nx) {
    const unsigned G = gridDim.x * gridDim.y * gridDim.z;
    unsigned sum, cnt, mine, sp = 0u;
    for (;;) {
        sum = 0u; cnt = 0u; mine = 0u;
#pragma unroll
        for (unsigned j = 0; j < 16; ++j) { const unsigned c = xb_ld(&bar[XB_XCNT(j)]); sum += c; cnt += (c > 0u) ? 1u : 0u; mine = (j == x) ? c : mine; }
        if (sum == G) break;
        __builtin_amdgcn_s_sleep(1);
        if ((++sp & 255u) == 0u) { if (xb_ld(&bar[XB_TMO])) break; if (sp > XB_SPIN_CAP) { atomicAdd(&bar[XB_TMO], 1u); break; } }
    }
    nloc = mine > 0u ? mine : 1u; nx = cnt > 0u ? cnt : 1u;
}

__device__ __forceinline__ void xcd_barrier(const XcdBarrier& b) {
    asm volatile("s_waitcnt vmcnt(0)" ::: "memory");
    __syncthreads();
    if (threadIdx.x == 0) {
        unsigned* bar = b.bar;
        __builtin_amdgcn_s_waitcnt(0);
        unsigned nloc = b.st[0], nx = b.st[1];
        if (nloc == 0u) { xcd_barrier_complete(bar, b.x, nloc, nx); b.st[0] = nloc; b.st[1] = nx; }
        const unsigned old = xb_add(&bar[XB_XSUB(b.x)], 1u);
        const unsigned gen = old / nloc;
        if (old + 1u == (gen + 1u) * nloc) {
            __builtin_amdgcn_fence(__ATOMIC_RELEASE, "agent");
            asm volatile("s_waitcnt vmcnt(0)" ::: "memory");
            const unsigned og = xb_add(&bar[XB_TOP], 1u);
            const unsigned tg = og / nx;
            if (og + 1u == (tg + 1u) * nx) xb_add(&bar[XB_TOPGEN], 1u);
            else XB_SPIN(xb_ld(&bar[XB_TOPGEN]) == tg, bar);
            __builtin_amdgcn_fence(__ATOMIC_ACQUIRE, "agent");
            xb_add(&bar[XB_XGEN(b.x)], 1u);
            asm volatile("s_waitcnt vmcnt(0)" ::: "memory");
        } else {
            XB_SPIN(xb_ld(&bar[XB_XGEN(b.x)]) == gen, bar);
            __builtin_amdgcn_fence(__ATOMIC_ACQUIRE, "agent");
            asm volatile("s_waitcnt vmcnt(0)" ::: "memory");
        }
    }
    __syncthreads();
}

struct Args {
    const float* in[26]; float* out; unsigned char* ws; int ph_lo, ph_hi;
};
enum { I_XP = 0, I_XS, I_CK, I_CV, I_SC, I_SN, I_SM, I_SCONV, I_G1, I_F1W1, I_F1W3, I_F1W2, I_GM, I_WIN, I_BIG, I_BFG, I_CONVW, I_CONVB, I_SBG, I_MLG, I_WOUT, I_G2, I_F2W1, I_F2W3, I_F2W2, I_GF };

struct CvtItem { const float* W; const float* gain; bf16* WT; int N, nKT, dst_row0, k0, n0; };
__device__ __forceinline__ void cvt_load(const CvtItem& d, int lane, f32x4 (&v)[8]) {
    const int r8 = lane >> 3, n = d.n0 + 4 * (lane & 7);
#pragma unroll
    for (int i = 0; i < 8; ++i) { const int kk = 8 * i + r8; f32x4 t = (f32x4){0.f, 0.f, 0.f, 0.f};
        if (n < d.N) t = __builtin_nontemporal_load((const f32x4*)(d.W + (size_t)(d.k0 + kk) * d.N + n));
        if (d.gain) t *= d.gain[d.k0 + kk];
        v[i] = t; }
}
__device__ __forceinline__ void cvt_store(const CvtItem& d, LAS float* scr, int lane, const f32x4 (&v)[8]) {
    const int r8 = lane >> 3, c4 = 4 * (lane & 7);
#pragma unroll
    for (int i = 0; i < 8; ++i) { LAS float* s = scr + (8 * i + r8) * 33 + c4; s[0] = v[i][0]; s[1] = v[i][1]; s[2] = v[i][2]; s[3] = v[i][3]; }
    LDS_WAIT(); asm volatile("" ::: "memory");
    const int c = lane & 7;
#pragma unroll
    for (int j = 0; j < 4; ++j) { const int nn = (lane >> 3) + 8 * j; const LAS float* s = scr + (8 * c) * 33 + nn;
        v4u o; o.x = pk2(s[0 * 33], s[1 * 33]); o.y = pk2(s[2 * 33], s[3 * 33]); o.z = pk2(s[4 * 33], s[5 * 33]); o.w = pk2(s[6 * 33], s[7 * 33]);
        *(GAS v4u*)(d.WT + pg8::tiled_elem_b(d.dst_row0 + nn, d.k0 + 8 * c, d.nKT)) = o; }
    LDS_WAIT(); asm volatile("" ::: "memory");
}
__device__ __forceinline__ CvtItem cvt_item(const Args& a, int part, int it) {
    unsigned char* ws = a.ws;
    constexpr int I_UP = (DM / 64) * (FF / 32);
    constexpr int I_DN = (FF / 64) * (DM / 32);
    constexpr int I_IN = (DM / 64) * (NINP / 32);
    const int n_up = part == 2 ? 0 : 2 * I_UP, n_dn = part == 1 ? 0 : I_DN;
    CvtItem d; int r = it;
    if (r < n_up) {
        const int which = r / I_UP; r -= which * I_UP; const int nblk = FF / 32, kb = r / nblk, nb = r % nblk, n0 = 32 * nb;
        d.W = a.in[part == 0 ? (which == 0 ? I_F1W1 : I_F1W3) : (which == 0 ? I_F2W1 : I_F2W3)]; d.gain = a.in[part == 0 ? I_G1 : I_G2];
        d.WT = (bf16*)(ws + (part == 0 ? WS_W13A : WS_W13B)); d.N = FF; d.nKT = DM / 64; d.dst_row0 = 256 * (n0 / 128) + (n0 % 128) + 128 * which; d.k0 = 64 * kb; d.n0 = n0; return d; }
    r -= n_up;
    if (r < n_dn) { const int nblk = DM / 32, kb = r / nblk, nb = r % nblk;
        d.W = a.in[part ? I_F2W2 : I_F1W2]; d.gain = nullptr; d.WT = (bf16*)(ws + (part ? WS_W2B : WS_W2A)); d.N = DM; d.nKT = FF / 64; d.dst_row0 = 32 * nb; d.k0 = 64 * kb; d.n0 = 32 * nb; return d; }
    r -= n_dn;
    if (r < I_IN) { const int nblk = NINP / 32, kb = r / nblk, nb = r % nblk;
        d.W = a.in[I_WIN]; d.gain = a.in[I_GM]; d.WT = (bf16*)(ws + WS_WIN); d.N = NIN; d.nKT = DM / 64; d.dst_row0 = 32 * nb; d.k0 = 64 * kb; d.n0 = 32 * nb; return d; }
    r -= I_IN; { const int nblk = DM / 32, kb = r / nblk, nb = r % nblk;
        d.W = a.in[I_WOUT]; d.gain = nullptr; d.WT = (bf16*)(ws + WS_WOUT); d.N = DM; d.nKT = DM / 64; d.dst_row0 = 32 * nb; d.k0 = 64 * kb; d.n0 = 32 * nb; return d; }
}
__device__ __forceinline__ void convert_weights(const Args& a, LAS unsigned char* lds, int part, int gw, int NGW, int wave, int lane, int it_lo = 0, int it_hi = 1 << 30) {
    LAS float* scr = (LAS float*)(lds + RING_OFF + wave * 16384);
    constexpr int I_UP = (DM / 64) * (FF / 32), I_DN = (FF / 64) * (DM / 32), I_IN = (DM / 64) * (NINP / 32), I_OUT = (DM / 64) * (DM / 32);
    const int full = (part == 2 ? 0 : 2 * I_UP) + (part == 1 ? 0 : I_DN) + (part == 1 ? I_IN + I_OUT : 0), total = it_hi < full ? it_hi : full;
    int it = it_lo + gw; if (it >= total) return;
    CvtItem d = cvt_item(a, part, it); f32x4 v[8]; cvt_load(d, lane, v);
    for (;;) {
        const int itn = it + NGW; const bool more = itn < total;
        CvtItem dn = d; f32x4 vn[8];
#pragma unroll
        for (int i = 0; i < 8; ++i) vn[i] = v[i];
        if (more) { dn = cvt_item(a, part, itn); cvt_load(dn, lane, vn); }
        cvt_store(d, scr, lane, v);
        if (!more) break;
        d = dn; it = itn;
#pragma unroll
        for (int i = 0; i < 8; ++i) v[i] = vn[i];
    }
}
__device__ __forceinline__ void p0_prologue(const Args& a, LAS unsigned char* lds, int vcu, int G, int wave, int lane) {
    const int gw = vcu * 8 + wave, NGW = G * 8;
    unsigned char* ws = a.ws;
    convert_weights(a, lds, 0, gw, NGW, wave, lane);
    bf16* XB = (bf16*)(ws + WS_XB); float* SS0 = (float*)(ws + WS_SS);
    for (int m = gw; m < MROWS; m += NGW) {
        const float* xrow = (m < MP) ? a.in[I_XP] + (size_t)m * DM : a.in[I_XS] + (size_t)(m - MP) * DM;
        const GAS f32x4* xr = (const GAS f32x4*)xrow + lane;
        f32x4 v[8]; float s = 0.f;
#pragma unroll
        for (int j = 0; j < 8; ++j) { v[j] = __builtin_nontemporal_load(xr + 64 * j); s += (v[j].x * v[j].x + v[j].y * v[j].y) + (v[j].z * v[j].z + v[j].w * v[j].w); }
        s = wave_sum(s);
#pragma unroll
        for (int j = 0; j < 8; ++j) { v2u w; w.x = pk2(v[j].x, v[j].y); w.y = pk2(v[j].z, v[j].w); *(GAS v2u*)(XB + pg8::tiled_elem(m, 4 * lane + 256 * j, DM / 64)) = w; }
        if (lane == 0) SS0[m] = 1.0f / sqrtf(s * (1.0f / DM) + EPS);
    }
}

__device__ __forceinline__ void finalize_rstd(const float* SS, float* RS, int gw, int NGW, int lane, int nrows = MROWS) {
    const int hl = lane & 31, hf = lane >> 5;
    constexpr int NB = 9;
    for (int mb = 2 * gw; mb < nrows; mb += NB * 2 * NGW) {
        float s[NB];
#pragma unroll
        for (int k = 0; k < NB; ++k) { const int m = mb + k * 2 * NGW + hf; s[k] = m < nrows ? SS[(size_t)m * 32 + hl] : 0.f; }
#pragma unroll
        for (int k = 0; k < NB; ++k) {
            const int m = mb + k * 2 * NGW + hf;
            float v = s[k];
#pragma unroll
            for (int o = 1; o < 32; o <<= 1) v += __shfl_xor(v, o);
            if (hl == 0 && m < nrows) RS[m] = 1.0f / sqrtf(v * (1.0f / DM) + EPS);
        }
    }
}

__device__ __forceinline__ void final_norm_sample_rows(const Args& a, const float* PART, int gw, int NGW, int lane) {
    const bf16* XB = (const bf16*)(a.ws + WS_XB); const float* gf = a.in[I_GF];
    for (int r = gw; r < MS; r += NGW) {
        const int m = MP + r;
        pg8::f32x4 v[4][2]; float ss = 0.f;
#pragma unroll
        for (int j = 0; j < 4; ++j) {
            const int col = 8 * lane + 512 * j;
            const v4u w = *(const v4u*)(XB + pg8::tiled_elem(m, col, DM / 64));
            const float* p = PART + (size_t)r * DM + col;
            const pg8::f32x4 s0 = *(const pg8::f32x4*)p + *(const pg8::f32x4*)(p + (size_t)MS * DM), s1 = *(const pg8::f32x4*)(p + 4) + *(const pg8::f32x4*)(p + 4 + (size_t)MS * DM);
            v[j][0] = pg8::bf_lo4(w.x, w.y) + s0 * 0.5f; v[j][1] = pg8::bf_lo4(w.z, w.w) + s1 * 0.5f;
#pragma unroll
            for (int e = 0; e < 4; ++e) ss += v[j][0][e] * v[j][0][e] + v[j][1][e] * v[j][1][e];
        }
        const float rstd = 1.0f / sqrtf(wave_sum(ss) * (1.0f / DM) + EPS);
        float* yr = a.out + O_Y + (size_t)m * DM + 8 * lane;
#pragma unroll
        for (int j = 0; j < 4; ++j) { const pg8::f32x4 g0 = *(const pg8::f32x4*)(gf + 8 * lane + 512 * j), g1 = *(const pg8::f32x4*)(gf + 8 * lane + 512 * j + 4);
            *(pg8::f32x4*)(yr + 512 * j) = v[j][0] * rstd * g0; *(pg8::f32x4*)(yr + 512 * j + 4) = v[j][1] * rstd * g1; }
    }
}

template <int NS> __device__ __forceinline__ void reduce_sample_rows(const Args& a, const float* PART, float scale, float* RS, int gw, int NGW, int lane) {
    bf16* XB = (bf16*)(a.ws + WS_XB);
    for (int r = gw; r < MS; r += NGW) {
        const int m = MP + r;
        pg8::f32x4 v[4][2]; float ss = 0.f;
#pragma unroll
        for (int j = 0; j < 4; ++j) {
            const int col = 8 * lane + 512 * j;
            const v4u w = *(const v4u*)(XB + pg8::tiled_elem(m, col, DM / 64));
            const float* p = PART + (size_t)r * DM + col;
            pg8::f32x4 s0 = *(const pg8::f32x4*)p, s1 = *(const pg8::f32x4*)(p + 4);
#pragma unroll
            for (int q = 1; q < NS; ++q) { s0 += *(const pg8::f32x4*)(p + (size_t)q * MS * DM); s1 += *(const pg8::f32x4*)(p + 4 + (size_t)q * MS * DM); }
            v[j][0] = pg8::bf_lo4(w.x, w.y) + s0 * scale; v[j][1] = pg8::bf_lo4(w.z, w.w) + s1 * scale;
#pragma unroll
            for (int e = 0; e < 4; ++e) ss += v[j][0][e] * v[j][0][e] + v[j][1][e] * v[j][1][e];
        }
        const float rstd = 1.0f / sqrtf(wave_sum(ss) * (1.0f / DM) + EPS);
#pragma unroll
        for (int j = 0; j < 4; ++j) *(pg8::u32x4*)(XB + pg8::tiled_elem(m, 8 * lane + 512 * j, DM / 64)) = pg8::pack8(v[j][0], v[j][1]);
        if (lane == 0) RS[m] = rstd;
    }
}

constexpr float CP_EXIT = 8.8817841970012523e-16f;
constexpr int KS_PITCH = 272;
__device__ __forceinline__ float ex2(float x) { return __builtin_amdgcn_exp2f(x); }
__device__ __forceinline__ void sb_tile(f32x16& p0, f32x16& p1, float& cp, bool diag, int kv0, int qpos, int hh) {
    float om0[16], om1[16];
#pragma unroll
    for (int i = 0; i < 16; ++i) {
        { const float E = ex2(fminf(p0[i], 60.f)), rr = __builtin_amdgcn_rcpf(1.f + E); om0[i] = rr; p0[i] = E * rr; }
        { const float E = ex2(fminf(p1[i], 60.f)), rr = __builtin_amdgcn_rcpf(1.f + E); om1[i] = rr; p1[i] = E * rr; }
    }
    if (diag) {
        int rel = qpos - kv0 - 4 * hh; asm volatile("" : "+v"(rel));
#pragma unroll
        for (int i = 0; i < 16; ++i) { const int kvr = (i & 3) + 8 * (i >> 2);
            if (kvr >= rel) { om0[i] = 1.f; p0[i] = 0.f; }
            if (kvr + 32 >= rel) { om1[i] = 1.f; p1[i] = 0.f; } }
    }
    float gp[8], pp[8], T[8], E[8];
#pragma unroll
    for (int g = 0; g < 4; ++g) { gp[g] = (om0[4 * g] * om0[4 * g + 1]) * (om0[4 * g + 2] * om0[4 * g + 3]); gp[4 + g] = (om1[4 * g] * om1[4 * g + 1]) * (om1[4 * g + 2] * om1[4 * g + 3]); }
#pragma unroll
    for (int o = 0; o < 8; ++o) { float lo, hi; halves32(gp[o], lo, hi); pp[o] = hh == 0 ? hi : lo; T[o] = lo * hi; }
    E[7] = cp;
#pragma unroll
    for (int o = 6; o >= 0; --o) E[o] = E[o + 1] * T[o + 1];
    cp = E[0] * T[0];
#pragma unroll
    for (int g = 0; g < 4; ++g) {
        { const float off = E[g] * (hh == 0 ? pp[g] : 1.f); const float s3 = off, s2 = s3 * om0[4 * g + 3], s1 = s2 * om0[4 * g + 2], s0 = s1 * om0[4 * g + 1];
          p0[4 * g + 3] *= s3; p0[4 * g + 2] *= s2; p0[4 * g + 1] *= s1; p0[4 * g] *= s0; }
        { const float off = E[4 + g] * (hh == 0 ? pp[4 + g] : 1.f); const float s3 = off, s2 = s3 * om1[4 * g + 3], s1 = s2 * om1[4 * g + 2], s0 = s1 * om1[4 * g + 1];
          p1[4 * g + 3] *= s3; p1[4 * g + 2] *= s2; p1[4 * g + 1] *= s1; p1[4 * g] *= s0; }
    }
}
__device__ __forceinline__ bf16x8 pack_frag(const f32x16& p, int half) {
    v4u w; w.x = pk2(p[8 * half + 0], p[8 * half + 1]); w.y = pk2(p[8 * half + 2], p[8 * half + 3]); w.z = pk2(p[8 * half + 4], p[8 * half + 5]); w.w = pk2(p[8 * half + 6], p[8 * half + 7]);
    return __builtin_bit_cast(bf16x8, w);
}
constexpr int RP = 320;
__device__ __forceinline__ s16x4 trd(const LAS unsigned char* blk, int pitch, int lane) {
    typedef short v4i16_t __attribute__((ext_vector_type(4)));
    const int i = lane & 15;
    return __builtin_bit_cast(s16x4, __builtin_amdgcn_ds_read_tr16_b64_v4i16((LAS v4i16_t*)(blk + (i >> 2) * pitch + 8 * (i & 3))));
}
__device__ __forceinline__ bf16x8 tr_frag(const LAS unsigned char* tile, int ra, int rb, int cbase, int lane) {
    const int g = (lane >> 4) & 1;
    const s16x4 lo = trd(tile + ra * RP + (cbase + 16 * g) * 2, RP, lane), hi = trd(tile + rb * RP + (cbase + 16 * g) * 2, RP, lane);
    return (bf16x8){lo[0], lo[1], lo[2], lo[3], hi[0], hi[1], hi[2], hi[3]};
}
__device__ __forceinline__ void attn_prompt_pair(const Args& a, LAS unsigned char* lds, int b, int h, int j, int tid, int wave, int lane) {
    const bf16* QA = (const bf16*)(a.ws + WS_QA); const bf16* KA = (const bf16*)(a.ws + WS_KA); const bf16* VA = (const bf16*)(a.ws + WS_VA);
    bf16* MRG = (bf16*)(a.out + O_Y);
    const int r = lane & 31, hh = lane >> 5, half = wave >> 2, hw = wave & 3;
    const int t0w = (2 * j + half) * 128 + hw * 32;
    const size_t mrow = (size_t)b * TP + t0w + r;
    f32x16 o[4];
#pragma unroll
    for (int k = 0; k < 4; ++k)
#pragma unroll
        for (int i = 0; i < 16; ++i) o[k][i] = 0.f;
    float cp = 1.f;
    constexpr int ABUF = 64 * KS_PITCH + 64 * RP + 128 * KS_PITCH;
    LAS unsigned char* Ks = lds + half * ABUF; LAS unsigned char* VS = Ks + 64 * KS_PITCH; LAS unsigned char* QS = VS + 64 * RP;
    static_assert(2 * ABUF + 64 <= LDSCTL_OFF, "attention LDS");
    LAS unsigned* DONE = (LAS unsigned*)(lds + 2 * ABUF);
    bool wdone = false;
    const int htid = tid & 255, srow = htid >> 4, sc8 = htid & 15;
    {
        const bf16* qg = QA + ((size_t)b * TP + (2 * j + half) * 128 + srow) * GW + h * HD + 8 * sc8;
#pragma unroll
        for (int i = 0; i < 8; ++i) *(LAS v4u*)(QS + (srow + 16 * i) * KS_PITCH + 16 * sc8) = *(const v4u*)(qg + (size_t)(16 * i) * GW);
    }
    const LAS unsigned char* qrow = QS + (hw * 32 + r) * KS_PITCH + hh * 16;
    const bf16* kg = KA + ((size_t)b * TP + srow) * GW + h * HD + 8 * sc8; const bf16* vg = VA + ((size_t)b * TP + srow) * GW + h * HD + 8 * sc8;
    v4u pk[4], pv[4];
    { const int jt0 = 2 * (2 * j + half) + 1;
#pragma unroll
      for (int i = 0; i < 4; ++i) { pk[i] = *(const v4u*)(kg + (size_t)(64 * jt0 + 16 * i) * GW); pv[i] = *(const v4u*)(vg + (size_t)(64 * jt0 + 16 * i) * GW); } }
    for (int jt = 2 * (2 * j + half) + 1;; --jt) {
        if (jt < 0) wdone = true;
        if (lane == 0) DONE[wave] = wdone ? 1u : 0u;
        __syncthreads();
        { const v4u d0 = *(const LAS v4u*)DONE, d1 = *(const LAS v4u*)(DONE + 4); if ((d0.x & d0.y & d0.z & d0.w & d1.x & d1.y & d1.z & d1.w) != 0u) break; }
        if (jt >= 0) {
            LAS unsigned char* kd = Ks + srow * KS_PITCH + 16 * sc8; LAS unsigned char* vd = VS + srow * RP + 16 * sc8;
#pragma unroll
            for (int i = 0; i < 4; ++i) { *(LAS v4u*)(kd + 16 * i * KS_PITCH) = pk[i]; *(LAS v4u*)(vd + 16 * i * RP) = pv[i]; }
        }
        if (jt >= 1) {
#pragma unroll
            for (int i = 0; i < 4; ++i) { pk[i] = *(const v4u*)(kg + (size_t)(64 * (jt - 1) + 16 * i) * GW); pv[i] = *(const v4u*)(vg + (size_t)(64 * (jt - 1) + 16 * i) * GW); }
        }
        __syncthreads();
        if (!wdone && 64 * jt <= t0w + 30) {
            f32x16 p0, p1;
#pragma unroll
            for (int i = 0; i < 16; ++i) { p0[i] = 0.f; p1[i] = 0.f; }
#pragma unroll
            for (int ks = 0; ks < 8; ++ks) {
                const bf16x8 k0 = *(const LAS bf16x8*)(Ks + r * KS_PITCH + (ks * 16 + hh * 8) * 2);
                const bf16x8 k1 = *(const LAS bf16x8*)(Ks + (32 + r) * KS_PITCH + (ks * 16 + hh * 8) * 2);
                const bf16x8 qf = *(const LAS bf16x8*)(qrow + ks * 32);
                p0 = MFMA32(k0, qf, p0); p1 = MFMA32(k1, qf, p1);
            }
            sb_tile(p0, p1, cp, 64 * jt + 63 >= t0w, 64 * jt, t0w + r, hh);
            bf16x8 af[4]; af[0] = pack_frag(p0, 0); af[1] = pack_frag(p0, 1); af[2] = pack_frag(p1, 0); af[3] = pack_frag(p1, 1);
#pragma unroll
            for (int blk = 0; blk < 4; ++blk)
#pragma unroll
                for (int s = 0; s < 4; ++s) {
                    o[blk] = MFMA32(tr_frag(VS, 16 * s + 4 * hh, 16 * s + 8 + 4 * hh, 32 * blk, lane), af[s], o[blk]);
                }
            wdone = __ballot(cp >= CP_EXIT) == 0ull;
        }
    }
    __syncthreads();
    float ss = 0.f;
#pragma unroll
    for (int k = 0; k < 4; ++k)
#pragma unroll
        for (int i = 0; i < 16; ++i) ss += o[k][i] * o[k][i];
    ss = sum_halves32(ss);
    const float rstd = 1.0f / sqrtf(ss * (1.0f / 128.0f) + EPS);
    const float* sbg = a.in[I_SBG] + h * HD;
#pragma unroll
    for (int k = 0; k < 4; ++k)
#pragma unroll
        for (int g = 0; g < 4; ++g) { const int d = 32 * k + 8 * g + 4 * hh; const f32x4 gv = *(const f32x4*)(sbg + d);
            v2u w; w.x = pk2(o[k][4 * g] * rstd * gv[0], o[k][4 * g + 1] * rstd * gv[1]); w.y = pk2(o[k][4 * g + 2] * rstd * gv[2], o[k][4 * g + 3] * rstd * gv[3]);
            *(v2u*)(MRG + pg8::tiled_elem((int)mrow, h * HD + d, DM / 64)) = w; }
}
__device__ __forceinline__ void attn_prompt_phase(const Args& a, LAS unsigned char* lds, int vcu, int G, int tid, int wave, int lane) {
    for (int p = vcu; p < NBP * NH * (TP / 256); p += G) {
        const int bh = p >> 5, j = p & 31;
        attn_prompt_pair(a, lds, bh >> 3, bh & 7, j, tid, wave, lane);
    }
}

constexpr int SEGK = 128;
__device__ __forceinline__ void attn_sample_unit(const Args& a, LAS unsigned char* lds, int b, int h, int tid, int wave, int lane) {
    LAS float* Qs = (LAS float*)lds;
    LAS float* OM = (LAS float*)(lds + 8192);
    LAS float* BT = (LAS float*)(lds + 16384);
    LAS float* RED = (LAS float*)(lds + 24576);
    LAS float* CAR = (LAS float*)(lds + 24576 + 256);
    const bf16* QA = (const bf16*)(a.ws + WS_QA); bf16* MRG = (bf16*)(a.out + O_Y);
    __syncthreads();
    for (int i = tid; i < 16 * 128; i += 512) { const int q = i >> 7, d = i & 127; Qs[i] = bf2f(QA[(size_t)(MP + b * TS + q) * GW + h * HD + d]); }
    __syncthreads();
    const int dch = tid & 127, qg = tid >> 7;
    float oacc[4] = {0.f, 0.f, 0.f, 0.f};
    float carry0 = 1.f, carry1 = 1.f;
    for (int seg = 0; seg <= PAST / SEGK; ++seg) {
        const bool first = seg == 0, lastseg = seg == PAST / SEGK; constexpr int NCF = SEGK - TS;
        const int seglen = lastseg ? TS : SEGK, kstart = lastseg ? 0 : PAST - NCF - seg * SEGK;
        {
            float om[4] = {1.f, 1.f, 1.f, 1.f}, bt[4] = {0.f, 0.f, 0.f, 0.f};
            if (dch < seglen) {
                const bool nk = first && dch >= NCF; const int kk = dch - NCF;
                const float* krow = nk ? a.out + O_KS + ((size_t)(b * TS + kk) * NH + h) * HD : a.in[I_CK] + (((size_t)b * PAST + kstart + dch) * NH + h) * HD;
                float z[4] = {0.f, 0.f, 0.f, 0.f};
#pragma unroll 8
                for (int d4 = 0; d4 < 32; ++d4) { const f32x4 kv = *(const f32x4*)(krow + 4 * d4);
#pragma unroll
                    for (int q = 0; q < 4; ++q) { const f32x4 qv = *(const LAS f32x4*)(Qs + (4 * qg + q) * 128 + 4 * d4); z[q] += (kv[0] * qv[0] + kv[1] * qv[1]) + (kv[2] * qv[2] + kv[3] * qv[3]); } }
#pragma unroll
                for (int q = 0; q < 4; ++q) { const float E = ex2(fminf(z[q], 60.f)), rr = __builtin_amdgcn_rcpf(1.f + E); om[q] = rr; bt[q] = E * rr;
                    if (nk && kk >= 4 * qg + q) { om[q] = 1.f; bt[q] = 0.f; } }
            }
#pragma unroll
            for (int q = 0; q < 4; ++q) { OM[(4 * qg + q) * SEGK + dch] = om[q]; BT[(4 * qg + q) * SEGK + dch] = bt[q]; }
        }
        __syncthreads();
#pragma unroll
        for (int rr2 = 0; rr2 < 2; ++rr2) { const int q = 2 * wave + rr2; float& carry = rr2 ? carry1 : carry0;
            const float om0 = OM[q * SEGK + 2 * lane], om1 = OM[q * SEGK + 2 * lane + 1], bt0 = BT[q * SEGK + 2 * lane], bt1 = BT[q * SEGK + 2 * lane + 1];
            float inc = om0 * om1;
#pragma unroll
            for (int off = 1; off < 64; off <<= 1) { const float v = __shfl_down(inc, off); if (lane + off < 64) inc *= v; }
            float exc = __shfl_down(inc, 1); if (lane == 63) exc = 1.f;
            const float suf = carry * exc;
            BT[q * SEGK + 2 * lane + 1] = bt1 * suf; BT[q * SEGK + 2 * lane] = bt0 * suf * om1;
            carry = carry * __shfl(inc, 0);
            if (lane == 0) CAR[q] = carry;
        }
        __syncthreads();
        {
            const float* vcache = a.in[I_CV] + (((size_t)b * PAST + kstart) * NH + h) * HD + dch; const float* vnew = a.out + O_VS + ((size_t)(b * TS) * NH + h) * HD + dch;
            for (int k4 = 0; k4 < seglen; k4 += 4) {
                const float* vb = (first && k4 >= NCF) ? vnew + (size_t)(k4 - NCF) * (NH * HD) : vcache + (size_t)k4 * (NH * HD);
                float v[4];
#pragma unroll
                for (int e = 0; e < 4; ++e) v[e] = vb[(size_t)e * (NH * HD)];
#pragma unroll
                for (int i = 0; i < 4; ++i) { const f32x4 aw = *(const LAS f32x4*)(BT + (4 * qg + i) * SEGK + k4); oacc[i] += (aw[0] * v[0] + aw[1] * v[1]) + (aw[2] * v[2] + aw[3] * v[3]); }
            }
        }
        float cmax = 0.f;
#pragma unroll
        for (int q4 = 0; q4 < 4; ++q4) { const f32x4 cv = *(const LAS f32x4*)(CAR + 4 * q4); cmax = fmaxf(fmaxf(cmax, fmaxf(cv[0], cv[1])), fmaxf(cv[2], cv[3])); }
        __syncthreads();
        if (cmax < CP_EXIT) break;
    }
#pragma unroll
    for (int i = 0; i < 4; ++i) { const float s = wave_sum(oacc[i] * oacc[i]); if (lane == 0) RED[(4 * qg + i) * 4 + (wave & 1)] = s; }
    __syncthreads();
    const float gsb = a.in[I_SBG][h * HD + dch];
#pragma unroll
    for (int i = 0; i < 4; ++i) { const int q = 4 * qg + i; const float ss = RED[q * 4] + RED[q * 4 + 1]; const float rstd = 1.0f / sqrtf(ss * (1.0f / 128.0f) + EPS);
        MRG[pg8::tiled_elem(MP + b * TS + q, h * HD + dch, DM / 64)] = f2bf(oacc[i] * rstd * gsb); }
}

constexpr int SEGC = 16, NSEGB = (TP / 64) / SEGC, NSEGP = NBP * NH * NSEGB;
constexpr int C0_PITCH = 272;
typedef float f32x2v __attribute__((ext_vector_type(2)));
constexpr int ML_QS = 0, ML_KS = 17408, ML_KT = 34816  , ML_VT = ML_KT + 64 * RP  , ML_C0 = 76288, ML_CWL = 119808, ML_PS = 127520, ML_MLG = 128544, ML_NST = 129056  ;
constexpr int ML_TAB = 132096, TAB_GS = ML_TAB, TAB_CM = ML_TAB + 4096, TAB_BS = ML_TAB + 8192, TAB_WA = ML_TAB + 12288, TAB_SC = ML_TAB + 16384, TAB_M = TAB_SC + 256, ML_TAB_END = TAB_M + 128;
static_assert(ML_TAB >= RING_BYTES && ML_TAB_END <= LDSCTL_OFF, "mLSTM gate tables");
static_assert(ML_VT + 64 * RP <= ML_C0 && ML_C0 + 2 * 64 * RP <= ML_CWL && ML_NST + 512 <= RING_BYTES, "mLSTM LDS map");

struct MUnit { int b, h, nvalid, nch, samp, sid, sg, t0; size_t row0; };
__device__ __forceinline__ MUnit munit_prompt(int seg) { MUnit u; const int bh = seg / NSEGB; u.sg = seg % NSEGB; u.b = bh >> 3; u.h = bh & 7; u.nvalid = 64; u.nch = SEGC; u.samp = 0; u.sid = seg;
    u.t0 = u.sg * SEGC * 64; u.row0 = (size_t)u.b * TP + u.t0; return u; }
__device__ __forceinline__ MUnit munit_sample(int sid) { MUnit u; u.b = sid >> 3; u.h = sid & 7; u.sg = 0; u.nvalid = TS; u.nch = 1; u.samp = 1; u.sid = sid; u.t0 = 0; u.row0 = (size_t)MP + u.b * TS; return u; }

__device__ __forceinline__ void unpack8(const v4u w, float (&x)[8]) {
    x[0] = __uint_as_float(w.x << 16); x[1] = __uint_as_float(w.x & 0xffff0000u); x[2] = __uint_as_float(w.y << 16); x[3] = __uint_as_float(w.y & 0xffff0000u);
    x[4] = __uint_as_float(w.z << 16); x[5] = __uint_as_float(w.z & 0xffff0000u); x[6] = __uint_as_float(w.w << 16); x[7] = __uint_as_float(w.w & 0xffff0000u);
}
__device__ __forceinline__ void load_taps(const bf16* src, int tpos, v4u (&raw)[5]) {
#pragma unroll
    for (int j = 0; j < 5; ++j) { raw[j] = (v4u){0u, 0u, 0u, 0u}; if (tpos + j - 3 >= 0) raw[j] = *(const v4u*)(src + (long)(j - 3) * 2048); }
}
__device__ __forceinline__ void conv8x2(const v4u (&raw)[5], int tpos  , bool samp, const float* hist  , const LAS float* cwl  ,
                                        float sc, float (&o0)[8], float (&o1)[8], float (&x3)[8], float (&x4)[8]) {
    float x[5][8];
#pragma unroll
    for (int j = 0; j < 5; ++j) {
        const int tt = tpos + j - 3;
        unpack8(raw[j], x[j]);
        if (tt < 0 && samp) { const float* sp = hist + (size_t)(3 + tt) * 2048; const f32x4 s0 = *(const f32x4*)sp, s1 = *(const f32x4*)(sp + 4); x[j][0] = s0[0]; x[j][1] = s0[1]; x[j][2] = s0[2]; x[j][3] = s0[3]; x[j][4] = s1[0]; x[j][5] = s1[1]; x[j][6] = s1[2]; x[j][7] = s1[3]; }
    }
    { const f32x4 b0 = *(const LAS f32x4*)(cwl + 4 * 128), b1 = *(const LAS f32x4*)(cwl + 4 * 128 + 4);
#pragma unroll
      for (int e = 0; e < 4; ++e) { o0[e] = b0[e]; o0[4 + e] = b1[e]; o1[e] = b0[e]; o1[4 + e] = b1[e]; } }
#pragma unroll
    for (int j = 0; j < 4; ++j) { const f32x4 w0 = *(const LAS f32x4*)(cwl + j * 128), w1 = *(const LAS f32x4*)(cwl + j * 128 + 4);
#pragma unroll
        for (int e = 0; e < 4; ++e) { o0[e] += w0[e] * x[j][e]; o0[4 + e] += w1[e] * x[j][4 + e]; o1[e] += w0[e] * x[j + 1][e]; o1[4 + e] += w1[e] * x[j + 1][4 + e]; } }
#pragma unroll
    for (int e = 0; e < 8; ++e) { o0[e] = o0[e] * pg8::sigmoid_f(o0[e]) * sc; o1[e] = o1[e] * pg8::sigmoid_f(o1[e]) * sc; x3[e] = x[3][e]; x4[e] = x[4][e]; }
}
__device__ __forceinline__ v4u pack8f(const float (&v)[8]) { v4u w; w.x = pk2(v[0], v[1]); w.y = pk2(v[2], v[3]); w.z = pk2(v[4], v[5]); w.w = pk2(v[6], v[7]); return w; }
__device__ __forceinline__ v4u pack8fs(const float (&v)[8], float s) { v4u w; w.x = pk2(v[0] * s, v[1] * s); w.y = pk2(v[2] * s, v[3] * s); w.z = pk2(v[4] * s, v[5] * s); w.w = pk2(v[6] * s, v[7] * s); return w; }
template <bool OUT> __device__ __forceinline__ void stage_chunk(const Args& a, LAS unsigned char* lds, const MUnit& u, int c, int wkoff, int tid) {
    const LAS float* WA = (const LAS float*)(lds + TAB_WA) + 64 * c;
    const bf16* QKB = (const bf16*)(a.ws + WS_QKB); const bf16* VB = (const bf16*)(a.ws + WS_VB);
    const size_t rowc = u.row0 + 64 * c; const int tc = u.t0 + 64 * c;
    const int c8 = tid & 15, s0 = 2 * (tid >> 4);
    const LAS float* cwq = (const LAS float*)(lds + ML_CWL) + 8 * c8; const LAS float* cwk = cwq + 5 * 128;
    const float* histq = a.in[I_SCONV] + (size_t)u.b * 3 * 2048 + u.h * HD + 8 * c8; const float* histk = histq + 1024;
    const bool lastchunk = OUT && (u.samp || (u.sg == NSEGB - 1 && c == SEGC - 1));
    const v4u z4 = (v4u){0u, 0u, 0u, 0u};
    const bool valid = s0 < u.nvalid;
    LAS unsigned char* qsb = lds + ML_QS + s0 * KS_PITCH + 16 * c8;
    LAS unsigned char* wkb = lds + wkoff + s0 * RP + 16 * c8;
    float* ob = a.out + (u.samp ? O_CVS : O_CVP) + (size_t)u.b * 3 * 2048 + u.h * HD + 8 * c8;
    const bool w0 = lastchunk && s0 >= u.nvalid - 3, w1 = lastchunk && s0 + 1 >= u.nvalid - 3;
    v4u rk[5], rq[5], v0 = z4, v1 = z4;
#pragma unroll
    for (int j = 0; j < 5; ++j) { rk[j] = z4; rq[j] = z4; }
    if (valid) {
        load_taps(QKB + (rowc + s0) * 2048 + 1024 + u.h * HD + 8 * c8, tc + s0, rk);
        if (OUT) load_taps(QKB + (rowc + s0) * 2048 + u.h * HD + 8 * c8, tc + s0, rq);
        v0 = *(const v4u*)(VB + (rowc + s0) * GW + u.h * HD + 8 * c8); v1 = *(const v4u*)(VB + (rowc + s0 + 1) * GW + u.h * HD + 8 * c8);
    }
    {
        v4u k0 = z4, k1 = z4, wk0 = z4, wk1 = z4;
        if (valid) { float o0[8], o1[8], x3[8], x4[8];
            conv8x2(rk, tc + s0, u.samp != 0, histk, cwk, KSCALE, o0, o1, x3, x4);
            wk0 = pack8fs(o0, WA[s0]); wk1 = pack8fs(o1, WA[s0 + 1]);
            if (OUT) { k0 = pack8f(o0); k1 = pack8f(o1);
                if (w0) { float* o = ob + (size_t)(s0 - (u.nvalid - 3)) * 2048 + 1024; *(f32x4*)o = (f32x4){x3[0], x3[1], x3[2], x3[3]}; *(f32x4*)(o + 4) = (f32x4){x3[4], x3[5], x3[6], x3[7]}; }
                if (w1) { float* o = ob + (size_t)(s0 + 1 - (u.nvalid - 3)) * 2048 + 1024; *(f32x4*)o = (f32x4){x4[0], x4[1], x4[2], x4[3]}; *(f32x4*)(o + 4) = (f32x4){x4[4], x4[5], x4[6], x4[7]}; } } }
        if (OUT) { *(LAS v4u*)(qsb + (ML_KS - ML_QS)) = k0; *(LAS v4u*)(qsb + (ML_KS - ML_QS) + KS_PITCH) = k1; }
        *(LAS v4u*)wkb = wk0; *(LAS v4u*)(wkb + RP) = wk1;
        *(LAS v4u*)(wkb + 64 * RP) = v0; *(LAS v4u*)(wkb + 64 * RP + RP) = v1;
    }
    if (OUT) {
        __builtin_amdgcn_sched_barrier(0);
        v4u q0 = z4, q1 = z4;
        if (valid) { float o0[8], o1[8], x3[8], x4[8];
            conv8x2(rq, tc + s0, u.samp != 0, histq, cwq, 1.0f, o0, o1, x3, x4);
            q0 = pack8f(o0); q1 = pack8f(o1);
            if (w0) { float* o = ob + (size_t)(s0 - (u.nvalid - 3)) * 2048; *(f32x4*)o = (f32x4){x3[0], x3[1], x3[2], x3[3]}; *(f32x4*)(o + 4) = (f32x4){x3[4], x3[5], x3[6], x3[7]}; }
            if (w1) { float* o = ob + (size_t)(s0 + 1 - (u.nvalid - 3)) * 2048; *(f32x4*)o = (f32x4){x4[0], x4[1], x4[2], x4[3]}; *(f32x4*)(o + 4) = (f32x4){x4[4], x4[5], x4[6], x4[7]}; } }
        *(LAS v4u*)qsb = q0; *(LAS v4u*)(qsb + KS_PITCH) = q1;
    }
}
__device__ __forceinline__ void load_kv(const Args& a, const MUnit& u, int c, int tid, v4u (&t)[7]) {
    const bf16* QKB = (const bf16*)(a.ws + WS_QKB); const bf16* VB = (const bf16*)(a.ws + WS_VB);
    const size_t rowc = u.row0 + 64 * c; const int tc = u.t0 + 64 * c;
    const int c8 = tid & 15, s0 = 2 * (tid >> 4);
    v4u rk[5]; load_taps(QKB + (rowc + s0) * 2048 + 1024 + u.h * HD + 8 * c8, tc + s0, rk);
#pragma unroll
    for (int j = 0; j < 5; ++j) t[j] = rk[j];
    t[5] = *(const v4u*)(VB + (rowc + s0) * GW + u.h * HD + 8 * c8); t[6] = *(const v4u*)(VB + (rowc + s0 + 1) * GW + u.h * HD + 8 * c8);
}
__device__ __forceinline__ void process_kv(const Args& a, LAS unsigned char* lds, const MUnit& u, int c, int wkoff, int tid, const v4u (&t)[7]) {
    const LAS float* WA = (const LAS float*)(lds + TAB_WA) + 64 * c;
    const int tc = u.t0 + 64 * c, c8 = tid & 15, s0 = 2 * (tid >> 4);
    const LAS float* cwk = (const LAS float*)(lds + ML_CWL) + 8 * c8 + 5 * 128;
    const float* histk = a.in[I_SCONV] + (size_t)u.b * 3 * 2048 + u.h * HD + 8 * c8 + 1024;
    v4u rk[5];
#pragma unroll
    for (int j = 0; j < 5; ++j) rk[j] = t[j];
    float o0[8], o1[8], x3[8], x4[8];
    conv8x2(rk, tc + s0, u.samp != 0, histk, cwk, KSCALE, o0, o1, x3, x4);
    LAS unsigned char* wkb = lds + wkoff + s0 * RP + 16 * c8;
    *(LAS v4u*)wkb = pack8fs(o0, WA[s0]); *(LAS v4u*)(wkb + RP) = pack8fs(o1, WA[s0 + 1]);
    *(LAS v4u*)(wkb + 64 * RP) = t[5]; *(LAS v4u*)(wkb + 64 * RP + RP) = t[6];
}
__device__ __forceinline__ void munit_setup(const Args& a, LAS unsigned char* lds, const MUnit& u, int tid, bool both  ) {
    LAS float* cwl = (LAS float*)(lds + ML_CWL);
    for (int i = tid; i < 2 * 5 * 128; i += 512) { const int qk = i / 640, j = (i % 640) >> 7, d = i & 127;
        cwl[i] = j < 4 ? a.in[I_CONVW][(size_t)j * 2048 + qk * 1024 + u.h * HD + d] : a.in[I_CONVB][qk * 1024 + u.h * HD + d]; }
    for (int i = tid; i < 64 * 4; i += 512) { const int row = i >> 2, q = i & 3; const v4u w = (v4u){q == 0 ? 0x3f80u : 0u, 0u, 0u, 0u};
        *(LAS v4u*)(lds + ML_VT + row * RP + 256 + 16 * q) = w; if (both) *(LAS v4u*)(lds + ML_C0 + 64 * RP + row * RP + 256 + 16 * q) = w; }
    if (tid < 128) ((LAS float*)(lds + ML_MLG))[tid] = a.in[I_MLG][u.h * HD + tid];
}
__device__ __forceinline__ float lane_read(float v, int src) { return __int_as_float(__builtin_amdgcn_ds_bpermute(src << 2, __float_as_int(v))); }
__device__ __forceinline__ void chunk_gates(const float* G, size_t rowc, int nvalid, int h, int lane, float& bs, float& gs, float& Btot, float& Gmax) {
    float ig = -INFINITY, lf = 0.f;
    if (lane < nvalid) { ig = G[(rowc + lane) * 16 + h]; lf = G[(rowc + lane) * 16 + 8 + h]; }
    float x = lf;
#pragma unroll
    for (int off = 1; off < 64; off <<= 1) { const float v = lane_read(x, lane >= off ? lane - off : lane); if (lane >= off) x += v; }
    bs = x; gs = ig - x; Btot = lane_read(x, 63 | (lane & 0));
    float mxv = gs;
#pragma unroll
    for (int off = 1; off < 64; off <<= 1) mxv = fmaxf(mxv, lane_read(mxv, lane ^ off));
    Gmax = mxv;
}
__device__ __forceinline__ void gate_tables(const float* G, LAS unsigned char* lds, const MUnit& u, float m0, int tid, int wave, int lane) {
    for (int c = wave; c < u.nch; c += 8) {
        float bs, gs, Bt, Gm; chunk_gates(G, u.row0 + 64 * c, u.nvalid, u.h, lane, bs, gs, Bt, Gm);
        float cm = gs;
#pragma unroll
        for (int off = 1; off < 64; off <<= 1) { const float v = lane_read(cm, lane >= off ? lane - off : lane); if (lane >= off) cm = fmaxf(cm, v); }
        ((LAS float*)(lds + TAB_GS))[64 * c + lane] = gs; ((LAS float*)(lds + TAB_CM))[64 * c + lane] = cm; ((LAS float*)(lds + TAB_BS))[64 * c + lane] = bs; ((LAS float*)(lds + TAB_WA))[64 * c + lane] = __expf(gs - Gm);
        if (lane == 0) { ((LAS float*)(lds + TAB_SC))[4 * c] = Bt; ((LAS float*)(lds + TAB_SC))[4 * c + 1] = Gm; }
    }
    __syncthreads();
    if (tid == 0) { float m = m0; LAS float* SC = (LAS float*)(lds + TAB_SC); LAS float* M = (LAS float*)(lds + TAB_M); float bsum = 0.f;
        for (int c = 0; c < u.nch; ++c) { M[c] = m; const float Bt = SC[4 * c], Gm = SC[4 * c + 1], mx = fmaxf(m, Gm); SC[4 * c + 2] = __expf(m - mx); SC[4 * c + 3] = __expf(Gm - mx); m = Bt + mx; bsum += Bt; }
        M[u.nch] = m; M[u.nch + 1] = bsum; }
    __syncthreads();
}
__device__ __forceinline__ void state_update(LAS unsigned char* lds, int wkoff, f32x16 (&R)[2], float& nst, float al, float be, int wave, int lane) {
    const int hh = lane >> 5, dkb = wave & 3, dvh = wave >> 2;
    const LAS unsigned char* WK = lds + wkoff; const LAS unsigned char* VS = WK + 64 * RP;
    bf16x8 kf[4];
#pragma unroll
    for (int ks = 0; ks < 4; ++ks) kf[ks] = tr_frag(WK, 16 * ks + 8 * hh, 16 * ks + 8 * hh + 4, dkb * 32, lane);
#pragma unroll
    for (int t = 0; t < 2; ++t) {
        const int dvb = 2 * dvh + t; f32x16 U;
#pragma unroll
        for (int i = 0; i < 16; ++i) U[i] = 0.f;
#pragma unroll
        for (int ks = 0; ks < 4; ++ks) U = MFMA32(tr_frag(VS, 16 * ks + 8 * hh, 16 * ks + 8 * hh + 4, dvb * 32, lane), kf[ks], U);
#pragma unroll
        for (int i = 0; i < 16; ++i) R[t][i] = al * R[t][i] + be * U[i];
    }
    if (dvh == 0) { f32x16 U;
#pragma unroll
        for (int i = 0; i < 16; ++i) U[i] = 0.f;
#pragma unroll
        for (int ks = 0; ks < 4; ++ks) U = MFMA32(tr_frag(VS, 16 * ks + 8 * hh, 16 * ks + 8 * hh + 4, 128, lane), kf[ks], U);
        nst = al * nst + be * U[0]; }
}
__device__ __forceinline__ void mlstm_summary_unit(const Args& a, LAS unsigned char* lds, int seg, int tid, int wave, int lane) {
    asm volatile("" : "+v"(tid), "+v"(lane));
    const MUnit u = munit_prompt(seg);
    const float* G = (const float*)(a.ws + WS_G);
    __syncthreads();
    munit_setup(a, lds, u, tid, true);
    gate_tables(G, lds, u, -INFINITY, tid, wave, lane);
    f32x16 R[2]; float nst = 0.f;
#pragma unroll
    for (int t = 0; t < 2; ++t)
#pragma unroll
        for (int i = 0; i < 16; ++i) R[t][i] = 0.f;
    v4u cur[7]; load_kv(a, u, 0, tid, cur);
    for (int cl = 0; cl < SEGC; ++cl) {
        int c = cl; asm volatile("" : "+s"(c));
        int tidc = tid, lanec = lane; asm volatile("" : "+v"(tidc), "+v"(lanec));
        const int tid = tidc, lane = lanec;
        const int ktoff = (c & 1) ? ML_C0 : ML_KT;
        v4u nxt[7];
#pragma unroll
        for (int j = 0; j < 7; ++j) nxt[j] = cur[j];
        if (c + 1 < SEGC) load_kv(a, u, c + 1, tid, nxt);
        process_kv(a, lds, u, c, ktoff, tid, cur);
#pragma unroll
        for (int j = 0; j < 7; ++j) cur[j] = nxt[j];
        __syncthreads();
        const LAS float* SC = (const LAS float*)(lds + TAB_SC) + 4 * c;
        state_update(lds, ktoff, R, nst, SC[2], SC[3], wave, lane);
    }
    const float Bseg = ((const LAS float*)(lds + TAB_M))[SEGC + 1], m_run = ((const LAS float*)(lds + TAB_M))[SEGC];
    int r = lane & 31; asm volatile("" : "+v"(r));
    const int hh = lane >> 5, dkb = wave & 3, dvh = wave >> 2;
    float* RS = (float*)(a.ws + WS_RSEG) + (size_t)seg * 16384 + wave * 2048 + hh * 32 + r;
#pragma unroll
    for (int t = 0; t < 2; ++t)
#pragma unroll
        for (int i = 0; i < 16; ++i) RS[(t * 16 + i) * 64] = R[t][i];
    if (dvh == 0 && hh == 0) ((float*)(a.ws + WS_NSEG))[(size_t)seg * 128 + dkb * 32 + r] = nst;
    if (tid == 0) { float* SS = (float*)(a.ws + WS_SSEG); SS[2 * seg] = Bseg; SS[2 * seg + 1] = m_run; }
}
__device__ __forceinline__ void mlstm_out_unit(const Args& a, LAS unsigned char* lds, const MUnit u, int tid, int wave, int lane) {
    asm volatile("" : "+v"(tid), "+v"(lane));
    const float* G = (const float*)(a.ws + WS_G);
    LAS float* PS = (LAS float*)(lds + ML_PS);
    LAS unsigned char* C0 = lds + ML_C0; LAS unsigned char* VT = lds + ML_VT;
    const bf16* OB = (const bf16*)(a.ws + WS_OB); bf16* MRG = (bf16*)(a.out + O_Y);
    const int r = lane & 31, hh = lane >> 5, dkb = wave & 3, dvh = wave >> 2;
    __syncthreads();
    munit_setup(a, lds, u, tid, false);
    f32x16 R[2]; float nst = 0.f, m_run = 0.f;
#pragma unroll
    for (int t = 0; t < 2; ++t)
#pragma unroll
        for (int i = 0; i < 16; ++i) R[t][i] = 0.f;
    if (u.samp) {
        const float* c0p = a.in[I_SC] + (size_t)u.sid * 16384;
#pragma unroll
        for (int t = 0; t < 2; ++t)
#pragma unroll
            for (int g = 0; g < 4; ++g) { const f32x4 v = *(const f32x4*)(c0p + (size_t)(dkb * 32 + r) * HD + (2 * dvh + t) * 32 + 8 * g + 4 * hh); R[t][4 * g] = v[0]; R[t][4 * g + 1] = v[1]; R[t][4 * g + 2] = v[2]; R[t][4 * g + 3] = v[3]; }
        nst = a.in[I_SN][(size_t)u.sid * 128 + dkb * 32 + r]; m_run = a.in[I_SM][u.sid];
    } else {
        const float* SSG = (const float*)(a.ws + WS_SSEG);
        const float* RSb = (const float*)(a.ws + WS_RSEG) + (size_t)(u.sid - u.sg) * 16384 + wave * 2048 + lane;
        const float* NSb = (const float*)(a.ws + WS_NSEG) + (size_t)(u.sid - u.sg) * 128 + dkb * 32 + r;
        const float* SGb = SSG + 2 * (u.sid - u.sg);
        f32x16 Rs[2]; float ns = 0.f, Bs = 0.f, ml = 0.f;
        if (u.sg > 0) {
#pragma unroll
            for (int t = 0; t < 2; ++t)
#pragma unroll
                for (int i = 0; i < 16; ++i) Rs[t][i] = RSb[(t * 16 + i) * 64];
            ns = NSb[0]; Bs = SGb[0]; ml = SGb[1];
        }
        for (int sp = 0; sp < u.sg; ++sp) {
            f32x16 Rn[2]; float nsn = 0.f, Bsn = 0.f, mln = 0.f;
            if (sp + 1 < u.sg) {
                const float* RS = RSb + (size_t)(sp + 1) * 16384;
#pragma unroll
                for (int t = 0; t < 2; ++t)
#pragma unroll
                    for (int i = 0; i < 16; ++i) Rn[t][i] = RS[(t * 16 + i) * 64];
                nsn = NSb[(sp + 1) * 128]; Bsn = SGb[2 * (sp + 1)]; mln = SGb[2 * (sp + 1) + 1];
            } else {
#pragma unroll
                for (int t = 0; t < 2; ++t)
#pragma unroll
                    for (int i = 0; i < 16; ++i) Rn[t][i] = 0.f;
            }
            const float mx = fmaxf(Bs + m_run, ml), al = __expf(Bs + m_run - mx), be = __expf(ml - mx);
#pragma unroll
            for (int t = 0; t < 2; ++t)
#pragma unroll
                for (int i = 0; i < 16; ++i) R[t][i] = al * R[t][i] + be * Rs[t][i];
            nst = al * nst + be * ns; m_run = mx;
#pragma unroll
            for (int t = 0; t < 2; ++t)
#pragma unroll
                for (int i = 0; i < 16; ++i) Rs[t][i] = Rn[t][i];
            ns = nsn; Bs = Bsn; ml = mln;
        }
    }
    gate_tables(G, lds, u, m_run, tid, wave, lane);
#pragma unroll
    for (int t = 0; t < 2; ++t)
#pragma unroll
        for (int i = 0; i < 16; ++i) *(LAS unsigned short*)(C0 + ((2 * dvh + t) * 32 + crow(i, hh)) * C0_PITCH + (dkb * 32 + r) * 2) = f2bf(R[t][i]);
    if (dvh == 0 && hh == 0) ((LAS float*)(lds + ML_NST))[dkb * 32 + r] = nst;
    const int tt = wave & 1, dvb = wave >> 1;
    const int t = 32 * tt + r; const bool tvalid = t < u.nvalid;
    const LAS float* mlg = (const LAS float*)(lds + ML_MLG);
    for (int cl = 0; cl < u.nch; ++cl) {
        int c = cl; asm volatile("" : "+s"(c));
        int tidc = tid, lanec = lane; asm volatile("" : "+v"(tidc), "+v"(lanec));
        const int tid = tidc, lane = lanec, r = lane & 31, hh = lane >> 5, t = 32 * tt + r; const bool tvalid = t < u.nvalid;
        const size_t rowc = u.row0 + 64 * c;
        const LAS float* GS = (const LAS float*)(lds + TAB_GS) + 64 * c;
        stage_chunk<true>(a, lds, u, c, ML_KT, tid);
        float touch = 0.f;
        if (cl + 1 < u.nch) { const size_t rn = rowc + 64 + (tid & 63); const int part = tid >> 6;
            const bf16* tb = part < 4 ? (const bf16*)(a.ws + WS_QKB) + rn * 2048 + (part >> 1) * 1024 + u.h * HD : (part < 6 ? (const bf16*)(a.ws + WS_VB) : OB) + rn * GW + u.h * HD;
            touch = *(const float*)(tb + (part & 1) * 64); }
        v2u ow[4];
#pragma unroll
        for (int g = 0; g < 4; ++g) { ow[g] = (v2u){0u, 0u}; if (tvalid) ow[g] = *(const v2u*)(OB + (rowc + t) * GW + u.h * HD + 32 * dvb + 8 * g + 4 * hh); }
        __syncthreads();
        const float m0c = ((const LAS float*)(lds + TAB_M))[c]; const float Mt = fmaxf(m0c, ((const LAS float*)(lds + TAB_CM))[64 * c + t]), it = __expf(m0c - Mt), et = __expf(-(((const LAS float*)(lds + TAB_BS))[64 * c + t] + Mt));
        f32x16 S0, S1, Nn; float dq = 0.f;
#pragma unroll
        for (int i = 0; i < 16; ++i) { S0[i] = 0.f; S1[i] = 0.f; Nn[i] = 0.f; }
        {
#pragma unroll
            for (int ks = 0; ks < 8; ++ks) {
                const bf16x8 qf = *(const LAS bf16x8*)(lds + ML_QS + t * KS_PITCH + (ks * 16 + hh * 8) * 2);
                const bf16x8 k0 = *(const LAS bf16x8*)(lds + ML_KS + r * KS_PITCH + (ks * 16 + hh * 8) * 2);
                S0 = MFMA32(k0, qf, S0);
                if (tt == 1) { const bf16x8 k1 = *(const LAS bf16x8*)(lds + ML_KS + (32 + r) * KS_PITCH + (ks * 16 + hh * 8) * 2); S1 = MFMA32(k1, qf, S1); }
            }
#pragma unroll
            for (int ks = 0; ks < 8; ++ks) { float f[8]; unpack8(*(const LAS v4u*)(lds + ML_QS + t * KS_PITCH + (ks * 16 + hh * 8) * 2), f);
                const f32x4 n0 = *(const LAS f32x4*)(lds + ML_NST + (ks * 16 + hh * 8) * 4), n1 = *(const LAS f32x4*)(lds + ML_NST + (ks * 16 + hh * 8) * 4 + 16);
#pragma unroll
                for (int e = 0; e < 8; ++e) f[e] *= it;
                dq += ((f[0] * n0[0] + f[1] * n0[1]) + (f[2] * n0[2] + f[3] * n0[3])) + ((f[4] * n1[0] + f[5] * n1[1]) + (f[6] * n1[2] + f[7] * n1[3]));
                const bf16x8 qs = __builtin_bit_cast(bf16x8, pack8f(f));
                const bf16x8 c0 = *(const LAS bf16x8*)(C0 + (32 * dvb + r) * C0_PITCH + (ks * 16 + hh * 8) * 2); Nn = MFMA32(c0, qs, Nn);
                if (ks & 1) __builtin_amdgcn_sched_barrier(0); }
        }
#pragma unroll
        for (int i = 0; i < 16; ++i) { const int s = crow(i, hh);
            S0[i] = (s <= t) ? S0[i] * __expf(GS[s] - Mt) : 0.f;
            S1[i] = (s + 32 <= t) ? S1[i] * __expf(GS[s + 32] - Mt) : 0.f;
            dq += S0[i] + S1[i]; }
        {
            bf16x8 sf[4]; sf[0] = pack_frag(S0, 0); sf[1] = pack_frag(S0, 1); sf[2] = pack_frag(S1, 0); sf[3] = pack_frag(S1, 1);
            const int nks = tt == 1 ? 4 : 2;
#pragma unroll
            for (int s = 0; s < 4; ++s) if (s < nks) {
                Nn = MFMA32(tr_frag(VT, 16 * s + 4 * hh, 16 * s + 8 + 4 * hh, 32 * dvb, lane), sf[s], Nn);
            }
        }
        const float den = sum_halves32(dq);
        const float inv = 1.0f / fmaxf(fabsf(den), et);
        float y[16]; float ss = 0.f;
#pragma unroll
        for (int g = 0; g < 4; ++g) { const int dv = 32 * dvb + 8 * g + 4 * hh;
            y[4 * g] = Nn[4 * g] * inv * __uint_as_float(ow[g].x << 16); y[4 * g + 1] = Nn[4 * g + 1] * inv * __uint_as_float(ow[g].x & 0xffff0000u);
            y[4 * g + 2] = Nn[4 * g + 2] * inv * __uint_as_float(ow[g].y << 16); y[4 * g + 3] = Nn[4 * g + 3] * inv * __uint_as_float(ow[g].y & 0xffff0000u);
            ss += (y[4 * g] * y[4 * g] + y[4 * g + 1] * y[4 * g + 1]) + (y[4 * g + 2] * y[4 * g + 2] + y[4 * g + 3] * y[4 * g + 3]); }
        ss = sum_halves32(ss);
        if (hh == 0) PS[dvb * 64 + t] = ss;
        { const LAS float* SC = (const LAS float*)(lds + TAB_SC) + 4 * c; state_update(lds, ML_KT, R, nst, SC[2], SC[3], wave, lane); }
        asm volatile("" :: "v"(touch));
        __syncthreads();
        const float tot = (PS[t] + PS[64 + t]) + (PS[128 + t] + PS[192 + t]);
        const float rstd = 1.0f / sqrtf(tot * (1.0f / 128.0f) + EPS);
        if (tvalid) {
#pragma unroll
            for (int g = 0; g < 4; ++g) { const int dv = 32 * dvb + 8 * g + 4 * hh; const f32x4 gv = *(const LAS f32x4*)(mlg + dv);
                v2u w; w.x = pk2(y[4 * g] * rstd * gv[0], y[4 * g + 1] * rstd * gv[1]); w.y = pk2(y[4 * g + 2] * rstd * gv[2], y[4 * g + 3] * rstd * gv[3]);
                *(v2u*)(MRG + pg8::tiled_elem((int)(rowc + t), GW + u.h * HD + dv, DM / 64)) = w; }
        }
        if (c + 1 < u.nch) {
#pragma unroll
            for (int tI = 0; tI < 2; ++tI)
#pragma unroll
                for (int i = 0; i < 16; ++i) *(LAS unsigned short*)(C0 + ((2 * dvh + tI) * 32 + crow(i, hh)) * C0_PITCH + (dkb * 32 + r) * 2) = f2bf(R[tI][i]);
            if (dvh == 0 && hh == 0) ((LAS float*)(lds + ML_NST))[dkb * 32 + r] = nst;
        }
    }
    if (u.samp || u.sg == NSEGB - 1) {
        int lanef = lane; asm volatile("" : "+v"(lanef));
        const int r = lanef & 31, hh = lanef >> 5;
        float* oc = a.out + (u.samp ? O_CS + (size_t)u.sid * 16384 : O_CP + (size_t)(u.b * NH + u.h) * 16384);
#pragma unroll
        for (int tI = 0; tI < 2; ++tI)
#pragma unroll
            for (int g = 0; g < 4; ++g) *(f32x4*)(oc + (size_t)(dkb * 32 + r) * HD + (2 * dvh + tI) * 32 + 8 * g + 4 * hh) = (f32x4){R[tI][4 * g], R[tI][4 * g + 1], R[tI][4 * g + 2], R[tI][4 * g + 3]};
        if (dvh == 0 && hh == 0) a.out[(u.samp ? O_NS + (size_t)u.sid * 128 : O_NP + (size_t)(u.b * NH + u.h) * 128) + dkb * 32 + r] = nst;
        if (tid == 0) a.out[u.samp ? O_MS + u.sid : O_MP + u.b * NH + u.h] = ((const LAS float*)(lds + TAB_M))[u.nch];
    }
}

__device__ __forceinline__ void final_norm_rows(const Args& a, int row_lo, int row_hi, int gw, int NGW, int lane) {
    const float* gf = a.in[I_GF];
    const bf16* XB = (const bf16*)(a.ws + WS_XB); const float* SS3 = (const float*)(a.ws + WS_SS + 15 * MiB);
    for (int m = row_hi - 1 - gw; m >= row_lo; m -= NGW) {
        float s = lane < 32 ? SS3[(size_t)m * 32 + lane] : 0.f;
        const float rstd = 1.0f / sqrtf(wave_sum(s) * (1.0f / DM) + EPS);

        float* yr = a.out + O_Y + (size_t)m * DM + 8 * lane;
#pragma unroll
        for (int j = 0; j < 4; ++j) { const v4u w = __builtin_nontemporal_load((const v4u*)(XB + pg8::tiled_elem(m, 8 * lane + 512 * j, DM / 64))); const f32x4 g0 = *(const f32x4*)(gf + 8 * lane + 512 * j), g1 = *(const f32x4*)(gf + 8 * lane + 512 * j + 4);
            f32x4 o0, o1; o0[0] = __uint_as_float(w.x << 16); o0[1] = __uint_as_float(w.x & 0xffff0000u); o0[2] = __uint_as_float(w.y << 16); o0[3] = __uint_as_float(w.y & 0xffff0000u);
            o1[0] = __uint_as_float(w.z << 16); o1[1] = __uint_as_float(w.z & 0xffff0000u); o1[2] = __uint_as_float(w.w << 16); o1[3] = __uint_as_float(w.w & 0xffff0000u);
            __builtin_nontemporal_store(o0 * rstd * g0, (f32x4*)(yr + 512 * j)); __builtin_nontemporal_store(o1 * rstd * g1, (f32x4*)(yr + 512 * j + 4)); }
    }
}


#ifndef ORD_SHARED
#define ORD_SHARED true
#endif
#define ORD_C (ORD_SHARED ? ((G % 8 == 0) ? (bx % 8) * (G / 8) + bx / 8 : bx) : bx)
#ifndef ORD_REV
#define ORD_REV true
#endif
#ifndef SPLIT_P6
#define SPLIT_P6 true
#endif
#ifndef SPLIT_P2
#define SPLIT_P2 true
#endif
#ifndef WGM_UP
#define WGM_UP 4
#endif
#ifndef WGM_DN
#define WGM_DN 4
#endif
#ifndef WGM_IN
#define WGM_IN 4
#endif
template <bool DIRECT> __device__ __forceinline__ void ph_ffn_up(LAS unsigned char* lds, const bf16* A, const bf16* W13, bf16* H, const float* SS, int G, int bx, bool rev = ORD_REV) {
    pg8::Gemm g{A, W13, MROWS, FF2, DM}; pg8::StaticOrder S; S.init(MROWS, FF2, G, ORD_C, WGM_UP); S.shared_a = ORD_SHARED; S.rev = rev;
    pg8::EpiSwiGLU<DIRECT> E{H, FF, SS};
    pg8::gemm_phase<pg8::EpiSwiGLU<DIRECT>, pg8::StaticOrder, true, true>(lds + RING_OFF, g, S, E);
}
__device__ __forceinline__ void ph_resid(LAS unsigned char* lds, const bf16* A, const bf16* Wt, int K, bf16* X, float* SSout, float scale, int G, int bx) {
    pg8::Gemm g{A, Wt, MROWS, DM, K}; pg8::StaticOrder S; S.init(MROWS, DM, G, ORD_C, WGM_DN); S.shared_a = ORD_SHARED;
    pg8::EpiResid E{X, X, SSout, scale, DM};
    pg8::gemm_phase<pg8::EpiResid, pg8::StaticOrder, true, true>(lds + RING_OFF, g, S, E);
}
__device__ __forceinline__ void ph_resid_prompt(LAS unsigned char* lds, const bf16* A, const bf16* Wt, int K, bf16* X, float* SSout, float scale, int G, int bx) {
    pg8::Gemm g{A, Wt, MP, DM, K}; pg8::StaticOrder S; S.init(MP, DM, G, ORD_C, WGM_DN); S.shared_a = ORD_SHARED;
    pg8::EpiResid E{X, X, SSout, scale, DM};
    pg8::gemm_phase<pg8::EpiResid, pg8::StaticOrder, true, true>(lds + RING_OFF, g, S, E);
}
template <int NS> __device__ __forceinline__ void ph_tail_splitk(LAS unsigned char* lds, const bf16* A, const bf16* Wt, int K, float* PART, int q) {
    const int unit = q / NS, sp = q % NS, nkt = K / 64, per = (((nkt + NS - 1) / NS) + 1) & ~1, kt0 = sp * per;
    pg8::Gemm g{A, Wt, MROWS, DM, K, kt0, (nkt - kt0) < per ? (nkt - kt0) : per}; pg8::SingleOrder S{MP / 256 + (unit >> 3), unit & 7};
    pg8::EpiPartial E{PART + (size_t)sp * MS * DM, MP};
    pg8::gemm_phase<pg8::EpiPartial, pg8::SingleOrder, true, true>(lds + RING_OFF, g, S, E);
}
__device__ __forceinline__ void ph_inproj(const Args& args, LAS unsigned char* lds, const bf16* A, const float* SS, int G, int bx) {
    unsigned char* ws = args.ws;
    pg8::Gemm g{A, (const bf16*)(ws + WS_WIN), MROWS, NINP, DM}; pg8::StaticOrder S; S.init(MROWS, NINP, G, ORD_C, WGM_IN); S.shared_a = ORD_SHARED; S.rev = ORD_REV;
    pg8::EpiInProj E{SS, (bf16*)(ws + WS_QA), (bf16*)(ws + WS_KA), (bf16*)(ws + WS_VA), (bf16*)(ws + WS_QKB), (bf16*)(ws + WS_VB), (bf16*)(ws + WS_OB),
                     args.out + O_KP, args.out + O_VP, args.out + O_KS, args.out + O_VS, (float*)(ws + WS_G), args.in[I_BIG], args.in[I_BFG], MP, QSCALE};
    pg8::gemm_phase<pg8::EpiInProj, pg8::StaticOrder, true, true>(lds + RING_OFF, g, S, E);
}

__device__ __forceinline__ void ph_probe(LAS unsigned char* lds, const bf16* A, const bf16* Wt, int N, int K, float* sink, int flag, int G, int bx) {
    pg8::Gemm g{A, Wt, MROWS, N, K}; pg8::StaticOrder S; S.init(MROWS, N, G, bx);
    pg8::EpiProbe E{sink, flag};
    pg8::gemm_phase<pg8::EpiProbe, pg8::StaticOrder, true, true>(lds + RING_OFF, g, S, E);
}

constexpr int NPHASE = 10;
#ifndef PROBE_REP
#define PROBE_REP 0
#endif
#define NREP(k) (1 + ((PROBE_REP >> (k)) & 1))
#define BARX() do { if (MK_N_LAUNCHES == 1) xcd_barrier(bar); } while (0)
__global__ void __launch_bounds__(512, 2) hymba_fwd(Args args) {
    extern __shared__ __attribute__((aligned(16))) unsigned char lds_raw[];
    LAS unsigned char* lds = (LAS unsigned char*)lds_raw;
    volatile LAS unsigned* MISC = (volatile LAS unsigned*)(lds + MISC_OFF);
    const int tid = threadIdx.x, lane = tid & 63, wave = __builtin_amdgcn_readfirstlane(tid >> 6);
    const int G = gridDim.x; const int bx = blockIdx.x; const int vcu = (G % 8 == 0) ? (bx % 8) * (G / 8) + bx / 8 : bx;
    unsigned char* ws = args.ws;
    gu32* ctl = (gu32*)(ws + WS_CTL);
    for (int u = tid; u < (LDS_BYTES - LDSCTL_OFF) / 4; u += 512) ((LAS unsigned*)(lds + LDSCTL_OFF))[u] = 0u;
    __syncthreads();
    XcdBarrier bar; bar.bar = (unsigned*)(ctl + CW_BAR); bar.x = 0; bar.st = nullptr;
    if (MK_N_LAUNCHES == 1) bar = xcd_barrier_post((unsigned*)(ctl + CW_BAR), MISC + 8);
    const int lo = args.ph_lo, hi = args.ph_hi;
#define IN(k) (lo <= (k) && (k) < hi)
#define SEAM(k) do { if (MK_N_LAUNCHES == 1 && IN(k) && IN((k) + 1)) xcd_barrier(bar); } while (0)
    bf16* XB = (bf16*)(ws + WS_XB); bf16* HB = (bf16*)(ws + WS_HU); bf16* MRG = (bf16*)(args.out + O_Y);
    float* SS0 = (float*)(ws + WS_SS); float* SS1 = (float*)(ws + WS_SS + 5 * MiB); float* SS2 = (float*)(ws + WS_SS + 10 * MiB); float* SS3 = (float*)(ws + WS_SS + 15 * MiB);
    float* RS1 = SS1 + (size_t)MROWS * 32; float* RS2 = SS2 + (size_t)MROWS * 32;
    const bool SPLITK = (MK_N_LAUNCHES == 1 && G == 256);
    constexpr int NSPL2 = 4, NSPL6 = 4;
    const int tq_x = vcu >> 5, tq_j = vcu & 31;
#define TAIL_CU(NS) (tq_j < 2 * (NS))
#define TAIL_Q(NS) (tq_x * 2 * (NS) + tq_j)
#define SIDE_I(NS) (tq_x * (32 - 2 * (NS)) + tq_j - 2 * (NS))
#define NSIDE(NS) (256 - 16 * (NS))
    float* PART = (float*)(ws + WS_RSEG);

    if (IN(0)) { p0_prologue(args, lds, vcu, G, wave, lane); if (NREP(0) == 2) p0_prologue(args, lds, vcu, G, wave, lane); } SEAM(0);
    constexpr int CV1_UP = 1536, CV3_UP = 5504;
    if (IN(1)) { ph_ffn_up<true>(lds, XB, (const bf16*)(ws + WS_W13A), HB, SS0, G, bx);
                 if (SPLITK) { const int nun = (MROWS / 256) * (FF2 / 256), nlast = nun - (nun / G) * G;
                     if (nlast > 0 && vcu >= nlast) { convert_weights(args, lds, 1, (vcu - nlast) * 8 + wave, (G - nlast) * 8, wave, lane, 18432, 20480); convert_weights(args, lds, 1, (vcu - nlast) * 8 + wave, (G - nlast) * 8, wave, lane, 0, CV1_UP); } } if (NREP(12) == 2) ph_ffn_up<true>(lds, XB, (const bf16*)(ws + WS_W13A), HB, SS0, G, bx); if (NREP(1) == 2) ph_probe(lds, XB, (const bf16*)(ws + WS_W13A), FF2, DM, (float*)(ws + WS_RSEG), args.ph_lo < 0, G, bx); } SEAM(1);
    if (IN(2) && SPLITK && SPLIT_P2) { ph_resid_prompt(lds, HB, (const bf16*)(ws + WS_W2A), FF, XB, SS1, 0.5f, G, bx);
                 if (TAIL_CU(NSPL2)) ph_tail_splitk<NSPL2>(lds, HB, (const bf16*)(ws + WS_W2A), FF, PART, TAIL_Q(NSPL2));
                 else convert_weights(args, lds, 1, SIDE_I(NSPL2) * 8 + wave, NSIDE(NSPL2) * 8, wave, lane, CV1_UP + CV3_UP, 18432); }
    else if (IN(2)) { ph_resid(lds, HB, (const bf16*)(ws + WS_W2A), FF, XB, SS1, 0.5f, G, bx);
                 { const int nun = (MROWS / 256) * (DM / 256), nfull = nun / G, nlast = nun - nfull * G;
                   const int oc = ORD_C;
                   if (nlast > 0 && oc >= nlast) convert_weights(args, lds, 1, (oc - nlast) * 8 + wave, (G - nlast) * 8, wave, lane);
                   else if (nlast == 0) convert_weights(args, lds, 1, oc * 8 + wave, G * 8, wave, lane); }
                 if (NREP(2) == 2) { __syncthreads(); ph_probe(lds, HB, (const bf16*)(ws + WS_W2A), DM, FF, (float*)(ws + WS_RSEG), args.ph_lo < 0, G, bx); } } SEAM(2);
    if (IN(3)) { if (SPLITK && SPLIT_P2) { finalize_rstd(SS1, RS1, vcu * 8 + wave, G * 8, lane, MP); reduce_sample_rows<NSPL2>(args, PART, 0.5f, RS1, wave * G + vcu, G * 8, lane); } else finalize_rstd(SS1, RS1, vcu * 8 + wave, G * 8, lane);
                 if (MK_N_LAUNCHES == 1) xcd_barrier(bar); else if (lo == 3) {   finalize_rstd(SS1, RS1, wave, 8, lane); __syncthreads(); }
                 ph_inproj(args, lds, XB, RS1, G, bx);
                 if (SPLITK) { const int nun = (MROWS / 256) * (NINP / 256), nlast = nun - (nun / G) * G;
                     if (nlast > 0 && vcu >= nlast) convert_weights(args, lds, 1, (vcu - nlast) * 8 + wave, (G - nlast) * 8, wave, lane, CV1_UP, CV1_UP + CV3_UP); } if (NREP(13) == 2) ph_inproj(args, lds, XB, RS1, G, bx); if (NREP(3) == 2) ph_probe(lds, XB, (const bf16*)(ws + WS_WIN), NINP, DM, (float*)(ws + WS_RSEG), args.ph_lo < 0, G, bx); } SEAM(3);
    if (IN(4)) {
        for (int j = vcu; j < NBP * NH * (NSEGB - 1); j += G) mlstm_summary_unit(args, lds, (j / (NSEGB - 1)) * NSEGB + j % (NSEGB - 1), tid, wave, lane);
        attn_prompt_phase(args, lds, vcu, G, tid, wave, lane);
        for (int u = vcu; u < NBS * NH; u += G) attn_sample_unit(args, lds, u >> 3, u & 7, tid, wave, lane);
        if (NREP(4) == 2) { for (int j = vcu; j < NBP * NH * (NSEGB - 1); j += G) mlstm_summary_unit(args, lds, (j / (NSEGB - 1)) * NSEGB + j % (NSEGB - 1), tid, wave, lane); }
        if (NREP(10) == 2) attn_prompt_phase(args, lds, vcu, G, tid, wave, lane);
        if (NREP(11) == 2) { for (int u = vcu; u < NBS * NH; u += G) attn_sample_unit(args, lds, u >> 3, u & 7, tid, wave, lane); }
    } SEAM(4);
    if (IN(5)) {
        for (int rep = 0; rep < NREP(5); ++rep)
        for (int s = vcu; s < NSEGP + NBS * NH; s += G) mlstm_out_unit(args, lds, s < NSEGP ? munit_prompt(s) : munit_sample(s - NSEGP), tid, wave, lane);
    } SEAM(5);
    if (IN(6) && SPLITK && SPLIT_P6) { __syncthreads(); ph_resid_prompt(lds, MRG, (const bf16*)(ws + WS_WOUT), DM, XB, SS2, 1.0f, G, bx);
                 if (TAIL_CU(NSPL6)) ph_tail_splitk<NSPL6>(lds, MRG, (const bf16*)(ws + WS_WOUT), DM, PART, TAIL_Q(NSPL6));
                 else convert_weights(args, lds, 2, SIDE_I(NSPL6) * 8 + wave, NSIDE(NSPL6) * 8, wave, lane); }
    else if (IN(6)) { __syncthreads(); ph_resid(lds, MRG, (const bf16*)(ws + WS_WOUT), DM, XB, SS2, 1.0f, G, bx);
                 { const int nun = (MROWS / 256) * (DM / 256), nfull = nun / G, nlast = nun - nfull * G;
                   const int oc = ORD_C;
                   if (nlast > 0 && oc >= nlast) convert_weights(args, lds, 2, (oc - nlast) * 8 + wave, (G - nlast) * 8, wave, lane);
                   else if (nlast == 0) convert_weights(args, lds, 2, oc * 8 + wave, G * 8, wave, lane); }
                 if (NREP(6) == 2) ph_probe(lds, MRG, (const bf16*)(ws + WS_WOUT), DM, DM, (float*)(ws + WS_RSEG), args.ph_lo < 0, G, bx); } SEAM(6);
    if (IN(7)) { if (SPLITK && SPLIT_P6) { finalize_rstd(SS2, RS2, vcu * 8 + wave, G * 8, lane, MP); reduce_sample_rows<NSPL6>(args, PART, 1.0f, RS2, wave * G + vcu, G * 8, lane); } else finalize_rstd(SS2, RS2, vcu * 8 + wave, G * 8, lane);
                 if (MK_N_LAUNCHES == 1) xcd_barrier(bar); else if (lo == 7) { finalize_rstd(SS2, RS2, wave, 8, lane); __syncthreads(); }
                 ph_ffn_up<true>(lds, XB, (const bf16*)(ws + WS_W13B), HB, RS2, G, bx); if (NREP(7) == 2) ph_probe(lds, XB, (const bf16*)(ws + WS_W13B), FF2, DM, (float*)(ws + WS_RSEG), args.ph_lo < 0, G, bx); } SEAM(7);
    if (IN(8) && IN(9) && MK_N_LAUNCHES == 1 && G == 256) {
        { pg8::Gemm g{HB, (const bf16*)(ws + WS_W2B), MP, DM, FF}; pg8::StaticOrder S; S.init(MP, DM, G, ORD_C, WGM_DN); S.shared_a = ORD_SHARED;
          pg8::EpiResid E{XB, XB, SS3, 0.5f, DM};
          pg8::gemm_phase<pg8::EpiResid, pg8::StaticOrder, true, true>(lds + RING_OFF, g, S, E); }
        xcd_barrier(bar);
        { const int tq_x = vcu >> 5, tq_j = vcu & 31; float* PART = (float*)(ws + WS_RSEG);
          constexpr int NORM_SPLIT = 14336;
          if (tq_j < 4) { const int q = tq_x * 4 + tq_j, unit = q >> 1, sp = q & 1;
              pg8::Gemm g{HB, (const bf16*)(ws + WS_W2B), MROWS, DM, FF, sp * 44, sp ? 42 : 44}; pg8::SingleOrder S{MP / 256 + (unit >> 3), unit & 7};
              pg8::EpiPartial E{PART + (size_t)sp * MS * DM, MP};
              pg8::gemm_phase<pg8::EpiPartial, pg8::SingleOrder, true, true>(lds + RING_OFF, g, S, E); }
          else final_norm_rows(args, NORM_SPLIT, MP, (tq_x * 28 + tq_j - 4) * 8 + wave, 224 * 8, lane);
          final_norm_rows(args, 0, NORM_SPLIT, vcu * 8 + wave, G * 8, lane);
          xcd_barrier(bar);
          final_norm_sample_rows(args, PART, wave * G + vcu, G * 8, lane); }
    } else {
    if (IN(8)) { ph_resid(lds, HB, (const bf16*)(ws + WS_W2B), FF, XB, SS3, 0.5f, G, bx);
                 if (NREP(8) == 2) ph_probe(lds, HB, (const bf16*)(ws + WS_W2B), DM, FF, (float*)(ws + WS_RSEG), args.ph_lo < 0, G, bx); } SEAM(8);
    if (IN(9)) { final_norm_rows(args, 0, MROWS, vcu * 8 + wave, G * 8, lane); }
    }
#undef IN
#undef SEAM
}

extern "C" void kernel_launch(void* const* d_in, const int* in_sizes, int n_in, void* d_out, int out_size, void* d_ws, size_t ws_size, hipStream_t stream) {
    static int grid = 0;
    if (grid == 0) {
        if (n_in != 26 || (size_t)out_size != O_END || ws_size < WS_END) { fprintf(stderr, "kernel_launch: unexpected shapes: n_in %d out %d ws %zu (need %zu)\n", n_in, out_size, ws_size, (size_t)WS_END); grid = -1; return; }
        int dev = 0, cus = 0, per_cu = 0;
        if (hipGetDevice(&dev) != hipSuccess || hipDeviceGetAttribute(&cus, hipDeviceAttributeMultiprocessorCount, dev) != hipSuccess) { grid = -1; return; }
        if (hipFuncSetAttribute((const void*)hymba_fwd, hipFuncAttributeMaxDynamicSharedMemorySize, LDS_BYTES) != hipSuccess) { fprintf(stderr, "kernel_launch: hipFuncSetAttribute failed\n"); grid = -1; return; }
        if (hipOccupancyMaxActiveBlocksPerMultiprocessor(&per_cu, (const void*)hymba_fwd, 512, LDS_BYTES) != hipSuccess || per_cu < 1) { fprintf(stderr, "kernel_launch: occupancy query says %d\n", per_cu); (void)hipGetLastError(); grid = -1; return; }
        grid = cus;
    }
    if (grid < 0) return;
    if (hipMemsetAsync((char*)d_ws + WS_CTL, 0, CTL_ZERO_BYTES, stream) != hipSuccess) return;
    Args a{};
    for (int i = 0; i < 26; ++i) a.in[i] = (const float*)d_in[i];
    a.out = (float*)d_out; a.ws = (unsigned char*)d_ws;
    if (MK_N_LAUNCHES == 1) { a.ph_lo = 0; a.ph_hi = NPHASE; hipLaunchKernelGGL(hymba_fwd, dim3(grid), dim3(512), LDS_BYTES, stream, a); }
    else for (int p = 0; p < NPHASE; ++p) { a.ph_lo = p; a.ph_hi = p + 1; hipLaunchKernelGGL(hymba_fwd, dim3(grid), dim3(512), LDS_BYTES, stream, a); }
}
```
